# Optimizing an MI355X kernel written in HIP

```python
import jax, jax.numpy as jnp
from jax import lax
import numpy as np

D_MODEL = 1024
BATCH = 8
SEQ = 4096
DEPTH = 2

HEAD_DIM = 64
N_Q_HEADS = 8
N_KV_HEADS = 2
GQA_GROUP = N_Q_HEADS // N_KV_HEADS
WINDOW = 128
ROPE_THETA = 10000.0
RET_HEADS = 4
RET_QK_DIM = 128
RET_V_DIM = 2 * RET_QK_DIM
RET_CHUNK = 128
RET_THETA = 10000.0
D_FF = 4 * D_MODEL
EPS = 1e-6

ATT_Q = N_Q_HEADS * HEAD_DIM
ATT_KV = N_KV_HEADS * HEAD_DIM
RET_QK = RET_HEADS * RET_QK_DIM
RET_V = RET_HEADS * RET_V_DIM
SPLIT_SIZES = (ATT_Q, ATT_KV, ATT_KV, RET_QK, RET_QK, RET_V, RET_V, D_MODEL, D_MODEL)
W_IN = sum(SPLIT_SIZES)
SPLIT_POINTS = tuple(int(v) for v in np.cumsum(SPLIT_SIZES)[:-1])

kernel_name = "hybrid_swa_sink_retention_gated"


def rmsnorm(x, g):
    xf = x.astype(jnp.float32)
    y = xf * lax.rsqrt(jnp.mean(xf * xf, axis=-1, keepdims=True) + EPS)
    return (y * g.astype(jnp.float32)).astype(x.dtype)


def rope_half(x, pos):
    half = x.shape[-1] // 2
    inv = ROPE_THETA ** (-jnp.arange(half, dtype=jnp.float32) / half)
    ang = pos.astype(jnp.float32)[:, None] * inv[None, :]
    cos = jnp.cos(ang)[None, :, None, :]
    sin = jnp.sin(ang)[None, :, None, :]
    xf = x.astype(jnp.float32)
    x1, x2 = xf[..., :half], xf[..., half:]
    return jnp.concatenate([x1 * cos - x2 * sin, x2 * cos + x1 * sin], axis=-1).astype(x.dtype)


def rotate_every_two(x):
    x1, x2 = x[..., ::2], x[..., 1::2]
    return jnp.stack([-x2, x1], axis=-1).reshape(x.shape)


def retention_rotation(x, pos):
    dk = x.shape[-1]
    theta = 1.0 / (RET_THETA ** jnp.linspace(0.0, 1.0, dk // 2, dtype=jnp.float32))
    theta = jnp.repeat(theta, 2)
    ang = pos.astype(jnp.float32)[:, None] * theta[None, :]
    cos = jnp.cos(ang)[None, :, None, :]
    sin = jnp.sin(ang)[None, :, None, :]
    xf = x.astype(jnp.float32)
    return (xf * cos + rotate_every_two(xf) * sin).astype(x.dtype)


def sliding_window_sink_attention(q, k, v, sinks):
    B, S = q.shape[0], q.shape[1]
    C = WINDOW
    nb = S // C
    qb = q.reshape(B, nb, C, N_KV_HEADS, GQA_GROUP, HEAD_DIM)
    kb = k.reshape(B, nb, C, N_KV_HEADS, HEAD_DIM)
    vb = v.reshape(B, nb, C, N_KV_HEADS, HEAD_DIM)

    def band(t):
        prev = jnp.pad(t, ((0, 0), (1, 0), (0, 0), (0, 0), (0, 0)))[:, :-1]
        return jnp.concatenate([prev, t], axis=2)

    kk, vv = band(kb), band(vb)
    s = jnp.einsum('bnqhgd,bnkhd->bnhgqk', qb, kk).astype(jnp.float32) * (HEAD_DIM ** -0.5)
    qi = jnp.arange(C)[:, None] + C
    kj = jnp.arange(2 * C)[None, :]
    rel = qi - kj
    valid = (rel >= 0) & (rel < WINDOW)
    first = (jnp.arange(nb) > 0)[:, None, None] | (kj >= C)[None]
    mask = valid[None] & first
    s = jnp.where(mask[None, :, None, None], s, -jnp.inf)
    sink = jnp.broadcast_to(
        sinks.astype(jnp.float32).reshape(1, 1, N_KV_HEADS, GQA_GROUP, 1, 1),
        s.shape[:-1] + (1,))
    p = jax.nn.softmax(jnp.concatenate([s, sink], axis=-1), axis=-1)[..., :-1]
    o = jnp.einsum('bnhgqk,bnkhd->bnqhgd', p.astype(v.dtype), vv)
    return o.reshape(B, S, ATT_Q)


def chunkwise_retention(q, k, v):
    B, S = q.shape[0], q.shape[1]
    C = RET_CHUNK
    nc = S // C
    log_g = jnp.log(1.0 - 2.0 ** (-5.0 - jnp.arange(RET_HEADS, dtype=jnp.float32)))
    idx = jnp.arange(C, dtype=jnp.float32)
    rel = idx[:, None] - idx[None, :]
    dmask = jnp.where(rel[None] >= 0, jnp.exp(log_g[:, None, None] * jnp.maximum(rel, 0.0)[None]), 0.0)

    qc = q.astype(jnp.float32).reshape(B, nc, C, RET_HEADS, RET_QK_DIM)
    kc = k.astype(jnp.float32).reshape(B, nc, C, RET_HEADS, RET_QK_DIM)
    vc = v.astype(jnp.float32).reshape(B, nc, C, RET_HEADS, RET_V_DIM)

    s = jnp.einsum('bnihd,bnjhd->bnhij', qc, kc) * dmask[None, None]
    inner = jnp.einsum('bnhij,bnjhe->bnihe', s, vc)

    zeta = jnp.exp(log_g[None, :] * (C - 1.0 - idx)[:, None])
    kv = jnp.einsum('bnjhd,bnjhe->nbhde', kc, vc * zeta[None, None, :, :, None])
    g_chunk = jnp.exp(log_g * C)[None, :, None, None]

    def step(R, kv_n):
        return R * g_chunk + kv_n, R

    R0 = jnp.zeros((B, RET_HEADS, RET_QK_DIM, RET_V_DIM), jnp.float32)
    _, R_prev = lax.scan(step, R0, kv)
    xi = jnp.exp(log_g[None, :] * (idx + 1.0)[:, None])
    cross = jnp.einsum('bnihd,nbhde->bnihe', qc, R_prev) * xi[None, None, :, :, None]
    return (inner + cross).reshape(B, S, RET_HEADS, RET_V_DIM)


def hybrid_layer(x, g_mix, w_in, sinks, w_a, w_b, w_out, g_mlp, w_up, w_down):
    B, S, _ = x.shape
    pos = jnp.arange(S)
    h = rmsnorm(x, g_mix)
    z = h @ w_in
    aq, ak, av, rq, rk, rv, rg, ga, gb = jnp.split(z, SPLIT_POINTS, axis=-1)

    aq = rope_half(aq.reshape(B, S, N_Q_HEADS, HEAD_DIM), pos)
    ak = rope_half(ak.reshape(B, S, N_KV_HEADS, HEAD_DIM), pos)
    av = av.reshape(B, S, N_KV_HEADS, HEAD_DIM)
    ya = sliding_window_sink_attention(aq, ak, av, sinks) @ w_a

    rq = retention_rotation(rq.reshape(B, S, RET_HEADS, RET_QK_DIM), pos)
    rk = retention_rotation(rk.reshape(B, S, RET_HEADS, RET_QK_DIM), pos) * (RET_QK_DIM ** -0.5)
    rv = rv.reshape(B, S, RET_HEADS, RET_V_DIM)
    r = chunkwise_retention(rq, rk, rv)
    r = r * lax.rsqrt(jnp.mean(r * r, axis=-1, keepdims=True) + EPS)
    r = r.reshape(B, S, RET_V) * jax.nn.silu(rg.astype(jnp.float32))
    yb = r.astype(x.dtype) @ w_b

    mixed = jax.nn.sigmoid(ga) * ya + jax.nn.sigmoid(gb) * yb
    x = x + mixed @ w_out

    h2 = rmsnorm(x, g_mlp)
    x = x + jnp.square(jax.nn.relu(h2 @ w_up)) @ w_down
    return x


def setup_inputs(seed: int = 0) -> dict:
    key = jax.random.key(seed)
    ks = jax.random.split(key, 12)
    f32 = jnp.float32

    def nrm(k, shape, fan_in):
        return jax.random.normal(k, shape, f32) * (fan_in ** -0.5)

    return {
        "x": jax.random.normal(ks[0], (BATCH, SEQ, D_MODEL), f32),
        "g_mix": 1.0 + 0.05 * jax.random.normal(ks[1], (DEPTH, D_MODEL), f32),
        "w_in": nrm(ks[2], (DEPTH, D_MODEL, W_IN), D_MODEL),
        "sinks": 0.5 * jax.random.normal(ks[3], (DEPTH, N_Q_HEADS), f32),
        "w_a": nrm(ks[4], (DEPTH, ATT_Q, D_MODEL), ATT_Q),
        "w_b": nrm(ks[5], (DEPTH, RET_V, D_MODEL), RET_V),
        "w_out": nrm(ks[6], (DEPTH, D_MODEL, D_MODEL), D_MODEL),
        "g_mlp": 1.0 + 0.05 * jax.random.normal(ks[7], (DEPTH, D_MODEL), f32),
        "w_up": nrm(ks[8], (DEPTH, D_MODEL, D_FF), D_MODEL),
        "w_down": nrm(ks[9], (DEPTH, D_FF, D_MODEL), D_FF),
        "g_final": 1.0 + 0.05 * jax.random.normal(ks[10], (D_MODEL,), f32),
    }


def reference(x, g_mix, w_in, sinks, w_a, w_b, w_out, g_mlp, w_up, w_down, g_final):
    for l in range(DEPTH):
        x = hybrid_layer(x, g_mix[l], w_in[l], sinks[l], w_a[l], w_b[l], w_out[l],
                         g_mlp[l], w_up[l], w_down[l])
    return rmsnorm(x, g_final)
```

```cpp
#include <hip/hip_runtime.h>
#include <cstdio>
#include <cstdint>
namespace pg8 {
#define PG8_LAS __attribute__((address_space(3)))
typedef unsigned short bf16_t;
typedef short bf16x8 __attribute__((ext_vector_type(8)));
typedef float f32x4 __attribute__((ext_vector_type(4)));
typedef float f32x2 __attribute__((ext_vector_type(2)));
typedef unsigned u32x4 __attribute__((ext_vector_type(4)));
constexpr int BM = 256, BK = 64, HALF = 128, HTB = HALF * BK * 2  , STAGE_BYTES = 8 * HTB, NXCD = 8, WGM = 8;

__host__ __device__ __forceinline__ int lds_byte(int r, int c) { const int st = (r >> 4) * 2 + (c >> 5), rr = r & 15, cc = c & 31, ob = rr * 64 + cc * 2; return st * 1024 + (ob ^ (((ob >> 9) & 1) << 5)); }
__host__ __device__ __forceinline__ void stage_rc(int b, int& R, int& C) { const int st = b / 1024, sb = b % 1024, swz = sb ^ (((sb >> 9) & 1) << 5); R = (st >> 1) * 16 + swz / 64; C = (st & 1) * 32 + (swz % 64) / 2; }
__host__ __device__ __forceinline__ int perm32(int rho) { const int n = rho >> 4, i = rho & 15; return 8 * (i >> 2) + 4 * n + (i & 3); }

struct Unit { int pm, pn; };
template <int M_, int N_, int K_, int LDA_> struct Gemm { const bf16_t* A; const bf16_t* Bt; static constexpr int M = M_, N = N_, K = K_, lda = LDA_; };

template <int M_, int N_> struct StaticOrder {
    static constexpr int nM = M_ / BM, nN = N_ / BM, nwg = nM * nN; int G, c;
    __host__ __device__ void init(int G_, int c_) { G = G_; c = c_; }
    __host__ __device__ bool next(int i, Unit& u) const {
        const long L = (long)i * G + c; if (L >= nwg) return false;
        int wgid = (int)L; { const int q = nwg / NXCD, r = nwg % NXCD, xcd = wgid % NXCD, off = wgid / NXCD; wgid = (xcd < r ? xcd * (q + 1) : r * (q + 1) + (xcd - r) * q) + off; }
        const int nig = WGM * nN, gid = wgid / nig, fm = gid * WGM, gsz = (nM - fm) < WGM ? (nM - fm) : WGM;
        u.pm = fm + ((wgid % nig) % gsz); u.pn = (wgid % nig) / gsz; return true;
    }
    __device__ __forceinline__ void a_ready(const Unit&) const {}
    __device__ __forceinline__ void done(const Unit&) const {}
};

__device__ __forceinline__ unsigned cvt_pk_bf16(float lo, float hi) { unsigned r; asm volatile("v_cvt_pk_bf16_f32 %0, %1, %2" : "=v"(r) : "v"(lo), "v"(hi)); return r; }

template <int ACT  > struct EpiBf16 {
    static constexpr bool PERM = true, AFTER_DRAIN = false;
    bf16_t* O; int ldc;
    __device__ __forceinline__ void operator()(const f32x4 (&acc)[2][2][4][2], const Unit& u, int wr, int wc, int fr, int fq) const {
        const int row0 = u.pm * BM + wr * 64 + fr; const int col0 = u.pn * BM + wc * 32 + 8 * fq;
#pragma unroll
        for (int ai = 0; ai < 2; ++ai)
#pragma unroll
            for (int m = 0; m < 4; ++m) { bf16_t* rowp = O + (size_t)(row0 + ai * HALF + m * 16) * ldc + col0;
#pragma unroll
                for (int bj = 0; bj < 2; ++bj) { f32x4 v0 = acc[ai][bj][m][0], v1 = acc[ai][bj][m][1];
                    if (ACT == 2) {
#pragma unroll
                        for (int i = 0; i < 4; ++i) { const float a = fmaxf(v0[i], 0.f), b = fmaxf(v1[i], 0.f); v0[i] = a * a; v1[i] = b * b; } }
                    u32x4 w; w.x = cvt_pk_bf16(v0[0], v0[1]); w.y = cvt_pk_bf16(v0[2], v0[3]); w.z = cvt_pk_bf16(v1[0], v1[1]); w.w = cvt_pk_bf16(v1[2], v1[3]);
                    *(u32x4*)(rowp + bj * HALF) = w; } }
    }
};
struct EpiResF32 {
    static constexpr bool PERM = false, AFTER_DRAIN = false;
    const float* base; float* out; int ldc;
    __device__ __forceinline__ void operator()(const f32x4 (&acc)[2][2][4][2], const Unit& u, int wr, int wc, int fr, int fq) const {
        const int col0 = u.pn * BM + wc * 32 + 4 * fq;
#pragma unroll
        for (int ai = 0; ai < 2; ++ai)
#pragma unroll
            for (int m = 0; m < 4; ++m) { const int r = ai * HALF + wr * 64 + m * 16 + fr; const size_t off = (size_t)(u.pm * BM + r) * ldc + col0;
#pragma unroll
                for (int bj = 0; bj < 2; ++bj)
#pragma unroll
                    for (int n = 0; n < 2; ++n) { const f32x4 bs = *(const f32x4*)(base + off + bj * HALF + n * 16); *(f32x4*)(out + off + bj * HALF + n * 16) = bs + acc[ai][bj][m][n]; } }
    }
};

template <class Epi, class Sched, bool ALIGN_EPI, bool SP2, class GemmT>
__device__ __forceinline__ void gemm_phase(PG8_LAS unsigned char* lds, const GemmT g, const Sched& S, const Epi& E) {
    int tid_ = threadIdx.x; asm volatile("" : "+v"(tid_));
    const int tid = tid_, wid = __builtin_amdgcn_readfirstlane(tid >> 6), lane = tid & 63, wr = wid >> 2, wc = wid & 3, fr = lane & 15, fq = lane >> 4;
    constexpr int K = GemmT::K, nt = K / BK, lda = GemmT::lda;
    unsigned voffA[2], voffB[2];
#pragma unroll
    for (int i = 0; i < 2; ++i) { int R, C; stage_rc(tid * 16 + i * 8192, R, C); const int Rb = Epi::PERM ? ((R & ~31) + perm32(R & 31)) : R;
        voffA[i] = (unsigned)(R * lda + C) * 2u; voffB[i] = (unsigned)(Rb * K + C) * 2u; }
    constexpr size_t kstep = (size_t)(BK * 2);
    constexpr size_t hstepA = (size_t)HALF * lda * 2, hstepB = (size_t)HALF * K * 2;
    constexpr size_t tstepA = 2 * hstepA, tstepB = 2 * hstepB;
    const unsigned ldsw = (unsigned)wid * 1024u;
    const int aoff = lds_byte(wr * 64 + fr, fq * 8), boff = lds_byte(wc * 32 + fr, fq * 8);
#define PG8_SA(b, h) (((b) * 2 + (h)) * HTB)
#define PG8_SB(b, h) ((4 + (b) * 2 + (h)) * HTB)
#define PG8_STAGE(bufoff, gbase, voff) do { _Pragma("unroll") for (int _i = 0; _i < 2; ++_i) \
        __builtin_amdgcn_global_load_lds((const unsigned*)((const char*)(gbase) + (voff)[_i]), (PG8_LAS unsigned*)(lds + (bufoff) + ldsw + _i * 8192), 16, 0, 0); } while (0)
#define PG8_LDA(dst, b, h) do { _Pragma("unroll") for (int m = 0; m < 4; ++m) _Pragma("unroll") for (int k = 0; k < 2; ++k) dst[m][k] = *(const PG8_LAS bf16x8*)(lds + PG8_SA(b, h) + aoff + m * 2048 + k * 1024); } while (0)
#define PG8_LDB(dst, b, h) do { _Pragma("unroll") for (int n = 0; n < 2; ++n) _Pragma("unroll") for (int k = 0; k < 2; ++k) dst[n][k] = *(const PG8_LAS bf16x8*)(lds + PG8_SB(b, h) + boff + n * 2048 + k * 1024); } while (0)
#define PG8_MMA(ai, bj, At, Bt) do { __builtin_amdgcn_s_setprio(1); _Pragma("unroll") for (int m = 0; m < 4; ++m) _Pragma("unroll") for (int n = 0; n < 2; ++n) _Pragma("unroll") for (int k = 0; k < 2; ++k) \
        acc[ai][bj][m][n] = __builtin_amdgcn_mfma_f32_16x16x32_bf16(Bt[n][k], At[m][k], acc[ai][bj][m][n], 0, 0, 0); __builtin_amdgcn_s_setprio(0); } while (0)
#define PG8_WAIT_V(n) asm volatile("s_waitcnt vmcnt(" #n ")" ::: "memory")
#define PG8_WAIT_L(n) asm volatile("s_waitcnt lgkmcnt(" #n ")" ::: "memory")
#define PG8_BAR __builtin_amdgcn_s_barrier()
#define PG8_SCHED __builtin_amdgcn_sched_barrier(0)
    Unit cur, nxt; int ui = 0;
    if (!S.next(0, cur)) return;
    f32x4 acc[2][2][4][2];
#pragma unroll
    for (int a = 0; a < 2; ++a)
#pragma unroll
        for (int b = 0; b < 2; ++b)
#pragma unroll
            for (int m = 0; m < 4; ++m)
#pragma unroll
                for (int n = 0; n < 2; ++n) acc[a][b][m][n] = (f32x4){0.f, 0.f, 0.f, 0.f};
    bf16x8 At[4][2], B0[2][2], B1[2][2];
    const char* cA = (const char*)g.A + (size_t)cur.pm * tstepA; const char* cB = (const char*)g.Bt + (size_t)cur.pn * tstepB;
    S.a_ready(cur);
    if constexpr (SP2) {
        PG8_STAGE(PG8_SB(0, 0), cB, voffB); PG8_STAGE(PG8_SB(0, 1), cB + hstepB, voffB); PG8_STAGE(PG8_SA(0, 0), cA, voffA); PG8_STAGE(PG8_SA(0, 1), cA + hstepA, voffA);
        if (wr == 1) PG8_BAR;
        PG8_WAIT_V(2); PG8_BAR;
        PG8_STAGE(PG8_SB(1, 0), cB + kstep, voffB); PG8_STAGE(PG8_SA(1, 0), cA + kstep, voffA); PG8_STAGE(PG8_SB(1, 1), cB + hstepB + kstep, voffB);
        PG8_WAIT_V(6); PG8_BAR;
    } else {
        PG8_STAGE(PG8_SB(0, 0), cB, voffB); PG8_STAGE(PG8_SA(0, 0), cA, voffA); PG8_STAGE(PG8_SB(0, 1), cB + hstepB, voffB); PG8_STAGE(PG8_SA(0, 1), cA + hstepA, voffA);
        if (wr == 1) PG8_BAR;
        PG8_WAIT_V(4); PG8_BAR;
        PG8_STAGE(PG8_SB(1, 0), cB + kstep, voffB); PG8_STAGE(PG8_SA(1, 0), cA + kstep, voffA); PG8_STAGE(PG8_SB(1, 1), cB + hstepB + kstep, voffB);
        PG8_WAIT_V(6); PG8_BAR;
    }
    for (;;) {
        const bool has_next = S.next(ui + 1, nxt);
        const char* nA = has_next ? (const char*)g.A + (size_t)nxt.pm * tstepA : cA; const char* nB = has_next ? (const char*)g.Bt + (size_t)nxt.pn * tstepB : cB;
#pragma unroll 1
        for (int t = 0; t < nt; t += 2) {
            const bool last = (t == nt - 2);
            const char* a1 = cA + (size_t)(t + 1) * kstep;
            const char* a2 = last ? nA : cA + (size_t)(t + 2) * kstep; const char* b2 = last ? nB : cB + (size_t)(t + 2) * kstep;
            const char* a3 = a2 + kstep; const char* b3 = b2 + kstep;
            if (last && has_next) S.a_ready(nxt);
            if constexpr (SP2) {
            PG8_LDB(B0, 0, 0); PG8_LDB(B1, 0, 1); PG8_SCHED; PG8_LDA(At, 0, 0); PG8_STAGE(PG8_SA(1, 1), a1 + hstepA, voffA);
            PG8_WAIT_V(8); PG8_WAIT_L(0); PG8_BAR; PG8_MMA(0, 0, At, B0); PG8_MMA(0, 1, At, B1); PG8_BAR; PG8_SCHED;
            PG8_LDA(At, 0, 1); PG8_STAGE(PG8_SB(0, 0), b2, voffB); PG8_STAGE(PG8_SB(0, 1), b2 + hstepB, voffB); PG8_STAGE(PG8_SA(0, 0), a2, voffA);
            PG8_WAIT_V(8); PG8_WAIT_L(0); PG8_BAR; PG8_MMA(1, 0, At, B0); PG8_MMA(1, 1, At, B1); PG8_BAR; PG8_SCHED;
            PG8_LDB(B0, 1, 0); PG8_LDB(B1, 1, 1); PG8_SCHED; PG8_LDA(At, 1, 0); PG8_STAGE(PG8_SA(0, 1), a2 + hstepA, voffA);
            PG8_WAIT_V(8); PG8_WAIT_L(0); PG8_BAR; PG8_MMA(0, 0, At, B0); PG8_MMA(0, 1, At, B1); PG8_BAR; PG8_SCHED;
            PG8_LDA(At, 1, 1); PG8_STAGE(PG8_SB(1, 0), b3, voffB); PG8_STAGE(PG8_SB(1, 1), b3 + hstepB, voffB); PG8_STAGE(PG8_SA(1, 0), a3, voffA);
            PG8_WAIT_V(8); PG8_WAIT_L(0); PG8_BAR; PG8_MMA(1, 0, At, B0); PG8_MMA(1, 1, At, B1); PG8_BAR; PG8_SCHED;
            } else {
            PG8_LDB(B0, 0, 0); PG8_SCHED; PG8_LDA(At, 0, 0); PG8_STAGE(PG8_SA(1, 1), a1 + hstepA, voffA);
            PG8_WAIT_L(8); PG8_BAR; PG8_WAIT_L(0); PG8_MMA(0, 0, At, B0); PG8_BAR; PG8_SCHED;
            PG8_LDB(B1, 0, 1); PG8_STAGE(PG8_SB(0, 0), b2, voffB);
            PG8_BAR; PG8_WAIT_L(0); PG8_MMA(0, 1, At, B1); PG8_BAR;
            PG8_LDA(At, 0, 1); PG8_STAGE(PG8_SA(0, 0), a2, voffA);
            PG8_BAR; PG8_WAIT_L(0); PG8_MMA(1, 0, At, B0); PG8_BAR; PG8_SCHED;
            PG8_STAGE(PG8_SB(0, 1), b2 + hstepB, voffB);
            PG8_WAIT_V(6); PG8_BAR; PG8_MMA(1, 1, At, B1); PG8_BAR;
            PG8_LDB(B0, 1, 0); PG8_SCHED; PG8_LDA(At, 1, 0); PG8_STAGE(PG8_SA(0, 1), a2 + hstepA, voffA);
            PG8_WAIT_L(8); PG8_BAR; PG8_WAIT_L(0); PG8_MMA(0, 0, At, B0); PG8_BAR; PG8_SCHED;
            PG8_LDB(B1, 1, 1); PG8_STAGE(PG8_SB(1, 0), b3, voffB);
            PG8_BAR; PG8_WAIT_L(0); PG8_MMA(0, 1, At, B1); PG8_BAR;
            PG8_LDA(At, 1, 1); PG8_STAGE(PG8_SA(1, 0), a3, voffA);
            PG8_BAR; PG8_WAIT_L(0); PG8_MMA(1, 0, At, B0); PG8_BAR; PG8_SCHED;
            PG8_STAGE(PG8_SB(1, 1), b3 + hstepB, voffB);
            PG8_WAIT_V(6); PG8_BAR; PG8_MMA(1, 1, At, B1); PG8_BAR;
            }
        }
        if constexpr (ALIGN_EPI) { if (wr == 0) PG8_BAR; }
        if constexpr (!Epi::AFTER_DRAIN) { E(acc, cur, wr, wc, fr, fq); S.done(cur); }
        if (!has_next) break;
#pragma unroll
        for (int a = 0; a < 2; ++a)
#pragma unroll
            for (int b = 0; b < 2; ++b)
#pragma unroll
                for (int m = 0; m < 4; ++m)
#pragma unroll
                    for (int n = 0; n < 2; ++n) acc[a][b][m][n] = (f32x4){0.f, 0.f, 0.f, 0.f};
        cur = nxt; cA = nA; cB = nB; ++ui;
        if constexpr (ALIGN_EPI) { if (wr == 1) PG8_BAR; }
    }
    PG8_WAIT_V(0);
    if constexpr (!ALIGN_EPI) { if (wr == 0) PG8_BAR; }
    PG8_BAR;
    if constexpr (Epi::AFTER_DRAIN) { E.fused(acc, cur, wr, wc, fr, fq, lds, wid, lane); S.done(cur); }
#undef PG8_SA
#undef PG8_SB
#undef PG8_STAGE
#undef PG8_LDA
#undef PG8_LDB
#undef PG8_MMA
#undef PG8_WAIT_V
#undef PG8_WAIT_L
#undef PG8_BAR
#undef PG8_SCHED
}
}
constexpr int NWAVES = 8;
constexpr int BATCH = 8, SEQ = 4096, D = 1024, M = BATCH * SEQ, NZ = 5888, FF = 4096, DEPTH = 2;
constexpr int C_AQ = 0, C_AK = 512, C_AV = 640, C_RQ = 768, C_RK = 1280, C_RV = 1792, C_RG = 2816, C_GA = 3840, C_GB = 4864;
constexpr int C_YA = 768, C_YB = 1792;
constexpr float EPS = 1e-6f;

constexpr size_t MiB = 1u << 20;
constexpr size_t WS_CTL = 0, CTL_ZERO_BYTES = 1 * MiB;
constexpr size_t WS_TABA = 1 * MiB, WS_TABR = 2 * MiB;
constexpr size_t WS_W = 4 * MiB;
constexpr size_t W_WIN = 0, W_WA = 6029312, W_WB = 6553600, W_WOUT = 7602176, W_WUP = 8650752, W_WDOWN = 12845056, W_LAYER = 17039360;
constexpr size_t WS_H = 69 * MiB;
constexpr size_t WS_Z = 133 * MiB;
constexpr size_t WS_END = 501 * MiB;
static_assert(WS_W + 2 * W_LAYER * 2 <= WS_H && WS_H + (size_t)M * D * 2 <= WS_Z && WS_Z + (size_t)M * NZ * 2 <= WS_END, "d_ws map");
constexpr int CW_BAR = 4096;

constexpr int RING_OFF = 0, RING_BYTES = 131072;
constexpr int LDSCTL_OFF = RING_BYTES, MISC_OFF = LDSCTL_OFF + 320;
constexpr int LDS_BYTES = 147456;

#define GAS __attribute__((address_space(1)))
#define LAS __attribute__((address_space(3)))
typedef unsigned short bf16;
typedef unsigned v4u __attribute__((ext_vector_type(4)));
typedef unsigned v2u __attribute__((ext_vector_type(2)));
typedef float f32x4 __attribute__((ext_vector_type(4)));
typedef float f32x2 __attribute__((ext_vector_type(2)));
#define LDS_WAIT() asm volatile("s_waitcnt lgkmcnt(0)" ::: "memory")
#define VM_WAIT() asm volatile("s_waitcnt vmcnt(0)" ::: "memory")
__device__ __forceinline__ unsigned f2bf(float f) { unsigned u = __builtin_bit_cast(unsigned, f); return (u + 0x7fffu + ((u >> 16) & 1u)) >> 16; }
__device__ __forceinline__ unsigned pk2(float lo, float hi) { return f2bf(lo) | (f2bf(hi) << 16); }
__device__ __forceinline__ float bf2f(unsigned short b) { return __builtin_bit_cast(float, (unsigned)b << 16); }
__device__ __forceinline__ float bflo(unsigned w) { return __builtin_bit_cast(float, w << 16); }
__device__ __forceinline__ float bfhi(unsigned w) { return __builtin_bit_cast(float, w & 0xffff0000u); }

#define XB_TMO      128
#define XB_XCNT(j)  (256  + 64 * (j))
#define XB_XSUB(j)  (1280 + 64 * (j))
#define XB_XGEN(j)  (2304 + 64 * (j))
#define XB_TOP      3328
#define XB_TOPGEN   3392
#define XCD_BAR_WORDS 3456
#define XB_SPIN_CAP (1u << 24)

__device__ __forceinline__ unsigned xb_ld(unsigned* p)              { return __hip_atomic_load(p, __ATOMIC_RELAXED, __HIP_MEMORY_SCOPE_AGENT); }
__device__ __forceinline__ unsigned xb_add(unsigned* p, unsigned v) { return __hip_atomic_fetch_add(p, v, __ATOMIC_RELAXED, __HIP_MEMORY_SCOPE_AGENT); }
__device__ __forceinline__ unsigned xb_xcc_id() { return (unsigned)__builtin_amdgcn_s_getreg((3 << 11) | 20) & 0xFu; }
#define XB_SPIN(cond, bar) do { unsigned _sp = 0; while (cond) { __builtin_amdgcn_s_sleep(1); \
    if ((++_sp & 255u) == 0u) { if (xb_ld(&(bar)[XB_TMO])) break; if (_sp > XB_SPIN_CAP) { atomicAdd(&(bar)[XB_TMO], 1u); break; } } } } while (0)

struct XcdBarrier { unsigned* bar; unsigned x; volatile LAS unsigned* st; };

__device__ __forceinline__ XcdBarrier xcd_barrier_post(unsigned* bar, volatile LAS unsigned* st) {
    XcdBarrier b; b.bar = bar; b.x = xb_xcc_id(); b.st = st;
    if (threadIdx.x == 0) (void)xb_add(&bar[XB_XCNT(b.x)], 1u);
    return b;
}
__device__ __forceinline__ void xcd_barrier_complete(unsigned* bar, unsigned x, unsigned& nloc, unsigned& nx) {
    const unsigned G = gridDim.x * gridDim.y * gridDim.z;
    unsigned sum, cnt, mine, sp = 0u;
    for (;;) {
        sum = 0u; cnt = 0u; mine = 0u;
#pragma unroll 1
        for (unsigned j = 0; j < 16; ++j) { const unsigned c = xb_ld(&bar[XB_XCNT(j)]); sum += c; cnt += (c > 0u) ? 1u : 0u; mine = (j == x) ? c : mine; }
        if (sum == G) break;
        __builtin_amdgcn_s_sleep(1);
        if ((++sp & 255u) == 0u) { if (xb_ld(&bar[XB_TMO])) break; if (sp > XB_SPIN_CAP) { atomicAdd(&bar[XB_TMO], 1u); break; } }
    }
    nloc = mine > 0u ? mine : 1u; nx = cnt > 0u ? cnt : 1u;
}
__device__ __forceinline__ void xcd_barrier_census(const XcdBarrier& b) {
    if (threadIdx.x == 0) { unsigned nloc, nx; xcd_barrier_complete(b.bar, b.x, nloc, nx); b.st[0] = nloc; b.st[1] = nx; }
    __syncthreads();
}
__device__ __forceinline__ void xcd_barrier(const XcdBarrier& b) {
    asm volatile("s_waitcnt vmcnt(0)" ::: "memory");
    __syncthreads();
    if (threadIdx.x == 0) {
        unsigned* bar = b.bar;
        __builtin_amdgcn_s_waitcnt(0);
        const unsigned nloc = b.st[0], nx = b.st[1];
        const unsigned old = xb_add(&bar[XB_XSUB(b.x)], 1u);
        const unsigned gen = old / nloc;
        if (old + 1u == (gen + 1u) * nloc) {
            __builtin_amdgcn_fence(__ATOMIC_RELEASE, "agent");
            asm volatile("s_waitcnt vmcnt(0)" ::: "memory");
            const unsigned og = xb_add(&bar[XB_TOP], 1u);
            const unsigned tg = og / nx;
            if (og + 1u == (tg + 1u) * nx) xb_add(&bar[XB_TOPGEN], 1u);
            else XB_SPIN(xb_ld(&bar[XB_TOPGEN]) == tg, bar);
            __builtin_amdgcn_fence(__ATOMIC_ACQUIRE, "agent");
            xb_add(&bar[XB_XGEN(b.x)], 1u);
            asm volatile("s_waitcnt vmcnt(0)" ::: "memory");
        } else {
            XB_SPIN(xb_ld(&bar[XB_XGEN(b.x)]) == gen, bar);
            __builtin_amdgcn_fence(__ATOMIC_ACQUIRE, "agent");
            asm volatile("s_waitcnt vmcnt(0)" ::: "memory");
        }
    }
    __syncthreads();
}

__device__ __forceinline__ float wave_sum(float v) {
#pragma unroll
    for (int o = 1; o < 64; o <<= 1) v += __shfl_xor(v, o);
    return v;
}
__device__ __forceinline__ void p0_transpose_item(const float* W, int K, int N, bf16* WT, LAS float* scr, int item, int lane) {
    const int nblk = N / 32, kb = item / nblk, nb = item % nblk, k0 = 64 * kb, n0 = 32 * nb;
#pragma unroll 8
    for (int i = 0; i < 32; ++i) { const int kk = 2 * i + (lane >> 5); scr[kk * 33 + (lane & 31)] = W[(size_t)(k0 + kk) * N + n0 + (lane & 31)]; }
    LDS_WAIT(); asm volatile("" ::: "memory");
    const int c = lane & 7;
#pragma unroll
    for (int j = 0; j < 4; ++j) { const int n = (lane >> 3) + 8 * j; const LAS float* s = scr + (8 * c) * 33 + n;
        v4u o; o.x = pk2(s[0 * 33], s[1 * 33]); o.y = pk2(s[2 * 33], s[3 * 33]); o.z = pk2(s[4 * 33], s[5 * 33]); o.w = pk2(s[6 * 33], s[7 * 33]);
        *(GAS v4u*)(WT + (size_t)(n0 + n) * K + k0 + 8 * c) = o; }
    LDS_WAIT(); asm volatile("" ::: "memory");
}
struct Ctx {
    LAS unsigned char* lds;
    int tid, lane, wave, vcu, G;
    const float* in[11]; float* out; unsigned char* ws;
};
#define CTXP const Ctx& F

__device__ __forceinline__ bf16* wsl(CTXP, int l, size_t off) { return (bf16*)(F.ws + WS_W) + (size_t)l * W_LAYER + off; }

__device__ __forceinline__ void phase_prologue(CTXP) {
    LAS float* scr = (LAS float*)(F.lds + RING_OFF + F.wave * 16384);
    const int gw = F.vcu * NWAVES + F.wave, NGW = F.G * NWAVES;
    constexpr int I_IN = (D / 64) * (NZ / 32), I_A = (512 / 64) * (D / 32), I_B = (D / 64) * (D / 32), I_O = I_B, I_U = (D / 64) * (FF / 32), I_D = (FF / 64) * (D / 32);
    constexpr int I_LAYER = I_IN + I_A + I_B + I_O + I_U + I_D;
    for (int it = gw; it < DEPTH * I_LAYER; it += NGW) {
        const int l = it / I_LAYER; int r = it % I_LAYER;
        if (r < I_IN) { p0_transpose_item(F.in[2] + (size_t)l * D * NZ, D, NZ, wsl(F, l, W_WIN), scr, r, F.lane); continue; } r -= I_IN;
        if (r < I_A) { p0_transpose_item(F.in[4] + (size_t)l * 512 * D, 512, D, wsl(F, l, W_WA), scr, r, F.lane); continue; } r -= I_A;
        if (r < I_B) { p0_transpose_item(F.in[5] + (size_t)l * D * D, D, D, wsl(F, l, W_WB), scr, r, F.lane); continue; } r -= I_B;
        if (r < I_O) { p0_transpose_item(F.in[6] + (size_t)l * D * D, D, D, wsl(F, l, W_WOUT), scr, r, F.lane); continue; } r -= I_O;
        if (r < I_U) { p0_transpose_item(F.in[8] + (size_t)l * D * FF, D, FF, wsl(F, l, W_WUP), scr, r, F.lane); continue; } r -= I_U;
        p0_transpose_item(F.in[9] + (size_t)l * FF * D, FF, D, wsl(F, l, W_WDOWN), scr, r, F.lane);
    }
    f32x2* tabA = (f32x2*)(F.ws + WS_TABA); f32x2* tabR = (f32x2*)(F.ws + WS_TABR);
    const int gt = (F.vcu * NWAVES + F.wave) * 64 + F.lane, NGT = F.G * NWAVES * 64;
    for (int idx = gt; idx < SEQ * 96; idx += NGT) {
        const int pos = idx / 96, j = idx % 96;
        const float ex = (j < 32) ? (float)j * (1.f / 32.f) : (float)(j - 32) * (1.f / 63.f);
        const float inv = exp2f(-ex * 13.287712379549449f);
        const float ang = (float)pos * inv;
        float s, c; sincosf(ang, &s, &c);
        const f32x2 v = {c, s};
        if (j < 32) tabA[pos * 32 + j] = v; else tabR[pos * 64 + (j - 32)] = v;
    }
}

__device__ __forceinline__ void phase_rms_bf16(CTXP, const float* x, const float* g, bf16* H) {
    const int gw = F.vcu * NWAVES + F.wave, NGW = F.G * NWAVES;
    const f32x4* g4 = (const f32x4*)g + F.lane;
    for (int m = gw; m < M; m += NGW) {
        const f32x4* xr = (const f32x4*)(x + (size_t)m * D) + F.lane;
        f32x4 v[4]; float s = 0.f;
#pragma unroll
        for (int j = 0; j < 4; ++j) { v[j] = xr[64 * j]; s += (v[j].x * v[j].x + v[j].y * v[j].y) + (v[j].z * v[j].z + v[j].w * v[j].w); }
        const float rstd = 1.f / sqrtf(wave_sum(s) * (1.f / D) + EPS);
        unsigned long long* o8 = (unsigned long long*)(H + (size_t)m * D) + F.lane;
#pragma unroll
        for (int j = 0; j < 4; ++j) { const f32x4 gg = g4[64 * j];
            o8[64 * j] = (unsigned long long)pk2(v[j].x * rstd * gg.x, v[j].y * rstd * gg.y) | ((unsigned long long)pk2(v[j].z * rstd * gg.z, v[j].w * rstd * gg.w) << 32); }
    }
}
__device__ __forceinline__ void phase_rms_final(CTXP, float* x, const float* g) {
    const int gw = F.vcu * NWAVES + F.wave, NGW = F.G * NWAVES;
    const f32x4* g4 = (const f32x4*)g + F.lane;
    for (int m = gw; m < M; m += NGW) {
        f32x4* xr = (f32x4*)(x + (size_t)m * D) + F.lane;
        f32x4 v[4]; float s = 0.f;
#pragma unroll
        for (int j = 0; j < 4; ++j) { v[j] = xr[64 * j]; s += (v[j].x * v[j].x + v[j].y * v[j].y) + (v[j].z * v[j].z + v[j].w * v[j].w); }
        const float rstd = 1.f / sqrtf(wave_sum(s) * (1.f / D) + EPS);
#pragma unroll
        for (int j = 0; j < 4; ++j) { const f32x4 gg = g4[64 * j]; xr[64 * j] = v[j] * rstd * gg; }
    }
}

__device__ __forceinline__ void phase_rotary(CTXP, bf16* z) {
    const f32x2* tabA = (const f32x2*)(F.ws + WS_TABA); const f32x2* tabR = (const f32x2*)(F.ws + WS_TABR);
    const long gt = (long)(F.vcu * NWAVES + F.wave) * 64 + F.lane, NGT = (long)F.G * NWAVES * 64;
    for (long idx = gt; idx < (long)M * 832; idx += NGT) {
        const int m = (int)(idx / 832), p = (int)(idx % 832), pos = m % SEQ;
        int c1, c2; f32x2 cs; float sc = 1.f;
        if (p < 256)      { const int h = p / 32, i = p % 32; c1 = C_AQ + 64 * h + i; c2 = c1 + 32; cs = tabA[pos * 32 + i]; }
        else if (p < 320) { const int pp = p - 256, h = pp / 32, i = pp % 32; c1 = C_AK + 64 * h + i; c2 = c1 + 32; cs = tabA[pos * 32 + i]; }
        else if (p < 576) { const int pp = p - 320, h = pp / 64, i = pp % 64; c1 = C_RQ + 128 * h + 2 * i; c2 = c1 + 1; cs = tabR[pos * 64 + i]; }
        else              { const int pp = p - 576, h = pp / 64, i = pp % 64; c1 = C_RK + 128 * h + 2 * i; c2 = c1 + 1; cs = tabR[pos * 64 + i]; sc = 0.08838834764831845f; }
        bf16* zr = z + (size_t)m * NZ;
        const float x1 = bf2f(zr[c1]), x2 = bf2f(zr[c2]);
        zr[c1] = (bf16)f2bf((x1 * cs.x - x2 * cs.y) * sc); zr[c2] = (bf16)f2bf((x2 * cs.x + x1 * cs.y) * sc);
    }
}

__device__ __forceinline__ void phase_attn_naive(CTXP, bf16* z, const float* sinks) {
    const int gw = F.vcu * NWAVES + F.wave, NGW = F.G * NWAVES;
    for (int u = gw; u < BATCH * 64 * 8; u += NGW) {
        const int h = u % 8, tb = (u / 8) % 64, b = u / 512, g = h / 4;
        const int t = tb * 64 + F.lane; const size_t m = (size_t)b * SEQ + t;
        float q[64], o[64];
        { const v4u* qp = (const v4u*)(z + m * NZ + C_AQ + 64 * h);
#pragma unroll
          for (int c = 0; c < 8; ++c) { const v4u w = qp[c];
              q[8 * c + 0] = bflo(w.x) * 0.125f; q[8 * c + 1] = bfhi(w.x) * 0.125f; q[8 * c + 2] = bflo(w.y) * 0.125f; q[8 * c + 3] = bfhi(w.y) * 0.125f;
              q[8 * c + 4] = bflo(w.z) * 0.125f; q[8 * c + 5] = bfhi(w.z) * 0.125f; q[8 * c + 6] = bflo(w.w) * 0.125f; q[8 * c + 7] = bfhi(w.w) * 0.125f; } }
#pragma unroll
        for (int d = 0; d < 64; ++d) o[d] = 0.f;
        float mr = sinks[h], l = 1.f;
        const int k0 = (tb * 64 - 127) > 0 ? (tb * 64 - 127) : 0, k1 = tb * 64 + 63;
        for (int kk = k0; kk <= k1; ++kk) {
            const bf16* krow = z + ((size_t)b * SEQ + kk) * NZ + C_AK + 64 * g;
            const bf16* vrow = z + ((size_t)b * SEQ + kk) * NZ + C_AV + 64 * g;
            float s = 0.f;
#pragma unroll
            for (int c = 0; c < 8; ++c) { const v4u w = ((const v4u*)krow)[c];
                s += q[8 * c + 0] * bflo(w.x) + q[8 * c + 1] * bfhi(w.x) + q[8 * c + 2] * bflo(w.y) + q[8 * c + 3] * bfhi(w.y)
                   + q[8 * c + 4] * bflo(w.z) + q[8 * c + 5] * bfhi(w.z) + q[8 * c + 6] * bflo(w.w) + q[8 * c + 7] * bfhi(w.w); }
            const bool valid = (kk <= t) && (kk >= t - 127);
            if (valid) {
                const float mn = fmaxf(mr, s), corr = __expf(mr - mn), p = __expf(s - mn);
                l = l * corr + p; mr = mn;
#pragma unroll
                for (int c = 0; c < 8; ++c) { const v4u w = ((const v4u*)vrow)[c];
                    o[8 * c + 0] = o[8 * c + 0] * corr + p * bflo(w.x); o[8 * c + 1] = o[8 * c + 1] * corr + p * bfhi(w.x);
                    o[8 * c + 2] = o[8 * c + 2] * corr + p * bflo(w.y); o[8 * c + 3] = o[8 * c + 3] * corr + p * bfhi(w.y);
                    o[8 * c + 4] = o[8 * c + 4] * corr + p * bflo(w.z); o[8 * c + 5] = o[8 * c + 5] * corr + p * bfhi(w.z);
                    o[8 * c + 6] = o[8 * c + 6] * corr + p * bflo(w.w); o[8 * c + 7] = o[8 * c + 7] * corr + p * bfhi(w.w); }
            }
        }
        const float rl = 1.f / l;
        v4u* op = (v4u*)(z + m * NZ + C_AQ + 64 * h);
#pragma unroll
        for (int c = 0; c < 8; ++c) { v4u w; w.x = pk2(o[8 * c + 0] * rl, o[8 * c + 1] * rl); w.y = pk2(o[8 * c + 2] * rl, o[8 * c + 3] * rl);
            w.z = pk2(o[8 * c + 4] * rl, o[8 * c + 5] * rl); w.w = pk2(o[8 * c + 6] * rl, o[8 * c + 7] * rl); op[c] = w; }
    }
}

__device__ __forceinline__ void phase_ret_scan_naive(CTXP, const bf16* z, bf16* RP) {
    const int gt = (F.vcu * NWAVES + F.wave) * 64 + F.lane, NGT = F.G * NWAVES * 64;
    for (int idx = gt; idx < BATCH * 4 * 128 * 64; idx += NGT) {
        const int e0 = idx % 64, d = (idx / 64) % 128, h = (idx / 8192) % 4, b = idx / 32768;
        const float gamma = 1.f - exp2f(-5.f - (float)h);
        float S0 = 0.f, S1 = 0.f, S2 = 0.f, S3 = 0.f;
        const bf16* zk = z + (size_t)b * SEQ * NZ + C_RK + 128 * h + d;
        const bf16* zv = z + (size_t)b * SEQ * NZ + C_RV + 256 * h + e0;
        bf16* rp = RP + ((size_t)(b * 4 + h) * 32) * 32768 + d * 256 + e0;
        for (int n = 0; n < 32; ++n) {
            rp[0] = (bf16)f2bf(S0); rp[64] = (bf16)f2bf(S1); rp[128] = (bf16)f2bf(S2); rp[192] = (bf16)f2bf(S3); rp += 32768;
#pragma unroll 4
            for (int j = 0; j < 128; ++j) {
                const float kd = bf2f(*zk); const float v0 = bf2f(zv[0]), v1 = bf2f(zv[64]), v2 = bf2f(zv[128]), v3 = bf2f(zv[192]);
                S0 = gamma * S0 + kd * v0; S1 = gamma * S1 + kd * v1; S2 = gamma * S2 + kd * v2; S3 = gamma * S3 + kd * v3;
                zk += NZ; zv += NZ;
            }
        }
    }
}

__device__ __forceinline__ void phase_ret_out_naive(CTXP, bf16* z, const bf16* RP) {
    LAS float* Sl = (LAS float*)(F.lds + RING_OFF);
    LAS float* rowsq = (LAS float*)(F.lds + RING_OFF + 32768);
    const int tid = F.tid;
    for (int unit = F.vcu; unit < BATCH * 4 * 32 * 2; unit += F.G) {
        const int half = unit & 1, n = (unit >> 1) & 31, h = (unit >> 6) & 3, b = unit >> 8;
        const size_t m0 = (size_t)b * SEQ + n * 128;
        const float log2g = log2f(1.f - exp2f(-5.f - (float)h));
        {
            const int j = tid & 127, ig = tid >> 7;
            unsigned kreg[64];
            { const v4u* kp = (const v4u*)(z + (m0 + j) * NZ + C_RK + 128 * h);
#pragma unroll
              for (int c = 0; c < 16; ++c) { const v4u w = kp[c]; kreg[4 * c] = w.x; kreg[4 * c + 1] = w.y; kreg[4 * c + 2] = w.z; kreg[4 * c + 3] = w.w; } }
            for (int r = 0; r < 16; ++r) {
                const int i = ig + 4 * r, iglob = 64 * half + i;
                float s = 0.f;
                if (j <= iglob) {
                    const v4u* qp = (const v4u*)(z + (m0 + iglob) * NZ + C_RQ + 128 * h);
#pragma unroll
                    for (int c = 0; c < 16; ++c) { const v4u w = qp[c];
                        s += bflo(w.x) * bflo(kreg[4 * c]) + bfhi(w.x) * bfhi(kreg[4 * c]) + bflo(w.y) * bflo(kreg[4 * c + 1]) + bfhi(w.y) * bfhi(kreg[4 * c + 1])
                           + bflo(w.z) * bflo(kreg[4 * c + 2]) + bfhi(w.z) * bfhi(kreg[4 * c + 2]) + bflo(w.w) * bflo(kreg[4 * c + 3]) + bfhi(w.w) * bfhi(kreg[4 * c + 3]); }
                    s *= exp2f(log2g * (float)(iglob - j));
                }
                Sl[i * 128 + j] = s;
            }
            if (tid < 64) rowsq[tid] = 0.f;
        }
        __syncthreads();
        {
            const int e = tid & 255, rgp = tid >> 8;
            float acc[32], acc2[32];
#pragma unroll
            for (int rr = 0; rr < 32; ++rr) { acc[rr] = 0.f; acc2[rr] = 0.f; }
            const bf16* vp = z + m0 * NZ + C_RV + 256 * h + e;
            for (int j = 0; j < 128; ++j) {
                const float v = bf2f(vp[(size_t)j * NZ]);
#pragma unroll
                for (int rr = 0; rr < 32; ++rr) acc[rr] += Sl[(rgp * 32 + rr) * 128 + j] * v;
            }
            const bf16* rp = RP + ((size_t)((b * 4 + h) * 32 + n)) * 32768 + e;
            const bf16* qb = z + (m0 + 64 * half + rgp * 32) * NZ + C_RQ + 128 * h;
            for (int d = 0; d < 128; d += 2) {
                const float r0 = bf2f(rp[(size_t)d * 256]), r1 = bf2f(rp[(size_t)(d + 1) * 256]);
#pragma unroll
                for (int rr = 0; rr < 32; ++rr) { const unsigned w = *(const unsigned*)(qb + (size_t)rr * NZ + d); acc2[rr] += bflo(w) * r0 + bfhi(w) * r1; }
            }
#pragma unroll
            for (int rr = 0; rr < 32; ++rr) {
                const int iglob = 64 * half + rgp * 32 + rr;
                const float r = acc[rr] + exp2f(log2g * (float)(iglob + 1)) * acc2[rr];
                acc[rr] = r;
                const float ss = wave_sum(r * r);
                if (F.lane == 0) atomicAdd((float*)(rowsq + rgp * 32 + rr), ss);
            }
            __syncthreads();
#pragma unroll
            for (int rr = 0; rr < 32; ++rr) {
                const int iglob = 64 * half + rgp * 32 + rr;
                const float rstd = 1.f / sqrtf(rowsq[rgp * 32 + rr] * (1.f / 256.f) + EPS);
                bf16* gp = z + (m0 + iglob) * NZ + C_RG + 256 * h + e;
                const float gv = bf2f(*gp);
                const float sil = gv / (1.f + __expf(-gv));
                *gp = (bf16)f2bf(acc[rr] * rstd * sil);
            }
        }
        __syncthreads();
    }
}

__device__ __forceinline__ void phase_merge_naive(CTXP, bf16* z) {
    const long gt = (long)(F.vcu * NWAVES + F.wave) * 64 + F.lane, NGT = (long)F.G * NWAVES * 64;
    for (long idx = gt; idx < (long)M * (D / 8); idx += NGT) {
        const size_t m = (size_t)(idx / (D / 8)); const int c = (int)(idx % (D / 8)) * 8;
        bf16* zr = z + m * NZ;
        const v4u ya = *(const v4u*)(zr + C_YA + c), yb = *(const v4u*)(zr + C_YB + c), ga = *(const v4u*)(zr + C_GA + c), gb = *(const v4u*)(zr + C_GB + c);
        v4u o;
#define MRG(A, B, GA_, GB_, LOHI) ((1.f / (1.f + __expf(-LOHI(GA_)))) * LOHI(A) + (1.f / (1.f + __expf(-LOHI(GB_)))) * LOHI(B))
        o.x = pk2(MRG(ya.x, yb.x, ga.x, gb.x, bflo), MRG(ya.x, yb.x, ga.x, gb.x, bfhi));
        o.y = pk2(MRG(ya.y, yb.y, ga.y, gb.y, bflo), MRG(ya.y, yb.y, ga.y, gb.y, bfhi));
        o.z = pk2(MRG(ya.z, yb.z, ga.z, gb.z, bflo), MRG(ya.z, yb.z, ga.z, gb.z, bfhi));
        o.w = pk2(MRG(ya.w, yb.w, ga.w, gb.w, bflo), MRG(ya.w, yb.w, ga.w, gb.w, bfhi));
#undef MRG
        *(v4u*)(zr + C_GA + c) = o;
    }
}
#ifndef MK_PER_PHASE
#define MK_PER_PHASE 0
#endif
constexpr int NPH = 1 + DEPTH * 11 + 1;
struct Args { const float* in[11]; float* out; unsigned char* ws; int ph_lo, ph_hi; };
typedef __attribute__((address_space(4))) const Args CArgs;
__global__ void __launch_bounds__(NWAVES * 64, 2) mega_fwd(Args args) {
    extern __shared__ __attribute__((aligned(16))) unsigned char lds[];
    volatile LAS unsigned* MISC = (volatile LAS unsigned*)((LAS unsigned char*)lds + MISC_OFF);
    for (int u = threadIdx.x; u < (LDS_BYTES - LDSCTL_OFF) / 4; u += NWAVES * 64) ((LAS unsigned*)((LAS unsigned char*)lds + LDSCTL_OFF))[u] = 0u;
    __syncthreads();
    const int lo = args.ph_lo, hi = args.ph_hi;
    unsigned* ctl = (unsigned*)(args.ws + WS_CTL);
    XcdBarrier bar; bar.bar = ctl + CW_BAR; bar.x = 0; bar.st = nullptr;
    if (hi - lo > 1) { bar = xcd_barrier_post(ctl + CW_BAR, MISC + 8); xcd_barrier_census(bar); }
#pragma unroll 1
    for (int ph = lo; ph < hi; ++ph) {
        CArgs* ap = (CArgs*)__builtin_amdgcn_kernarg_segment_ptr(); asm volatile("" : "+s"(ap));
        int tid = threadIdx.x; asm volatile("" : "+v"(tid));
        Ctx F;
        F.lds = (LAS unsigned char*)lds;
        F.tid = tid; F.lane = tid & 63; F.wave = __builtin_amdgcn_readfirstlane(tid >> 6);
        F.G = gridDim.x; { const int bx = blockIdx.x; F.vcu = (F.G % 8 == 0) ? (bx % 8) * (F.G / 8) + bx / 8 : bx; }
#pragma unroll
        for (int i = 0; i < 11; ++i) F.in[i] = ap->in[i];
        F.out = ap->out; F.ws = ap->ws;
        bf16* const H = (bf16*)(F.ws + WS_H);
        bf16* const Z = (bf16*)(F.ws + WS_Z);
        const int bx = (int)blockIdx.x;
        if (ph == 0) phase_prologue(F);
        else if (ph == NPH - 1) phase_rms_final(F, F.out, F.in[10]);
        else {
            const int l = (ph - 1) / 11, k = (ph - 1) % 11;
            const float* xcur = (l == 0) ? F.in[0] : (const float*)F.out;
            switch (k) {
            case 0: phase_rms_bf16(F, xcur, F.in[1] + l * D, H); break;
            case 1: { pg8::Gemm<M, NZ, D, D> g{H, wsl(F, l, W_WIN)}; pg8::StaticOrder<M, NZ> S; S.init(F.G, bx);
                      pg8::EpiBf16<0> E{Z, NZ}; pg8::gemm_phase<pg8::EpiBf16<0>, pg8::StaticOrder<M, NZ>, true, true>(F.lds + RING_OFF, g, S, E); } break;
            case 2: phase_rotary(F, Z); break;
            case 3: phase_attn_naive(F, Z, F.in[3] + l * 8); phase_ret_scan_naive(F, Z, H); break;
            case 4: phase_ret_out_naive(F, Z, H); break;
            case 5: { { pg8::Gemm<M, D, 512, NZ> g{Z + C_AQ, wsl(F, l, W_WA)}; pg8::StaticOrder<M, D> S; S.init(F.G, bx);
                        pg8::EpiBf16<0> E{Z + C_YA, NZ}; pg8::gemm_phase<pg8::EpiBf16<0>, pg8::StaticOrder<M, D>, true, true>(F.lds + RING_OFF, g, S, E); }
                      { pg8::Gemm<M, D, D, NZ> g{Z + C_RG, wsl(F, l, W_WB)}; pg8::StaticOrder<M, D> S; S.init(F.G, bx);
                        pg8::EpiBf16<0> E{Z + C_YB, NZ}; pg8::gemm_phase<pg8::EpiBf16<0>, pg8::StaticOrder<M, D>, true, true>(F.lds + RING_OFF, g, S, E); } } break;
            case 6: phase_merge_naive(F, Z); break;
            case 7: { pg8::Gemm<M, D, D, NZ> g{Z + C_GA, wsl(F, l, W_WOUT)}; pg8::StaticOrder<M, D> S; S.init(F.G, bx);
                      pg8::EpiResF32 E{xcur, F.out, D}; pg8::gemm_phase<pg8::EpiResF32, pg8::StaticOrder<M, D>, true, true>(F.lds + RING_OFF, g, S, E); } break;
            case 8: phase_rms_bf16(F, F.out, F.in[7] + l * D, H); break;
            case 9: { pg8::Gemm<M, FF, D, D> g{H, wsl(F, l, W_WUP)}; pg8::StaticOrder<M, FF> S; S.init(F.G, bx);
                      pg8::EpiBf16<2> E{Z, FF}; pg8::gemm_phase<pg8::EpiBf16<2>, pg8::StaticOrder<M, FF>, true, true>(F.lds + RING_OFF, g, S, E); } break;
            default: { pg8::Gemm<M, D, FF, FF> g{Z, wsl(F, l, W_WDOWN)}; pg8::StaticOrder<M, D> S; S.init(F.G, bx);
                      pg8::EpiResF32 E{F.out, F.out, D}; pg8::gemm_phase<pg8::EpiResF32, pg8::StaticOrder<M, D>, true, true>(F.lds + RING_OFF, g, S, E); } break;
            }
        }
        if (ph + 1 < hi) xcd_barrier(bar);
    }
}

extern "C" void kernel_launch(void* const* d_in, const int* in_sizes, int n_in, void* d_out, int out_size, void* d_ws, size_t ws_size, hipStream_t stream) {
    static int grid = 0;
    if (grid == 0) {
        if (n_in != 11 || in_sizes[0] != M * D || out_size != M * D || ws_size < WS_END) {
            fprintf(stderr, "kernel_launch: unexpected shapes: n_in %d in0 %d out %d ws %zu (need %zu)\n", n_in, n_in > 0 ? in_sizes[0] : -1, out_size, ws_size, (size_t)WS_END); grid = -1; return; }
        int dev = 0, cus = 0, per_cu = 0;
        if (hipGetDevice(&dev) != hipSuccess || hipDeviceGetAttribute(&cus, hipDeviceAttributeMultiprocessorCount, dev) != hipSuccess) { grid = -1; return; }
        if (hipFuncSetAttribute((const void*)mega_fwd, hipFuncAttributeMaxDynamicSharedMemorySize, LDS_BYTES) != hipSuccess) { fprintf(stderr, "kernel_launch: hipFuncSetAttribute failed\n"); grid = -1; return; }
        if (hipOccupancyMaxActiveBlocksPerMultiprocessor(&per_cu, (const void*)mega_fwd, NWAVES * 64, LDS_BYTES) != hipSuccess || per_cu < 1)
            fprintf(stderr, "kernel_launch: occupancy query reports %d workgroups per CU\n", per_cu);
        (void)hipGetLastError();
        grid = cus;
    }
    if (grid < 0) return;
    if (hipMemsetAsync((char*)d_ws + WS_CTL, 0, CTL_ZERO_BYTES, stream) != hipSuccess) return;
    Args a{};
    for (int i = 0; i < 11; ++i) a.in[i] = (const float*)d_in[i];
    a.out = (float*)d_out; a.ws = (unsigned char*)d_ws;
#if MK_PER_PHASE
    for (int p = 0; p < NPH; ++p) { a.ph_lo = p; a.ph_hi = p + 1; hipLaunchKernelGGL(mega_fwd, dim3(grid), dim3(NWAVES * 64), LDS_BYTES, stream, a); }
#else
    a.ph_lo = 0; a.ph_hi = NPH;
    hipLaunchKernelGGL(mega_fwd, dim3(grid), dim3(NWAVES * 64), LDS_BYTES, stream, a);
#endif
}
```

```cpp
#include <hip/hip_runtime.h>
#include <cstdio>
#include <cstdint>
namespace pg8 {
#define PG8_LAS __attribute__((address_space(3)))
typedef unsigned short bf16_t;
typedef short bf16x8 __attribute__((ext_vector_type(8)));
typedef float f32x4 __attribute__((ext_vector_type(4)));
typedef float f32x2 __attribute__((ext_vector_type(2)));
typedef unsigned u32x4 __attribute__((ext_vector_type(4)));
constexpr int BM = 256, BK = 64, HALF = 128, HTB = HALF * BK * 2  , STAGE_BYTES = 8 * HTB, NXCD = 8, WGM = 8;

__host__ __device__ __forceinline__ int lds_byte(int r, int c) { const int st = (r >> 4) * 2 + (c >> 5), rr = r & 15, cc = c & 31, ob = rr * 64 + cc * 2; return st * 1024 + (ob ^ (((ob >> 9) & 1) << 5)); }
__host__ __device__ __forceinline__ void stage_rc(int b, int& R, int& C) { const int st = b / 1024, sb = b % 1024, swz = sb ^ (((sb >> 9) & 1) << 5); R = (st >> 1) * 16 + swz / 64; C = (st & 1) * 32 + (swz % 64) / 2; }
__host__ __device__ __forceinline__ int perm32(int rho) { const int n = rho >> 4, i = rho & 15; return 8 * (i >> 2) + 4 * n + (i & 3); }

struct Unit { int pm, pn; };
template <int M_, int N_, int K_, int LDA_> struct Gemm { const bf16_t* A; const bf16_t* Bt; static constexpr int M = M_, N = N_, K = K_, lda = LDA_; };

template <int M_, int N_> struct StaticOrder {
    static constexpr int nM = M_ / BM, nN = N_ / BM, nwg = nM * nN; int G, c;
    __host__ __device__ void init(int G_, int c_) { G = G_; c = c_; }
    __host__ __device__ bool next(int i, Unit& u) const {
        const long L = (long)i * G + c; if (L >= nwg) return false;
        int wgid = (int)L; { const int q = nwg / NXCD, r = nwg % NXCD, xcd = wgid % NXCD, off = wgid / NXCD; wgid = (xcd < r ? xcd * (q + 1) : r * (q + 1) + (xcd - r) * q) + off; }
        const int nig = WGM * nN, gid = wgid / nig, fm = gid * WGM, gsz = (nM - fm) < WGM ? (nM - fm) : WGM;
        u.pm = fm + ((wgid % nig) % gsz); u.pn = (wgid % nig) / gsz; return true;
    }
    __device__ __forceinline__ void a_ready(const Unit&) const {}
    __device__ __forceinline__ void done(const Unit&) const {}
};

__device__ __forceinline__ unsigned cvt_pk_bf16(float lo, float hi) { unsigned r; asm volatile("v_cvt_pk_bf16_f32 %0, %1, %2" : "=v"(r) : "v"(lo), "v"(hi)); return r; }

template <int ACT  > struct EpiBf16 {
    static constexpr bool PERM = true, AFTER_DRAIN = false;
    bf16_t* O; int ldc;
    __device__ __forceinline__ void operator()(const f32x4 (&acc)[2][2][4][2], const Unit& u, int wr, int wc, int fr, int fq) const {
        const int row0 = u.pm * BM + wr * 64 + fr; const int col0 = u.pn * BM + wc * 32 + 8 * fq;
#pragma unroll
        for (int ai = 0; ai < 2; ++ai)
#pragma unroll
            for (int m = 0; m < 4; ++m) { bf16_t* rowp = O + (size_t)(row0 + ai * HALF + m * 16) * ldc + col0;
#pragma unroll
                for (int bj = 0; bj < 2; ++bj) { f32x4 v0 = acc[ai][bj][m][0], v1 = acc[ai][bj][m][1];
                    if (ACT == 2) {
#pragma unroll
                        for (int i = 0; i < 4; ++i) { const float a = fmaxf(v0[i], 0.f), b = fmaxf(v1[i], 0.f); v0[i] = a * a; v1[i] = b * b; } }
                    u32x4 w; w.x = cvt_pk_bf16(v0[0], v0[1]); w.y = cvt_pk_bf16(v0[2], v0[3]); w.z = cvt_pk_bf16(v1[0], v1[1]); w.w = cvt_pk_bf16(v1[2], v1[3]);
                    *(u32x4*)(rowp + bj * HALF) = w; } }
    }
};
struct EpiResF32 {
    static constexpr bool PERM = false, AFTER_DRAIN = false;
    const float* base; float* out; int ldc;
    __device__ __forceinline__ void operator()(const f32x4 (&acc)[2][2][4][2], const Unit& u, int wr, int wc, int fr, int fq) const {
        const int col0 = u.pn * BM + wc * 32 + 4 * fq;
#pragma unroll
        for (int ai = 0; ai < 2; ++ai)
#pragma unroll
            for (int m = 0; m < 4; ++m) { const int r = ai * HALF + wr * 64 + m * 16 + fr; const size_t off = (size_t)(u.pm * BM + r) * ldc + col0;
#pragma unroll
                for (int bj = 0; bj < 2; ++bj)
#pragma unroll
                    for (int n = 0; n < 2; ++n) { const f32x4 bs = *(const f32x4*)(base + off + bj * HALF + n * 16); *(f32x4*)(out + off + bj * HALF + n * 16) = bs + acc[ai][bj][m][n]; } }
    }
};

template <class Epi, class Sched, bool ALIGN_EPI, bool SP2, class GemmT>
__device__ __forceinline__ void gemm_phase(PG8_LAS unsigned char* lds, const GemmT g, const Sched& S, const Epi& E) {
    int tid_ = threadIdx.x; asm volatile("" : "+v"(tid_));
    const int tid = tid_, wid = __builtin_amdgcn_readfirstlane(tid >> 6), lane = tid & 63, wr = wid >> 2, wc = wid & 3, fr = lane & 15, fq = lane >> 4;
    constexpr int K = GemmT::K, nt = K / BK, lda = GemmT::lda;
    unsigned voffA[2], voffB[2];
#pragma unroll
    for (int i = 0; i < 2; ++i) { int R, C; stage_rc(tid * 16 + i * 8192, R, C); const int Rb = Epi::PERM ? ((R & ~31) + perm32(R & 31)) : R;
        voffA[i] = (unsigned)(R * lda + C) * 2u; voffB[i] = (unsigned)(Rb * K + C) * 2u; }
    constexpr size_t kstep = (size_t)(BK * 2);
    constexpr size_t hstepA = (size_t)HALF * lda * 2, hstepB = (size_t)HALF * K * 2;
    constexpr size_t tstepA = 2 * hstepA, tstepB = 2 * hstepB;
    const unsigned ldsw = (unsigned)wid * 1024u;
    const int aoff = lds_byte(wr * 64 + fr, fq * 8), boff = lds_byte(wc * 32 + fr, fq * 8);
#define PG8_SA(b, h) (((b) * 2 + (h)) * HTB)
#define PG8_SB(b, h) ((4 + (b) * 2 + (h)) * HTB)
#define PG8_STAGE(bufoff, gbase, voff) do { _Pragma("unroll") for (int _i = 0; _i < 2; ++_i) \
        __builtin_amdgcn_global_load_lds((const unsigned*)((const char*)(gbase) + (voff)[_i]), (PG8_LAS unsigned*)(lds + (bufoff) + ldsw + _i * 8192), 16, 0, 0); } while (0)
#define PG8_LDA(dst, b, h) do { _Pragma("unroll") for (int m = 0; m < 4; ++m) _Pragma("unroll") for (int k = 0; k < 2; ++k) dst[m][k] = *(const PG8_LAS bf16x8*)(lds + PG8_SA(b, h) + aoff + m * 2048 + k * 1024); } while (0)
#define PG8_LDB(dst, b, h) do { _Pragma("unroll") for (int n = 0; n < 2; ++n) _Pragma("unroll") for (int k = 0; k < 2; ++k) dst[n][k] = *(const PG8_LAS bf16x8*)(lds + PG8_SB(b, h) + boff + n * 2048 + k * 1024); } while (0)
#define PG8_MMA(ai, bj, At, Bt) do { __builtin_amdgcn_s_setprio(1); _Pragma("unroll") for (int m = 0; m < 4; ++m) _Pragma("unroll") for (int n = 0; n < 2; ++n) _Pragma("unroll") for (int k = 0; k < 2; ++k) \
        acc[ai][bj][m][n] = __builtin_amdgcn_mfma_f32_16x16x32_bf16(Bt[n][k], At[m][k], acc[ai][bj][m][n], 0, 0, 0); __builtin_amdgcn_s_setprio(0); } while (0)
#define PG8_WAIT_V(n) asm volatile("s_waitcnt vmcnt(" #n ")" ::: "memory")
#define PG8_WAIT_L(n) asm volatile("s_waitcnt lgkmcnt(" #n ")" ::: "memory")
#define PG8_BAR __builtin_amdgcn_s_barrier()
#define PG8_SCHED __builtin_amdgcn_sched_barrier(0)
    Unit cur, nxt; int ui = 0;
    if (!S.next(0, cur)) return;
    f32x4 acc[2][2][4][2];
#pragma unroll
    for (int a = 0; a < 2; ++a)
#pragma unroll
        for (int b = 0; b < 2; ++b)
#pragma unroll
            for (int m = 0; m < 4; ++m)
#pragma unroll
                for (int n = 0; n < 2; ++n) acc[a][b][m][n] = (f32x4){0.f, 0.f, 0.f, 0.f};
    bf16x8 At[4][2], B0[2][2], B1[2][2];
    const char* cA = (const char*)g.A + (size_t)cur.pm * tstepA; const char* cB = (const char*)g.Bt + (size_t)cur.pn * tstepB;
    S.a_ready(cur);
    if constexpr (SP2) {
        PG8_STAGE(PG8_SB(0, 0), cB, voffB); PG8_STAGE(PG8_SB(0, 1), cB + hstepB, voffB); PG8_STAGE(PG8_SA(0, 0), cA, voffA); PG8_STAGE(PG8_SA(0, 1), cA + hstepA, voffA);
        if (wr == 1) PG8_BAR;
        PG8_WAIT_V(2); PG8_BAR;
        PG8_STAGE(PG8_SB(1, 0), cB + kstep, voffB); PG8_STAGE(PG8_SA(1, 0), cA + kstep, voffA); PG8_STAGE(PG8_SB(1, 1), cB + hstepB + kstep, voffB);
        PG8_WAIT_V(6); PG8_BAR;
    } else {
        PG8_STAGE(PG8_SB(0, 0), cB, voffB); PG8_STAGE(PG8_SA(0, 0), cA, voffA); PG8_STAGE(PG8_SB(0, 1), cB + hstepB, voffB); PG8_STAGE(PG8_SA(0, 1), cA + hstepA, voffA);
        if (wr == 1) PG8_BAR;
        PG8_WAIT_V(4); PG8_BAR;
        PG8_STAGE(PG8_SB(1, 0), cB + kstep, voffB); PG8_STAGE(PG8_SA(1, 0), cA + kstep, voffA); PG8_STAGE(PG8_SB(1, 1), cB + hstepB + kstep, voffB);
        PG8_WAIT_V(6); PG8_BAR;
    }
    for (;;) {
        const bool has_next = S.next(ui + 1, nxt);
        const char* nA = has_next ? (const char*)g.A + (size_t)nxt.pm * tstepA : cA; const char* nB = has_next ? (const char*)g.Bt + (size_t)nxt.pn * tstepB : cB;
#pragma unroll 1
        for (int t = 0; t < nt; t += 2) {
            const bool last = (t == nt - 2);
            const char* a1 = cA + (size_t)(t + 1) * kstep;
            const char* a2 = last ? nA : cA + (size_t)(t + 2) * kstep; const char* b2 = last ? nB : cB + (size_t)(t + 2) * kstep;
            const char* a3 = a2 + kstep; const char* b3 = b2 + kstep;
            if (last && has_next) S.a_ready(nxt);
            if constexpr (SP2) {
            PG8_LDB(B0, 0, 0); PG8_LDB(B1, 0, 1); PG8_SCHED; PG8_LDA(At, 0, 0); PG8_STAGE(PG8_SA(1, 1), a1 + hstepA, voffA);
            PG8_WAIT_V(8); PG8_WAIT_L(0); PG8_BAR; PG8_MMA(0, 0, At, B0); PG8_MMA(0, 1, At, B1); PG8_BAR; PG8_SCHED;
            PG8_LDA(At, 0, 1); PG8_STAGE(PG8_SB(0, 0), b2, voffB); PG8_STAGE(PG8_SB(0, 1), b2 + hstepB, voffB); PG8_STAGE(PG8_SA(0, 0), a2, voffA);
            PG8_WAIT_V(8); PG8_WAIT_L(0); PG8_BAR; PG8_MMA(1, 0, At, B0); PG8_MMA(1, 1, At, B1); PG8_BAR; PG8_SCHED;
            PG8_LDB(B0, 1, 0); PG8_LDB(B1, 1, 1); PG8_SCHED; PG8_LDA(At, 1, 0); PG8_STAGE(PG8_SA(0, 1), a2 + hstepA, voffA);
            PG8_WAIT_V(8); PG8_WAIT_L(0); PG8_BAR; PG8_MMA(0, 0, At, B0); PG8_MMA(0, 1, At, B1); PG8_BAR; PG8_SCHED;
            PG8_LDA(At, 1, 1); PG8_STAGE(PG8_SB(1, 0), b3, voffB); PG8_STAGE(PG8_SB(1, 1), b3 + hstepB, voffB); PG8_STAGE(PG8_SA(1, 0), a3, voffA);
            PG8_WAIT_V(8); PG8_WAIT_L(0); PG8_BAR; PG8_MMA(1, 0, At, B0); PG8_MMA(1, 1, At, B1); PG8_BAR; PG8_SCHED;
            } else {
            PG8_LDB(B0, 0, 0); PG8_SCHED; PG8_LDA(At, 0, 0); PG8_STAGE(PG8_SA(1, 1), a1 + hstepA, voffA);
            PG8_WAIT_L(8); PG8_BAR; PG8_WAIT_L(0); PG8_MMA(0, 0, At, B0); PG8_BAR; PG8_SCHED;
            PG8_LDB(B1, 0, 1); PG8_STAGE(PG8_SB(0, 0), b2, voffB);
            PG8_BAR; PG8_WAIT_L(0); PG8_MMA(0, 1, At, B1); PG8_BAR;
            PG8_LDA(At, 0, 1); PG8_STAGE(PG8_SA(0, 0), a2, voffA);
            PG8_BAR; PG8_WAIT_L(0); PG8_MMA(1, 0, At, B0); PG8_BAR; PG8_SCHED;
            PG8_STAGE(PG8_SB(0, 1), b2 + hstepB, voffB);
            PG8_WAIT_V(6); PG8_BAR; PG8_MMA(1, 1, At, B1); PG8_BAR;
            PG8_LDB(B0, 1, 0); PG8_SCHED; PG8_LDA(At, 1, 0); PG8_STAGE(PG8_SA(0, 1), a2 + hstepA, voffA);
            PG8_WAIT_L(8); PG8_BAR; PG8_WAIT_L(0); PG8_MMA(0, 0, At, B0); PG8_BAR; PG8_SCHED;
            PG8_LDB(B1, 1, 1); PG8_STAGE(PG8_SB(1, 0), b3, voffB);
            PG8_BAR; PG8_WAIT_L(0); PG8_MMA(0, 1, At, B1); PG8_BAR;
            PG8_LDA(At, 1, 1); PG8_STAGE(PG8_SA(1, 0), a3, voffA);
            PG8_BAR; PG8_WAIT_L(0); PG8_MMA(1, 0, At, B0); PG8_BAR; PG8_SCHED;
            PG8_STAGE(PG8_SB(1, 1), b3 + hstepB, voffB);
            PG8_WAIT_V(6); PG8_BAR; PG8_MMA(1, 1, At, B1); PG8_BAR;
            }
        }
        if constexpr (ALIGN_EPI) { if (wr == 0) PG8_BAR; }
        if constexpr (!Epi::AFTER_DRAIN) { E(acc, cur, wr, wc, fr, fq); S.done(cur); }
        if (!has_next) break;
#pragma unroll
        for (int a = 0; a < 2; ++a)
#pragma unroll
            for (int b = 0; b < 2; ++b)
#pragma unroll
                for (int m = 0; m < 4; ++m)
#pragma unroll
                    for (int n = 0; n < 2; ++n) acc[a][b][m][n] = (f32x4){0.f, 0.f, 0.f, 0.f};
        cur = nxt; cA = nA; cB = nB; ++ui;
        if constexpr (ALIGN_EPI) { if (wr == 1) PG8_BAR; }
    }
    PG8_WAIT_V(0);
    if constexpr (!ALIGN_EPI) { if (wr == 0) PG8_BAR; }
    PG8_BAR;
    if constexpr (Epi::AFTER_DRAIN) { E.fused(acc, cur, wr, wc, fr, fq, lds, wid, lane); S.done(cur); }
#undef PG8_SA
#undef PG8_SB
#undef PG8_STAGE
#undef PG8_LDA
#undef PG8_LDB
#undef PG8_MMA
#undef PG8_WAIT_V
#undef PG8_WAIT_L
#undef PG8_BAR
#undef PG8_SCHED
}
}
constexpr int NWAVES = 8;
constexpr int BATCH = 8, SEQ = 4096, D = 1024, M = BATCH * SEQ, NZ = 5888, FF = 4096, DEPTH = 2;
constexpr int C_AQ = 0, C_AK = 512, C_AV = 640, C_RQ = 768, C_RK = 1280, C_RV = 1792, C_RG = 2816, C_GA = 3840, C_GB = 4864;
constexpr int C_YA = 768, C_YB = 1792;
constexpr float EPS = 1e-6f;

constexpr size_t MiB = 1u << 20;
constexpr size_t WS_CTL = 0, CTL_ZERO_BYTES = 1 * MiB;
constexpr size_t WS_TABA = 1 * MiB, WS_TABR = 2 * MiB;
constexpr size_t WS_W = 4 * MiB;
constexpr size_t W_WIN = 0, W_WA = 6029312, W_WB = 6553600, W_WOUT = 7602176, W_WUP = 8650752, W_WDOWN = 12845056, W_LAYER = 17039360;
constexpr size_t WS_H = 69 * MiB;
constexpr size_t WS_Z = 133 * MiB;
constexpr size_t WS_END = 501 * MiB;
static_assert(WS_W + 2 * W_LAYER * 2 <= WS_H && WS_H + (size_t)M * D * 2 <= WS_Z && WS_Z + (size_t)M * NZ * 2 <= WS_END, "d_ws map");
constexpr int CW_BAR = 4096;

constexpr int RING_OFF = 0, RING_BYTES = 131072;
constexpr int LDSCTL_OFF = RING_BYTES, MISC_OFF = LDSCTL_OFF + 320;
constexpr int LDS_BYTES = 147456;

#define GAS __attribute__((address_space(1)))
#define LAS __attribute__((address_space(3)))
typedef unsigned short bf16;
typedef unsigned v4u __attribute__((ext_vector_type(4)));
typedef unsigned v2u __attribute__((ext_vector_type(2)));
typedef float f32x4 __attribute__((ext_vector_type(4)));
typedef float f32x2 __attribute__((ext_vector_type(2)));
#define LDS_WAIT() asm volatile("s_waitcnt lgkmcnt(0)" ::: "memory")
#define VM_WAIT() asm volatile("s_waitcnt vmcnt(0)" ::: "memory")
__device__ __forceinline__ unsigned f2bf(float f) { unsigned u = __builtin_bit_cast(unsigned, f); return (u + 0x7fffu + ((u >> 16) & 1u)) >> 16; }
__device__ __forceinline__ unsigned pk2(float lo, float hi) { return f2bf(lo) | (f2bf(hi) << 16); }
__device__ __forceinline__ float bf2f(unsigned short b) { return __builtin_bit_cast(float, (unsigned)b << 16); }
__device__ __forceinline__ float bflo(unsigned w) { return __builtin_bit_cast(float, w << 16); }
__device__ __forceinline__ float bfhi(unsigned w) { return __builtin_bit_cast(float, w & 0xffff0000u); }

#define XB_TMO      128
#define XB_XCNT(j)  (256  + 64 * (j))
#define XB_XSUB(j)  (1280 + 64 * (j))
#define XB_XGEN(j)  (2304 + 64 * (j))
#define XB_TOP      3328
#define XB_TOPGEN   3392
#define XCD_BAR_WORDS 3456
#define XB_SPIN_CAP (1u << 24)

__device__ __forceinline__ unsigned xb_ld(unsigned* p)              { return __hip_atomic_load(p, __ATOMIC_RELAXED, __HIP_MEMORY_SCOPE_AGENT); }
__device__ __forceinline__ unsigned xb_add(unsigned* p, unsigned v) { return __hip_atomic_fetch_add(p, v, __ATOMIC_RELAXED, __HIP_MEMORY_SCOPE_AGENT); }
__device__ __forceinline__ unsigned xb_xcc_id() { return (unsigned)__builtin_amdgcn_s_getreg((3 << 11) | 20) & 0xFu; }
#define XB_SPIN(cond, bar) do { unsigned _sp = 0; while (cond) { __builtin_amdgcn_s_sleep(1); \
    if ((++_sp & 255u) == 0u) { if (xb_ld(&(bar)[XB_TMO])) break; if (_sp > XB_SPIN_CAP) { atomicAdd(&(bar)[XB_TMO], 1u); break; } } } } while (0)

struct XcdBarrier { unsigned* bar; unsigned x; volatile LAS unsigned* st; };

__device__ __forceinline__ XcdBarrier xcd_barrier_post(unsigned* bar, volatile LAS unsigned* st) {
    XcdBarrier b; b.bar = bar; b.x = xb_xcc_id(); b.st = st;
    if (threadIdx.x == 0) (void)xb_add(&bar[XB_XCNT(b.x)], 1u);
    return b;
}
__device__ __forceinline__ void xcd_barrier_complete(unsigned* bar, unsigned x, unsigned& nloc, unsigned& nx) {
    const unsigned G = gridDim.x * gridDim.y * gridDim.z;
    unsigned sum, cnt, mine, sp = 0u;
    for (;;) {
        sum = 0u; cnt = 0u; mine = 0u;
#pragma unroll 1
        for (unsigned j = 0; j < 16; ++j) { const unsigned c = xb_ld(&bar[XB_XCNT(j)]); sum += c; cnt += (c > 0u) ? 1u : 0u; mine = (j == x) ? c : mine; }
        if (sum == G) break;
        __builtin_amdgcn_s_sleep(1);
        if ((++sp & 255u) == 0u) { if (xb_ld(&bar[XB_TMO])) break; if (sp > XB_SPIN_CAP) { atomicAdd(&bar[XB_TMO], 1u); break; } }
    }
    nloc = mine > 0u ? mine : 1u; nx = cnt > 0u ? cnt : 1u;
}
__device__ __forceinline__ void xcd_barrier_census(const XcdBarrier& b) {
    if (threadIdx.x == 0) { unsigned nloc, nx; xcd_barrier_complete(b.bar, b.x, nloc, nx); b.st[0] = nloc; b.st[1] = nx; }
    __syncthreads();
}
__device__ __forceinline__ void xcd_barrier(const XcdBarrier& b) {
    asm volatile("s_waitcnt vmcnt(0)" ::: "memory");
    __syncthreads();
    if (threadIdx.x == 0) {
        unsigned* bar = b.bar;
        __builtin_amdgcn_s_waitcnt(0);
        const unsigned nloc = b.st[0], nx = b.st[1];
        const unsigned old = xb_add(&bar[XB_XSUB(b.x)], 1u);
        const unsigned gen = old / nloc;
        if (old + 1u == (gen + 1u) * nloc) {
            __builtin_amdgcn_fence(__ATOMIC_RELEASE, "agent");
            asm volatile("s_waitcnt vmcnt(0)" ::: "memory");
            const unsigned og = xb_add(&bar[XB_TOP], 1u);
            const unsigned tg = og / nx;
            if (og + 1u == (tg + 1u) * nx) xb_add(&bar[XB_TOPGEN], 1u);
            else XB_SPIN(xb_ld(&bar[XB_TOPGEN]) == tg, bar);
            __builtin_amdgcn_fence(__ATOMIC_ACQUIRE, "agent");
            xb_add(&bar[XB_XGEN(b.x)], 1u);
            asm volatile("s_waitcnt vmcnt(0)" ::: "memory");
        } else {
            XB_SPIN(xb_ld(&bar[XB_XGEN(b.x)]) == gen, bar);
            __builtin_amdgcn_fence(__ATOMIC_ACQUIRE, "agent");
            asm volatile("s_waitcnt vmcnt(0)" ::: "memory");
        }
    }
    __syncthreads();
}

__device__ __forceinline__ float wave_sum(float v) {
#pragma unroll
    for (int o = 1; o < 64; o <<= 1) v += __shfl_xor(v, o);
    return v;
}
__device__ __forceinline__ void p0_transpose_item(const float* W, int K, int N, bf16* WT, LAS float* scr, int item, int lane) {
    const int nblk = N / 32, kb = item / nblk, nb = item % nblk, k0 = 64 * kb, n0 = 32 * nb;
#pragma unroll 8
    for (int i = 0; i < 32; ++i) { const int kk = 2 * i + (lane >> 5); scr[kk * 33 + (lane & 31)] = W[(size_t)(k0 + kk) * N + n0 + (lane & 31)]; }
    LDS_WAIT(); asm volatile("" ::: "memory");
    const int c = lane & 7;
#pragma unroll
    for (int j = 0; j < 4; ++j) { const int n = (lane >> 3) + 8 * j; const LAS float* s = scr + (8 * c) * 33 + n;
        v4u o; o.x = pk2(s[0 * 33], s[1 * 33]); o.y = pk2(s[2 * 33], s[3 * 33]); o.z = pk2(s[4 * 33], s[5 * 33]); o.w = pk2(s[6 * 33], s[7 * 33]);
        *(GAS v4u*)(WT + (size_t)(n0 + n) * K + k0 + 8 * c) = o; }
    LDS_WAIT(); asm volatile("" ::: "memory");
}
struct Ctx {
    LAS unsigned char* lds;
    int tid, lane, wave, vcu, G;
    const float* in[11]; float* out; unsigned char* ws;
};
#define CTXP const Ctx& F

__device__ __forceinline__ bf16* wsl(CTXP, int l, size_t off) { return (bf16*)(F.ws + WS_W) + (size_t)l * W_LAYER + off; }

__device__ __forceinline__ void phase_prologue(CTXP) {
    LAS float* scr = (LAS float*)(F.lds + RING_OFF + F.wave * 16384);
    const int gw = F.vcu * NWAVES + F.wave, NGW = F.G * NWAVES;
    constexpr int I_IN = (D / 64) * (NZ / 32), I_A = (512 / 64) * (D / 32), I_B = (D / 64) * (D / 32), I_O = I_B, I_U = (D / 64) * (FF / 32), I_D = (FF / 64) * (D / 32);
    constexpr int I_LAYER = I_IN + I_A + I_B + I_O + I_U + I_D;
    for (int it = gw; it < DEPTH * I_LAYER; it += NGW) {
        const int l = it / I_LAYER; int r = it % I_LAYER;
        if (r < I_IN) { p0_transpose_item(F.in[2] + (size_t)l * D * NZ, D, NZ, wsl(F, l, W_WIN), scr, r, F.lane); continue; } r -= I_IN;
        if (r < I_A) { p0_transpose_item(F.in[4] + (size_t)l * 512 * D, 512, D, wsl(F, l, W_WA), scr, r, F.lane); continue; } r -= I_A;
        if (r < I_B) { p0_transpose_item(F.in[5] + (size_t)l * D * D, D, D, wsl(F, l, W_WB), scr, r, F.lane); continue; } r -= I_B;
        if (r < I_O) { p0_transpose_item(F.in[6] + (size_t)l * D * D, D, D, wsl(F, l, W_WOUT), scr, r, F.lane); continue; } r -= I_O;
        if (r < I_U) { p0_transpose_item(F.in[8] + (size_t)l * D * FF, D, FF, wsl(F, l, W_WUP), scr, r, F.lane); continue; } r -= I_U;
        p0_transpose_item(F.in[9] + (size_t)l * FF * D, FF, D, wsl(F, l, W_WDOWN), scr, r, F.lane);
    }
    f32x2* tabA = (f32x2*)(F.ws + WS_TABA); f32x2* tabR = (f32x2*)(F.ws + WS_TABR);
    const int gt = (F.vcu * NWAVES + F.wave) * 64 + F.lane, NGT = F.G * NWAVES * 64;
    for (int idx = gt; idx < SEQ * 96; idx += NGT) {
        const int pos = idx / 96, j = idx % 96;
        const float ex = (j < 32) ? (float)j * (1.f / 32.f) : (float)(j - 32) * (1.f / 63.f);
        const float inv = exp2f(-ex * 13.287712379549449f);
        const float ang = (float)pos * inv;
        float s, c; sincosf(ang, &s, &c);
        const f32x2 v = {c, s};
        if (j < 32) tabA[pos * 32 + j] = v; else tabR[pos * 64 + (j - 32)] = v;
    }
}

__device__ __forceinline__ void phase_rms_bf16(CTXP, const float* x, const float* g, bf16* H) {
    const int gw = F.vcu * NWAVES + F.wave, NGW = F.G * NWAVES;
    const f32x4* g4 = (const f32x4*)g + F.lane;
    for (int m = gw; m < M; m += NGW) {
        const f32x4* xr = (const f32x4*)(x + (size_t)m * D) + F.lane;
        f32x4 v[4]; float s = 0.f;
#pragma unroll
        for (int j = 0; j < 4; ++j) { v[j] = xr[64 * j]; s += (v[j].x * v[j].x + v[j].y * v[j].y) + (v[j].z * v[j].z + v[j].w * v[j].w); }
        const float rstd = 1.f / sqrtf(wave_sum(s) * (1.f / D) + EPS);
        unsigned long long* o8 = (unsigned long long*)(H + (size_t)m * D) + F.lane;
#pragma unroll
        for (int j = 0; j < 4; ++j) { const f32x4 gg = g4[64 * j];
            o8[64 * j] = (unsigned long long)pk2(v[j].x * rstd * gg.x, v[j].y * rstd * gg.y) | ((unsigned long long)pk2(v[j].z * rstd * gg.z, v[j].w * rstd * gg.w) << 32); }
    }
}
__device__ __forceinline__ void phase_rms_final(CTXP, float* x, const float* g) {
    const int gw = F.vcu * NWAVES + F.wave, NGW = F.G * NWAVES;
    const f32x4* g4 = (const f32x4*)g + F.lane;
    for (int m = gw; m < M; m += NGW) {
        f32x4* xr = (f32x4*)(x + (size_t)m * D) + F.lane;
        f32x4 v[4]; float s = 0.f;
#pragma unroll
        for (int j = 0; j < 4; ++j) { v[j] = xr[64 * j]; s += (v[j].x * v[j].x + v[j].y * v[j].y) + (v[j].z * v[j].z + v[j].w * v[j].w); }
        const float rstd = 1.f / sqrtf(wave_sum(s) * (1.f / D) + EPS);
#pragma unroll
        for (int j = 0; j < 4; ++j) { const f32x4 gg = g4[64 * j]; xr[64 * j] = v[j] * rstd * gg; }
    }
}

__device__ __forceinline__ void phase_rotary(CTXP, bf16* z) {
    const f32x2* tabA = (const f32x2*)(F.ws + WS_TABA); const f32x2* tabR = (const f32x2*)(F.ws + WS_TABR);
    const long gt = (long)(F.vcu * NWAVES + F.wave) * 64 + F.lane, NGT = (long)F.G * NWAVES * 64;
    for (long idx = gt; idx < (long)M * 832; idx += NGT) {
        const int m = (int)(idx / 832), p = (int)(idx % 832), pos = m % SEQ;
        int c1, c2; f32x2 cs; float sc = 1.f;
        if (p < 256)      { const int h = p / 32, i = p % 32; c1 = C_AQ + 64 * h + i; c2 = c1 + 32; cs = tabA[pos * 32 + i]; }
        else if (p < 320) { const int pp = p - 256, h = pp / 32, i = pp % 32; c1 = C_AK + 64 * h + i; c2 = c1 + 32; cs = tabA[pos * 32 + i]; }
        else if (p < 576) { const int pp = p - 320, h = pp / 64, i = pp % 64; c1 = C_RQ + 128 * h + 2 * i; c2 = c1 + 1; cs = tabR[pos * 64 + i]; }
        else              { const int pp = p - 576, h = pp / 64, i = pp % 64; c1 = C_RK + 128 * h + 2 * i; c2 = c1 + 1; cs = tabR[pos * 64 + i]; sc = 0.08838834764831845f; }
        bf16* zr = z + (size_t)m * NZ;
        const float x1 = bf2f(zr[c1]), x2 = bf2f(zr[c2]);
        zr[c1] = (bf16)f2bf((x1 * cs.x - x2 * cs.y) * sc); zr[c2] = (bf16)f2bf((x2 * cs.x + x1 * cs.y) * sc);
    }
}

__device__ __forceinline__ void phase_attn_naive(CTXP, bf16* z, const float* sinks) {
    const int gw = F.vcu * NWAVES + F.wave, NGW = F.G * NWAVES;
    for (int u = gw; u < BATCH * 64 * 8; u += NGW) {
        const int h = u % 8, tb = (u / 8) % 64, b = u / 512, g = h / 4;
        const int t = tb * 64 + F.lane; const size_t m = (size_t)b * SEQ + t;
        float q[64], o[64];
        { const v4u* qp = (const v4u*)(z + m * NZ + C_AQ + 64 * h);
#pragma unroll
          for (int c = 0; c < 8; ++c) { const v4u w = qp[c];
              q[8 * c + 0] = bflo(w.x) * 0.125f; q[8 * c + 1] = bfhi(w.x) * 0.125f; q[8 * c + 2] = bflo(w.y) * 0.125f; q[8 * c + 3] = bfhi(w.y) * 0.125f;
              q[8 * c + 4] = bflo(w.z) * 0.125f; q[8 * c + 5] = bfhi(w.z) * 0.125f; q[8 * c + 6] = bflo(w.w) * 0.125f; q[8 * c + 7] = bfhi(w.w) * 0.125f; } }
#pragma unroll
        for (int d = 0; d < 64; ++d) o[d] = 0.f;
        float mr = sinks[h], l = 1.f;
        const int k0 = (tb * 64 - 127) > 0 ? (tb * 64 - 127) : 0, k1 = tb * 64 + 63;
        for (int kk = k0; kk <= k1; ++kk) {
            const bf16* krow = z + ((size_t)b * SEQ + kk) * NZ + C_AK + 64 * g;
            const bf16* vrow = z + ((size_t)b * SEQ + kk) * NZ + C_AV + 64 * g;
            float s = 0.f;
#pragma unroll
            for (int c = 0; c < 8; ++c) { const v4u w = ((const v4u*)krow)[c];
                s += q[8 * c + 0] * bflo(w.x) + q[8 * c + 1] * bfhi(w.x) + q[8 * c + 2] * bflo(w.y) + q[8 * c + 3] * bfhi(w.y)
                   + q[8 * c + 4] * bflo(w.z) + q[8 * c + 5] * bfhi(w.z) + q[8 * c + 6] * bflo(w.w) + q[8 * c + 7] * bfhi(w.w); }
            const bool valid = (kk <= t) && (kk >= t - 127);
            if (valid) {
                const float mn = fmaxf(mr, s), corr = __expf(mr - mn), p = __expf(s - mn);
                l = l * corr + p; mr = mn;
#pragma unroll
                for (int c = 0; c < 8; ++c) { const v4u w = ((const v4u*)vrow)[c];
                    o[8 * c + 0] = o[8 * c + 0] * corr + p * bflo(w.x); o[8 * c + 1] = o[8 * c + 1] * corr + p * bfhi(w.x);
                    o[8 * c + 2] = o[8 * c + 2] * corr + p * bflo(w.y); o[8 * c + 3] = o[8 * c + 3] * corr + p * bfhi(w.y);
                    o[8 * c + 4] = o[8 * c + 4] * corr + p * bflo(w.z); o[8 * c + 5] = o[8 * c + 5] * corr + p * bfhi(w.z);
                    o[8 * c + 6] = o[8 * c + 6] * corr + p * bflo(w.w); o[8 * c + 7] = o[8 * c + 7] * corr + p * bfhi(w.w); }
            }
        }
        const float rl = 1.f / l;
        v4u* op = (v4u*)(z + m * NZ + C_AQ + 64 * h);
#pragma unroll
        for (int c = 0; c < 8; ++c) { v4u w; w.x = pk2(o[8 * c + 0] * rl, o[8 * c + 1] * rl); w.y = pk2(o[8 * c + 2] * rl, o[8 * c + 3] * rl);
            w.z = pk2(o[8 * c + 4] * rl, o[8 * c + 5] * rl); w.w = pk2(o[8 * c + 6] * rl, o[8 * c + 7] * rl); op[c] = w; }
    }
}

__device__ __forceinline__ void phase_ret_scan_naive(CTXP, const bf16* z, bf16* RP) {
    const int gt = (F.vcu * NWAVES + F.wave) * 64 + F.lane, NGT = F.G * NWAVES * 64;
    for (int idx = gt; idx < BATCH * 4 * 128 * 64; idx += NGT) {
        const int e0 = idx % 64, d = (idx / 64) % 128, h = (idx / 8192) % 4, b = idx / 32768;
        const float gamma = 1.f - exp2f(-5.f - (float)h);
        float S0 = 0.f, S1 = 0.f, S2 = 0.f, S3 = 0.f;
        const bf16* zk = z + (size_t)b * SEQ * NZ + C_RK + 128 * h + d;
        const bf16* zv = z + (size_t)b * SEQ * NZ + C_RV + 256 * h + e0;
        bf16* rp = RP + ((size_t)(b * 4 + h) * 32) * 32768 + d * 256 + e0;
        for (int n = 0; n < 32; ++n) {
            rp[0] = (bf16)f2bf(S0); rp[64] = (bf16)f2bf(S1); rp[128] = (bf16)f2bf(S2); rp[192] = (bf16)f2bf(S3); rp += 32768;
#pragma unroll 4
            for (int j = 0; j < 128; ++j) {
                const float kd = bf2f(*zk); const float v0 = bf2f(zv[0]), v1 = bf2f(zv[64]), v2 = bf2f(zv[128]), v3 = bf2f(zv[192]);
                S0 = gamma * S0 + kd * v0; S1 = gamma * S1 + kd * v1; S2 = gamma * S2 + kd * v2; S3 = gamma * S3 + kd * v3;
                zk += NZ; zv += NZ;
            }
        }
    }
}

__device__ __forceinline__ void phase_ret_out_naive(CTXP, bf16* z, const bf16* RP) {
    LAS float* Sl = (LAS float*)(F.lds + RING_OFF);
    LAS float* rowsq = (LAS float*)(F.lds + RING_OFF + 32768);
    const int tid = F.tid;
    for (int unit = F.vcu; unit < BATCH * 4 * 32 * 2; unit += F.G) {
        const int half = unit & 1, n = (unit >> 1) & 31, h = (unit >> 6) & 3, b = unit >> 8;
        const size_t m0 = (size_t)b * SEQ + n * 128;
        const float log2g = log2f(1.f - exp2f(-5.f - (float)h));
        {
            const int j = tid & 127, ig = tid >> 7;
            unsigned kreg[64];
            { const v4u* kp = (const v4u*)(z + (m0 + j) * NZ + C_RK + 128 * h);
#pragma unroll
              for (int c = 0; c < 16; ++c) { const v4u w = kp[c]; kreg[4 * c] = w.x; kreg[4 * c + 1] = w.y; kreg[4 * c + 2] = w.z; kreg[4 * c + 3] = w.w; } }
            for (int r = 0; r < 16; ++r) {
                const int i = ig + 4 * r, iglob = 64 * half + i;
                float s = 0.f;
                if (j <= iglob) {
                    const v4u* qp = (const v4u*)(z + (m0 + iglob) * NZ + C_RQ + 128 * h);
#pragma unroll
                    for (int c = 0; c < 16; ++c) { const v4u w = qp[c];
                        s += bflo(w.x) * bflo(kreg[4 * c]) + bfhi(w.x) * bfhi(kreg[4 * c]) + bflo(w.y) * bflo(kreg[4 * c + 1]) + bfhi(w.y) * bfhi(kreg[4 * c + 1])
                           + bflo(w.z) * bflo(kreg[4 * c + 2]) + bfhi(w.z) * bfhi(kreg[4 * c + 2]) + bflo(w.w) * bflo(kreg[4 * c + 3]) + bfhi(w.w) * bfhi(kreg[4 * c + 3]); }
                    s *= exp2f(log2g * (float)(iglob - j));
                }
                Sl[i * 128 + j] = s;
            }
            if (tid < 64) rowsq[tid] = 0.f;
        }
        __syncthreads();
        {
            const int e = tid & 255, rgp = tid >> 8;
            float acc[32], acc2[32];
#pragma unroll
            for (int rr = 0; rr < 32; ++rr) { acc[rr] = 0.f; acc2[rr] = 0.f; }
            const bf16* vp = z + m0 * NZ + C_RV + 256 * h + e;
            for (int j = 0; j < 128; ++j) {
                const float v = bf2f(vp[(size_t)j * NZ]);
#pragma unroll
                for (int rr = 0; rr < 32; ++rr) acc[rr] += Sl[(rgp * 32 + rr) * 128 + j] * v;
            }
            const bf16* rp = RP + ((size_t)((b * 4 + h) * 32 + n)) * 32768 + e;
            const bf16* qb = z + (m0 + 64 * half + rgp * 32) * NZ + C_RQ + 128 * h;
            for (int d = 0; d < 128; d += 2) {
                const float r0 = bf2f(rp[(size_t)d * 256]), r1 = bf2f(rp[(size_t)(d + 1) * 256]);
#pragma unroll
                for (int rr = 0; rr < 32; ++rr) { const unsigned w = *(const unsigned*)(qb + (size_t)rr * NZ + d); acc2[rr] += bflo(w) * r0 + bfhi(w) * r1; }
            }
#pragma unroll
            for (int rr = 0; rr < 32; ++rr) {
                const int iglob = 64 * half + rgp * 32 + rr;
                const float r = acc[rr] + exp2f(log2g * (float)(iglob + 1)) * acc2[rr];
                acc[rr] = r;
                const float ss = wave_sum(r * r);
                if (F.lane == 0) atomicAdd((float*)(rowsq + rgp * 32 + rr), ss);
            }
            __syncthreads();
#pragma unroll
            for (int rr = 0; rr < 32; ++rr) {
                const int iglob = 64 * half + rgp * 32 + rr;
                const float rstd = 1.f / sqrtf(rowsq[rgp * 32 + rr] * (1.f / 256.f) + EPS);
                bf16* gp = z + (m0 + iglob) * NZ + C_RG + 256 * h + e;
                const float gv = bf2f(*gp);
                const float sil = gv / (1.f + __expf(-gv));
                *gp = (bf16)f2bf(acc[rr] * rstd * sil);
            }
        }
        __syncthreads();
    }
}

__device__ __forceinline__ void phase_merge_naive(CTXP, bf16* z) {
    const long gt = (long)(F.vcu * NWAVES + F.wave) * 64 + F.lane, NGT = (long)F.G * NWAVES * 64;
    for (long idx = gt; idx < (long)M * (D / 8); idx += NGT) {
        const size_t m = (size_t)(idx / (D / 8)); const int c = (int)(idx % (D / 8)) * 8;
        bf16* zr = z + m * NZ;
        const v4u ya = *(const v4u*)(zr + C_YA + c), yb = *(const v4u*)(zr + C_YB + c), ga = *(const v4u*)(zr + C_GA + c), gb = *(const v4u*)(zr + C_GB + c);
        v4u o;
#define MRG(A, B, GA_, GB_, LOHI) ((1.f / (1.f + __expf(-LOHI(GA_)))) * LOHI(A) + (1.f / (1.f + __expf(-LOHI(GB_)))) * LOHI(B))
        o.x = pk2(MRG(ya.x, yb.x, ga.x, gb.x, bflo), MRG(ya.x, yb.x, ga.x, gb.x, bfhi));
        o.y = pk2(MRG(ya.y, yb.y, ga.y, gb.y, bflo), MRG(ya.y, yb.y, ga.y, gb.y, bfhi));
        o.z = pk2(MRG(ya.z, yb.z, ga.z, gb.z, bflo), MRG(ya.z, yb.z, ga.z, gb.z, bfhi));
        o.w = pk2(MRG(ya.w, yb.w, ga.w, gb.w, bflo), MRG(ya.w, yb.w, ga.w, gb.w, bfhi));
#undef MRG
        *(v4u*)(zr + C_GA + c) = o;
    }
}

typedef short bf16x8 __attribute__((ext_vector_type(8)));
typedef short s16x4 __attribute__((ext_vector_type(4)));
typedef float f32x16 __attribute__((ext_vector_type(16)));
typedef __bf16 bf16x2_t __attribute__((ext_vector_type(2)));
#define MFMA32(a, b, c) __builtin_amdgcn_mfma_f32_32x32x16_bf16((a), (b), (c), 0, 0, 0)
__device__ __forceinline__ int crow(int r, int h) { return (r & 3) + 8 * (r >> 2) + 4 * h; }
__device__ __forceinline__ unsigned cvtpk(float lo, float hi) { f32x2 v = {lo, hi}; bf16x2_t b = __builtin_convertvector(v, bf16x2_t); return __builtin_bit_cast(unsigned, b); }
__device__ __forceinline__ s16x4 tr_read(const LAS unsigned char* p) { return __builtin_bit_cast(s16x4, __builtin_amdgcn_ds_read_tr16_b64_v4i16((LAS s16x4*)p)); }
#define PACK_STEP(x, s) __builtin_bit_cast(bf16x8, (v4u){cvtpk((x)[8 * (s)], (x)[8 * (s) + 1]), cvtpk((x)[8 * (s) + 2], (x)[8 * (s) + 3]), cvtpk((x)[8 * (s) + 4], (x)[8 * (s) + 5]), cvtpk((x)[8 * (s) + 6], (x)[8 * (s) + 7])})

__device__ __forceinline__ void phase_attn_mfma(CTXP, bf16* z, const float* sinks) {
    const LAS unsigned char* Kl = F.lds + RING_OFF; const LAS unsigned char* Vl = F.lds + RING_OFF + 32768;
    const int tid = F.tid, lane = F.lane, r = lane & 31, h = lane >> 5, wave = F.wave;
    const int i16 = lane & 15, tq = i16 >> 2, tp = i16 & 3, blk = (lane >> 4) & 1;
    for (int unit = F.vcu; unit < BATCH * 32 * 2; unit += F.G) {
        const int g = unit & 1, n = (unit >> 1) & 31, b = unit >> 6;
        const size_t m0 = (size_t)b * SEQ + (size_t)n * 128;
        const int kj_lo = (n == 0) ? 128 : 0, kt_lo = (n == 0) ? 4 : 0;
#pragma unroll
        for (int p = 0; p < 4; ++p) { const int row = p * 64 + (tid >> 3), c = tid & 7;
            if (row >= kj_lo) { const bf16* src = z + (m0 - 128 + row) * NZ + 64 * g + 8 * c;
                const v4u kv = *(const v4u*)(src + C_AK), vv = *(const v4u*)(src + C_AV);
                *(LAS v4u*)(Kl + row * 128 + ((c ^ (row & 7)) * 16)) = kv; *(LAS v4u*)(Vl + row * 128 + c * 16) = vv; } }
        __syncthreads();
        const int hq = 4 * g + (wave >> 1);
        const float sinkl = sinks[hq] * 1.4426950408889634f;
#pragma unroll 1
        for (int qq = 0; qq < 2; ++qq) {
            const int qs = (wave & 1) * 2 + qq;
            bf16* qrow = z + (m0 + 32 * qs + r) * NZ + C_AQ + 64 * hq;
            bf16x8 qf[4];
#pragma unroll
            for (int ks = 0; ks < 4; ++ks) qf[ks] = *(const bf16x8*)(qrow + 16 * ks + 8 * h);
            f32x16 s[5];
            const int iq = 32 * qs + r;
#pragma unroll
            for (int t = 0; t < 5; ++t) {
                const int kt = qs + t;
                if (kt < kt_lo) {
#pragma unroll
                    for (int i = 0; i < 16; ++i) s[t][i] = -INFINITY;
                } else {
                    f32x16 acc;
#pragma unroll
                    for (int i = 0; i < 16; ++i) acc[i] = 0.f;
                    const int key = 32 * kt + r;
#pragma unroll
                    for (int ks = 0; ks < 4; ++ks) { const bf16x8 a = *(const LAS bf16x8*)(Kl + key * 128 + (((2 * ks + h) ^ (key & 7)) * 16)); acc = MFMA32(a, qf[ks], acc); }
#pragma unroll
                    for (int i = 0; i < 16; ++i) { const int kj = 32 * kt + crow(i, h); const bool valid = (kj >= iq + 1) && (kj <= iq + 128); s[t][i] = valid ? acc[i] * 0.18033688011112042f : -INFINITY; }
                }
            }
            float mx = sinkl;
#pragma unroll
            for (int t = 0; t < 5; ++t)
#pragma unroll
                for (int i = 0; i < 16; ++i) mx = fmaxf(mx, s[t][i]);
            mx = fmaxf(mx, __shfl_xor(mx, 32));
            float l = 0.f;
#pragma unroll
            for (int t = 0; t < 5; ++t)
#pragma unroll
                for (int i = 0; i < 16; ++i) { const float p = __builtin_amdgcn_exp2f(s[t][i] - mx); s[t][i] = p; l += p; }
            l += __shfl_xor(l, 32);
            l += __builtin_amdgcn_exp2f(sinkl - mx);
            f32x16 o[2];
#pragma unroll
            for (int i = 0; i < 16; ++i) { o[0][i] = 0.f; o[1][i] = 0.f; }
#pragma unroll
            for (int t = 0; t < 5; ++t) {
                const int kt = qs + t;
                if (kt >= kt_lo) {
#pragma unroll
                    for (int s2 = 0; s2 < 2; ++s2) {
                        const bf16x8 xs = PACK_STEP(s[t], s2);
#pragma unroll
                        for (int dt = 0; dt < 2; ++dt) {
                            const LAS unsigned char* vp = Vl + (32 * kt + 16 * s2 + 4 * h + tq) * 128 + (32 * dt + 16 * blk) * 2 + 8 * tp;
                            const s16x4 lo = tr_read(vp), hi = tr_read(vp + 8 * 128);
                            const bf16x8 pa = __builtin_shufflevector(lo, hi, 0, 1, 2, 3, 4, 5, 6, 7);
                            o[dt] = MFMA32(pa, xs, o[dt]);
                        }
                    }
                }
            }
            const float rl = 1.f / l;
#pragma unroll
            for (int dt = 0; dt < 2; ++dt)
#pragma unroll
                for (int g4 = 0; g4 < 4; ++g4) {
                    v2u w; w.x = cvtpk(o[dt][4 * g4] * rl, o[dt][4 * g4 + 1] * rl); w.y = cvtpk(o[dt][4 * g4 + 2] * rl, o[dt][4 * g4 + 3] * rl);
                    *(v2u*)(qrow + 32 * dt + 8 * g4 + 4 * h) = w;
                }
        }
        __syncthreads();
    }
}

__device__ __forceinline__ void phase_ret_kv_mfma(CTXP, const bf16* z, bf16* KV) {
    const LAS unsigned char* Vl = F.lds + RING_OFF; const LAS unsigned char* Kl = F.lds + RING_OFF + 65536;
    const int tid = F.tid, lane = F.lane, r = lane & 31, h = lane >> 5, wave = F.wave;
    const int i16 = lane & 15, tq = i16 >> 2, tp = i16 & 3, blk = (lane >> 4) & 1;
    for (int unit = F.vcu; unit < BATCH * 4 * 32; unit += F.G) {
        const int n = unit & 31, hd = (unit >> 5) & 3, b = unit >> 7;
        const size_t m0 = (size_t)b * SEQ + (size_t)n * 128;
        const float log2g = log2f(1.f - exp2f(-5.f - (float)hd));
#pragma unroll
        for (int p = 0; p < 4; ++p) { const int row = p * 32 + (tid >> 4), c = tid & 15;
            const v4u w = *(const v4u*)(z + (m0 + row) * NZ + C_RK + 128 * hd + 8 * c);
            const float zt = exp2f(log2g * (float)(127 - row));
            v4u o; o.x = cvtpk(bflo(w.x) * zt, bfhi(w.x) * zt); o.y = cvtpk(bflo(w.y) * zt, bfhi(w.y) * zt); o.z = cvtpk(bflo(w.z) * zt, bfhi(w.z) * zt); o.w = cvtpk(bflo(w.w) * zt, bfhi(w.w) * zt);
            *(LAS v4u*)(Kl + row * 256 + c * 16) = o; }
#pragma unroll
        for (int p = 0; p < 8; ++p) { const int row = p * 16 + (tid >> 5), c = tid & 31;
            *(LAS v4u*)(Vl + row * 512 + c * 16) = *(const v4u*)(z + (m0 + row) * NZ + C_RV + 256 * hd + 8 * c); }
        __syncthreads();
        f32x16 acc[4];
#pragma unroll
        for (int dt = 0; dt < 4; ++dt)
#pragma unroll
            for (int i = 0; i < 16; ++i) acc[dt][i] = 0.f;
#pragma unroll 2
        for (int s = 0; s < 8; ++s) {
            const LAS unsigned char* vp = Vl + (16 * s + 8 * h + tq) * 512 + (32 * wave + 16 * blk) * 2 + 8 * tp;
            const s16x4 vlo = tr_read(vp), vhi = tr_read(vp + 4 * 512);
            const bf16x8 bfrag = __builtin_shufflevector(vlo, vhi, 0, 1, 2, 3, 4, 5, 6, 7);
#pragma unroll
            for (int dt = 0; dt < 4; ++dt) {
                const LAS unsigned char* kp = Kl + (16 * s + 8 * h + tq) * 256 + (32 * dt + 16 * blk) * 2 + 8 * tp;
                const s16x4 klo = tr_read(kp), khi = tr_read(kp + 4 * 256);
                const bf16x8 afrag = __builtin_shufflevector(klo, khi, 0, 1, 2, 3, 4, 5, 6, 7);
                acc[dt] = MFMA32(afrag, bfrag, acc[dt]);
            }
        }
        bf16* out = KV + (size_t)unit * 32768 + (32 * wave + r) * 128;
#pragma unroll
        for (int dt = 0; dt < 4; ++dt)
#pragma unroll
            for (int g4 = 0; g4 < 4; ++g4) { v2u w; w.x = cvtpk(acc[dt][4 * g4], acc[dt][4 * g4 + 1]); w.y = cvtpk(acc[dt][4 * g4 + 2], acc[dt][4 * g4 + 3]);
                *(v2u*)(out + 32 * dt + 8 * g4 + 4 * h) = w; }
        __syncthreads();
    }
}
__device__ __forceinline__ void phase_ret_scan(CTXP, bf16* KV) {
    const int gt = (F.vcu * NWAVES + F.wave) * 64 + F.lane, NGT = F.G * NWAVES * 64;
    for (int idx = gt; idx < 32 * 4096; idx += NGT) {
        const int bh = idx >> 12, off = (idx & 4095) * 8, hd = bh & 3;
        const float gch = exp2f(128.f * log2f(1.f - exp2f(-5.f - (float)hd)));
        float R[8];
#pragma unroll
        for (int i = 0; i < 8; ++i) R[i] = 0.f;
        bf16* p = KV + (size_t)bh * 32 * 32768 + off;
#pragma unroll 4
        for (int n = 0; n < 32; ++n) {
            const v4u kv = *(const v4u*)p;
            v4u o; o.x = cvtpk(R[0], R[1]); o.y = cvtpk(R[2], R[3]); o.z = cvtpk(R[4], R[5]); o.w = cvtpk(R[6], R[7]);
            *(v4u*)p = o;
            R[0] = gch * R[0] + bflo(kv.x); R[1] = gch * R[1] + bfhi(kv.x); R[2] = gch * R[2] + bflo(kv.y); R[3] = gch * R[3] + bfhi(kv.y);
            R[4] = gch * R[4] + bflo(kv.z); R[5] = gch * R[5] + bfhi(kv.z); R[6] = gch * R[6] + bflo(kv.w); R[7] = gch * R[7] + bfhi(kv.w);
            p += 32768;
        }
    }
}
__device__ __forceinline__ void phase_ret_out_mfma(CTXP, bf16* z, const bf16* RP) {
    const LAS unsigned char* Vl = F.lds + RING_OFF; LAS float* red = (LAS float*)(F.lds + RING_OFF + 65536);
    const int tid = F.tid, lane = F.lane, r = lane & 31, h = lane >> 5, wave = F.wave, qb = wave & 3, eh = wave >> 2;
    const int i16 = lane & 15, tq = i16 >> 2, tp = i16 & 3, blk = (lane >> 4) & 1;
    for (int unit = F.vcu; unit < BATCH * 4 * 32; unit += F.G) {
        const int n = unit & 31, hd = (unit >> 5) & 3, b = unit >> 7;
        const size_t m0 = (size_t)b * SEQ + (size_t)n * 128;
        const float log2g = log2f(1.f - exp2f(-5.f - (float)hd));
#pragma unroll
        for (int p = 0; p < 8; ++p) { const int row = p * 16 + (tid >> 5), c = tid & 31;
            *(LAS v4u*)(Vl + row * 512 + c * 16) = *(const v4u*)(z + (m0 + row) * NZ + C_RV + 256 * hd + 8 * c); }
        const int iq = 32 * qb + r;
        const bf16* qrow = z + (m0 + iq) * NZ + C_RQ + 128 * hd + 8 * h;
        bf16x8 qf[8];
#pragma unroll
        for (int ks = 0; ks < 8; ++ks) qf[ks] = *(const bf16x8*)(qrow + 16 * ks);
        f32x16 acc[4];
        const bf16* rp = RP + (size_t)unit * 32768 + (128 * eh + r) * 128 + 8 * h;
        const float xi = exp2f(log2g * (float)(iq + 1));
#pragma unroll
        for (int et = 0; et < 4; ++et) {
#pragma unroll
            for (int i = 0; i < 16; ++i) acc[et][i] = 0.f;
#pragma unroll
            for (int ks = 0; ks < 8; ++ks) { const bf16x8 a = *(const bf16x8*)(rp + et * 32 * 128 + 16 * ks); acc[et] = MFMA32(a, qf[ks], acc[et]); }
#pragma unroll
            for (int i = 0; i < 16; ++i) acc[et][i] *= xi;
        }
        __syncthreads();
#pragma unroll 1
        for (int kt = 0; kt <= qb; ++kt) {
            f32x16 X;
#pragma unroll
            for (int i = 0; i < 16; ++i) X[i] = 0.f;
            const bf16* krow = z + (m0 + 32 * kt + r) * NZ + C_RK + 128 * hd + 8 * h;
#pragma unroll
            for (int ks = 0; ks < 8; ++ks) { const bf16x8 a = *(const bf16x8*)(krow + 16 * ks); X = MFMA32(a, qf[ks], X); }
#pragma unroll
            for (int i = 0; i < 16; ++i) { const int kj = 32 * kt + crow(i, h); X[i] = (kj <= iq) ? X[i] * exp2f(log2g * (float)(iq - kj)) : 0.f; }
#pragma unroll
            for (int s2 = 0; s2 < 2; ++s2) {
                const bf16x8 xs = PACK_STEP(X, s2);
#pragma unroll
                for (int et = 0; et < 4; ++et) {
                    const LAS unsigned char* vp = Vl + (32 * kt + 16 * s2 + 4 * h + tq) * 512 + (128 * eh + 32 * et + 16 * blk) * 2 + 8 * tp;
                    const s16x4 lo = tr_read(vp), hi = tr_read(vp + 8 * 512);
                    const bf16x8 pa = __builtin_shufflevector(lo, hi, 0, 1, 2, 3, 4, 5, 6, 7);
                    acc[et] = MFMA32(pa, xs, acc[et]);
                }
            }
        }
        float ss = 0.f;
#pragma unroll
        for (int et = 0; et < 4; ++et)
#pragma unroll
            for (int i = 0; i < 16; ++i) ss += acc[et][i] * acc[et][i];
        ss += __shfl_xor(ss, 32);
        if (h == 0) red[eh * 128 + iq] = ss;
        __syncthreads();
        const float rstd = 1.f / sqrtf((red[iq] + red[128 + iq]) * (1.f / 256.f) + EPS);
        bf16* grow = z + (m0 + iq) * NZ + C_RG + 256 * hd + 128 * eh + 4 * h;
#pragma unroll
        for (int et = 0; et < 4; ++et)
#pragma unroll
            for (int g4 = 0; g4 < 4; ++g4) {
                bf16* p = grow + 32 * et + 8 * g4;
                const v2u gv = *(const v2u*)p;
                const float g0 = bflo(gv.x), g1 = bfhi(gv.x), g2 = bflo(gv.y), g3 = bfhi(gv.y);
                const float o0 = acc[et][4 * g4] * rstd * (g0 / (1.f + __expf(-g0))), o1 = acc[et][4 * g4 + 1] * rstd * (g1 / (1.f + __expf(-g1)));
                const float o2 = acc[et][4 * g4 + 2] * rstd * (g2 / (1.f + __expf(-g2))), o3 = acc[et][4 * g4 + 3] * rstd * (g3 / (1.f + __expf(-g3)));
                v2u w; w.x = cvtpk(o0, o1); w.y = cvtpk(o2, o3);
                *(v2u*)p = w;
            }
        __syncthreads();
    }
}
#ifndef MK_PER_PHASE
#define MK_PER_PHASE 0
#endif
constexpr int PPL = 12;
constexpr int NPH = 1 + DEPTH * PPL + 1;
struct Args { const float* in[11]; float* out; unsigned char* ws; int ph_lo, ph_hi; };
typedef __attribute__((address_space(4))) const Args CArgs;
__global__ void __launch_bounds__(NWAVES * 64, 2) mega_fwd(Args args) {
    extern __shared__ __attribute__((aligned(16))) unsigned char lds[];
    volatile LAS unsigned* MISC = (volatile LAS unsigned*)((LAS unsigned char*)lds + MISC_OFF);
    for (int u = threadIdx.x; u < (LDS_BYTES - LDSCTL_OFF) / 4; u += NWAVES * 64) ((LAS unsigned*)((LAS unsigned char*)lds + LDSCTL_OFF))[u] = 0u;
    __syncthreads();
    const int lo = args.ph_lo, hi = args.ph_hi;
    unsigned* ctl = (unsigned*)(args.ws + WS_CTL);
    XcdBarrier bar; bar.bar = ctl + CW_BAR; bar.x = 0; bar.st = nullptr;
    if (hi - lo > 1) { bar = xcd_barrier_post(ctl + CW_BAR, MISC + 8); xcd_barrier_census(bar); }
#pragma unroll 1
    for (int ph = lo; ph < hi; ++ph) {
        CArgs* ap = (CArgs*)__builtin_amdgcn_kernarg_segment_ptr(); asm volatile("" : "+s"(ap));
        int tid = threadIdx.x; asm volatile("" : "+v"(tid));
        Ctx F;
        F.lds = (LAS unsigned char*)lds;
        F.tid = tid; F.lane = tid & 63; F.wave = __builtin_amdgcn_readfirstlane(tid >> 6);
        F.G = gridDim.x; { const int bx = blockIdx.x; F.vcu = (F.G % 8 == 0) ? (bx % 8) * (F.G / 8) + bx / 8 : bx; }
#pragma unroll
        for (int i = 0; i < 11; ++i) F.in[i] = ap->in[i];
        F.out = ap->out; F.ws = ap->ws;
        bf16* const H = (bf16*)(F.ws + WS_H);
        bf16* const Z = (bf16*)(F.ws + WS_Z);
        const int bx = (int)blockIdx.x;
        if (ph == 0) phase_prologue(F);
        else if (ph == NPH - 1) phase_rms_final(F, F.out, F.in[10]);
        else {
            const int l = (ph - 1) / PPL, k = (ph - 1) % PPL;
            const float* xcur = (l == 0) ? F.in[0] : (const float*)F.out;
            switch (k) {
            case 0: phase_rms_bf16(F, xcur, F.in[1] + l * D, H); break;
            case 1: { pg8::Gemm<M, NZ, D, D> g{H, wsl(F, l, W_WIN)}; pg8::StaticOrder<M, NZ> S; S.init(F.G, bx);
                      pg8::EpiBf16<0> E{Z, NZ}; pg8::gemm_phase<pg8::EpiBf16<0>, pg8::StaticOrder<M, NZ>, true, true>(F.lds + RING_OFF, g, S, E); } break;
            case 2: phase_rotary(F, Z); break;
            case 3: phase_ret_kv_mfma(F, Z, H); break;
            case 4: phase_attn_mfma(F, Z, F.in[3] + l * 8); phase_ret_scan(F, H); break;
            case 5: phase_ret_out_mfma(F, Z, H); break;
            case 6: { { pg8::Gemm<M, D, 512, NZ> g{Z + C_AQ, wsl(F, l, W_WA)}; pg8::StaticOrder<M, D> S; S.init(F.G, bx);
                        pg8::EpiBf16<0> E{Z + C_YA, NZ}; pg8::gemm_phase<pg8::EpiBf16<0>, pg8::StaticOrder<M, D>, true, true>(F.lds + RING_OFF, g, S, E); }
                      { pg8::Gemm<M, D, D, NZ> g{Z + C_RG, wsl(F, l, W_WB)}; pg8::StaticOrder<M, D> S; S.init(F.G, bx);
                        pg8::EpiBf16<0> E{Z + C_YB, NZ}; pg8::gemm_phase<pg8::EpiBf16<0>, pg8::StaticOrder<M, D>, true, true>(F.lds + RING_OFF, g, S, E); } } break;
            case 7: phase_merge_naive(F, Z); break;
            case 8: { pg8::Gemm<M, D, D, NZ> g{Z + C_GA, wsl(F, l, W_WOUT)}; pg8::StaticOrder<M, D> S; S.init(F.G, bx);
                      pg8::EpiResF32 E{xcur, F.out, D}; pg8::gemm_phase<pg8::EpiResF32, pg8::StaticOrder<M, D>, true, true>(F.lds + RING_OFF, g, S, E); } break;
            case 9: phase_rms_bf16(F, F.out, F.in[7] + l * D, H); break;
            case 10: { pg8::Gemm<M, FF, D, D> g{H, wsl(F, l, W_WUP)}; pg8::StaticOrder<M, FF> S; S.init(F.G, bx);
                      pg8::EpiBf16<2> E{Z, FF}; pg8::gemm_phase<pg8::EpiBf16<2>, pg8::StaticOrder<M, FF>, true, true>(F.lds + RING_OFF, g, S, E); } break;
            default: { pg8::Gemm<M, D, FF, FF> g{Z, wsl(F, l, W_WDOWN)}; pg8::StaticOrder<M, D> S; S.init(F.G, bx);
                      pg8::EpiResF32 E{F.out, F.out, D}; pg8::gemm_phase<pg8::EpiResF32, pg8::StaticOrder<M, D>, true, true>(F.lds + RING_OFF, g, S, E); } break;
            }
        }
        if (ph + 1 < hi) xcd_barrier(bar);
    }
}

extern "C" void kernel_launch(void* const* d_in, const int* in_sizes, int n_in, void* d_out, int out_size, void* d_ws, size_t ws_size, hipStream_t stream) {
    static int grid = 0;
    if (grid == 0) {
        if (n_in != 11 || in_sizes[0] != M * D || out_size != M * D || ws_size < WS_END) {
            fprintf(stderr, "kernel_launch: unexpected shapes: n_in %d in0 %d out %d ws %zu (need %zu)\n", n_in, n_in > 0 ? in_sizes[0] : -1, out_size, ws_size, (size_t)WS_END); grid = -1; return; }
        int dev = 0, cus = 0, per_cu = 0;
        if (hipGetDevice(&dev) != hipSuccess || hipDeviceGetAttribute(&cus, hipDeviceAttributeMultiprocessorCount, dev) != hipSuccess) { grid = -1; return; }
        if (hipFuncSetAttribute((const void*)mega_fwd, hipFuncAttributeMaxDynamicSharedMemorySize, LDS_BYTES) != hipSuccess) { fprintf(stderr, "kernel_launch: hipFuncSetAttribute failed\n"); grid = -1; return; }
        if (hipOccupancyMaxActiveBlocksPerMultiprocessor(&per_cu, (const void*)mega_fwd, NWAVES * 64, LDS_BYTES) != hipSuccess || per_cu < 1)
            fprintf(stderr, "kernel_launch: occupancy query reports %d workgroups per CU\n", per_cu);
        (void)hipGetLastError();
        grid = cus;
    }
    if (grid < 0) return;
    if (hipMemsetAsync((char*)d_ws + WS_CTL, 0, CTL_ZERO_BYTES, stream) != hipSuccess) return;
    Args a{};
    for (int i = 0; i < 11; ++i) a.in[i] = (const float*)d_in[i];
    a.out = (float*)d_out; a.ws = (unsigned char*)d_ws;
#if MK_PER_PHASE
    for (int p = 0; p < NPH; ++p) { a.ph_lo = p; a.ph_hi = p + 1; hipLaunchKernelGGL(mega_fwd, dim3(grid), dim3(NWAVES * 64), LDS_BYTES, stream, a); }
#else
    a.ph_lo = 0; a.ph_hi = NPH;
    hipLaunchKernelGGL(mega_fwd, dim3(grid), dim3(NWAVES * 64), LDS_BYTES, stream, a);
#endif
}
```

```cpp
#include <hip/hip_runtime.h>
#include <cstdio>
#include <cstdint>
namespace pg8 {
#define PG8_LAS __attribute__((address_space(3)))
typedef unsigned short bf16_t;
typedef short bf16x8 __attribute__((ext_vector_type(8)));
typedef float f32x4 __attribute__((ext_vector_type(4)));
typedef float f32x2 __attribute__((ext_vector_type(2)));
typedef unsigned u32x4 __attribute__((ext_vector_type(4)));
constexpr int BM = 256, BK = 64, HALF = 128, HTB = HALF * BK * 2  , STAGE_BYTES = 8 * HTB, NXCD = 8, WGM = 8;

__host__ __device__ __forceinline__ int lds_byte(int r, int c) { const int st = (r >> 4) * 2 + (c >> 5), rr = r & 15, cc = c & 31, ob = rr * 64 + cc * 2; return st * 1024 + (ob ^ (((ob >> 9) & 1) << 5)); }
__host__ __device__ __forceinline__ void stage_rc(int b, int& R, int& C) { const int st = b / 1024, sb = b % 1024, swz = sb ^ (((sb >> 9) & 1) << 5); R = (st >> 1) * 16 + swz / 64; C = (st & 1) * 32 + (swz % 64) / 2; }
__host__ __device__ __forceinline__ int perm32(int rho) { const int n = rho >> 4, i = rho & 15; return 8 * (i >> 2) + 4 * n + (i & 3); }

struct Unit { int pm, pn; };
template <int M_, int N_, int K_, int LDA_> struct Gemm { const bf16_t* A; const bf16_t* Bt; static constexpr int M = M_, N = N_, K = K_, lda = LDA_; };

template <int M_, int N_> struct StaticOrder {
    static constexpr int nM = M_ / BM, nN = N_ / BM, nwg = nM * nN; int G, c;
    __host__ __device__ void init(int G_, int c_) { G = G_; c = c_; }
    __host__ __device__ bool next(int i, Unit& u) const {
        const long L = (long)i * G + c; if (L >= nwg) return false;
        int wgid = (int)L; { const int q = nwg / NXCD, r = nwg % NXCD, xcd = wgid % NXCD, off = wgid / NXCD; wgid = (xcd < r ? xcd * (q + 1) : r * (q + 1) + (xcd - r) * q) + off; }
        const int nig = WGM * nN, gid = wgid / nig, fm = gid * WGM, gsz = (nM - fm) < WGM ? (nM - fm) : WGM;
        u.pm = fm + ((wgid % nig) % gsz); u.pn = (wgid % nig) / gsz; return true;
    }
    __device__ __forceinline__ void a_ready(const Unit&) const {}
    __device__ __forceinline__ void done(const Unit&) const {}
};

__device__ __forceinline__ unsigned cvt_pk_bf16(float lo, float hi) { unsigned r; asm volatile("v_cvt_pk_bf16_f32 %0, %1, %2" : "=v"(r) : "v"(lo), "v"(hi)); return r; }

__device__ __forceinline__ float row_rstd4(const float* SS, int row, int fq);
template <int ACT  > struct EpiBf16 {
    static constexpr bool PERM = true, AFTER_DRAIN = false;
    bf16_t* O; int ldc; const float* SS;
    __device__ __forceinline__ void operator()(const f32x4 (&acc)[2][2][4][2], const Unit& u, int wr, int wc, int fr, int fq) const {
        const int row0 = u.pm * BM + wr * 64 + fr; const int col0 = u.pn * BM + wc * 32 + 8 * fq;
#pragma unroll
        for (int ai = 0; ai < 2; ++ai)
#pragma unroll
            for (int m = 0; m < 4; ++m) { bf16_t* rowp = O + (size_t)(row0 + ai * HALF + m * 16) * ldc + col0;
                const float rs = SS ? row_rstd4(SS, row0 + ai * HALF + m * 16, fq) : 1.f;
#pragma unroll
                for (int bj = 0; bj < 2; ++bj) { f32x4 v0 = acc[ai][bj][m][0] * rs, v1 = acc[ai][bj][m][1] * rs;
                    if (ACT == 2) {
#pragma unroll
                        for (int i = 0; i < 4; ++i) { const float a = fmaxf(v0[i], 0.f), b = fmaxf(v1[i], 0.f); v0[i] = a * a; v1[i] = b * b; } }
                    u32x4 w; w.x = cvt_pk_bf16(v0[0], v0[1]); w.y = cvt_pk_bf16(v0[2], v0[3]); w.z = cvt_pk_bf16(v1[0], v1[1]); w.w = cvt_pk_bf16(v1[2], v1[3]);
                    *(u32x4*)(rowp + bj * HALF) = w; } }
    }
};
struct EpiResF32 {
    static constexpr bool PERM = false, AFTER_DRAIN = false;
    const float* base; float* out; int ldc;
    __device__ __forceinline__ void operator()(const f32x4 (&acc)[2][2][4][2], const Unit& u, int wr, int wc, int fr, int fq) const {
        const int col0 = u.pn * BM + wc * 32 + 4 * fq;
#pragma unroll
        for (int ai = 0; ai < 2; ++ai)
#pragma unroll
            for (int m = 0; m < 4; ++m) { const int r = ai * HALF + wr * 64 + m * 16 + fr; const size_t off = (size_t)(u.pm * BM + r) * ldc + col0;
#pragma unroll
                for (int bj = 0; bj < 2; ++bj)
#pragma unroll
                    for (int n = 0; n < 2; ++n) { const f32x4 bs = *(const f32x4*)(base + off + bj * HALF + n * 16); *(f32x4*)(out + off + bj * HALF + n * 16) = bs + acc[ai][bj][m][n]; } }
    }
};

template <int PASS> struct EpiGate {
    static constexpr bool PERM = true, AFTER_DRAIN = false;
    bf16_t* Zg; int ldc; int gboff;
    static __device__ __forceinline__ float sig(float x) { return __builtin_amdgcn_rcpf(1.f + __expf(-x)); }
    static __device__ __forceinline__ float lo(unsigned w) { return __builtin_bit_cast(float, w << 16); }
    static __device__ __forceinline__ float hi(unsigned w) { return __builtin_bit_cast(float, w & 0xffff0000u); }
    __device__ __forceinline__ void operator()(const f32x4 (&acc)[2][2][4][2], const Unit& u, int wr, int wc, int fr, int fq) const {
        const int row0 = u.pm * BM + wr * 64 + fr; const int col0 = u.pn * BM + wc * 32 + 8 * fq;
#pragma unroll
        for (int ai = 0; ai < 2; ++ai)
#pragma unroll
            for (int m = 0; m < 4; ++m) { bf16_t* rowp = Zg + (size_t)(row0 + ai * HALF + m * 16) * ldc + col0;
#pragma unroll
                for (int bj = 0; bj < 2; ++bj) { const f32x4 v0 = acc[ai][bj][m][0], v1 = acc[ai][bj][m][1]; bf16_t* p = rowp + bj * HALF;
                    const u32x4 g = *(const u32x4*)(p + (PASS == 0 ? 0 : gboff));
                    float o[8] = {sig(lo(g.x)) * v0[0], sig(hi(g.x)) * v0[1], sig(lo(g.y)) * v0[2], sig(hi(g.y)) * v0[3], sig(lo(g.z)) * v1[0], sig(hi(g.z)) * v1[1], sig(lo(g.w)) * v1[2], sig(hi(g.w)) * v1[3]};
                    if (PASS == 1) { const u32x4 t = *(const u32x4*)p; o[0] += lo(t.x); o[1] += hi(t.x); o[2] += lo(t.y); o[3] += hi(t.y); o[4] += lo(t.z); o[5] += hi(t.z); o[6] += lo(t.w); o[7] += hi(t.w); }
                    u32x4 w; w.x = cvt_pk_bf16(o[0], o[1]); w.y = cvt_pk_bf16(o[2], o[3]); w.z = cvt_pk_bf16(o[4], o[5]); w.w = cvt_pk_bf16(o[6], o[7]);
                    *(u32x4*)p = w; } }
    }
};
__host__ __device__ __forceinline__ int win_colmap(int rho) {
    const int pn = rho >> 8, bj = (rho >> 7) & 1, p = rho & 127;
    if (pn <= 1) return 256 * pn + 64 * (p >> 5) + (p & 31) + 32 * bj;
    if (pn == 2) return (p < 64) ? 512 + 64 * (p >> 5) + (p & 31) + 32 * bj : 640 + (p - 64) + 64 * bj;
    if (pn <= 4) return 768 + 256 * (pn - 3) + 128 * (p >> 6) + 2 * (p & 63) + bj;
    if (pn <= 6) return 1280 + 256 * (pn - 5) + 128 * (p >> 6) + 2 * (p & 63) + bj;
    return rho;
}
struct EpiWin {
    static constexpr bool PERM = true, AFTER_DRAIN = false;
    bf16_t* Z; int ldc; const f32x2* tabA; const f32x2* tabR; const float* SS;
    __device__ __forceinline__ void operator()(const f32x4 (&acc)[2][2][4][2], const Unit& u, int wr, int wc, int fr, int fq) const {
        const int row0 = u.pm * BM + wr * 64 + fr, pn = u.pn;
        int mode, c0, c1, fb = 0; float sc = 1.f;
        if (pn <= 1)      { mode = 1; c0 = 256 * pn + 64 * wc + 8 * fq; c1 = c0 + 32; fb = 8 * fq; }
        else if (pn == 2) { if (wc < 2) { mode = 1; c0 = 512 + 64 * wc + 8 * fq; c1 = c0 + 32; fb = 8 * fq; } else { mode = 0; c0 = 640 + 32 * (wc - 2) + 8 * fq; c1 = c0 + 64; } }
        else if (pn <= 6) { mode = 2; const int base = (pn <= 4) ? 768 + 256 * (pn - 3) : 1280 + 256 * (pn - 5); c0 = base + 128 * (wc >> 1) + 32 * (wc & 1) + 8 * fq; c1 = c0 + 64; fb = 32 * (wc & 1) + 8 * fq;
                            sc = (pn >= 5) ? 0.08838834764831845f : 1.f; }
        else              { mode = 0; c0 = 256 * pn + 32 * wc + 8 * fq; c1 = c0 + HALF; }
#pragma unroll
        for (int ai = 0; ai < 2; ++ai)
#pragma unroll
            for (int m = 0; m < 4; ++m) { const int row = row0 + ai * HALF + m * 16; bf16_t* rowp = Z + (size_t)row * ldc;
                const float rs = row_rstd4(SS, row, fq), scr = sc * rs;
                f32x4 a0 = acc[ai][0][m][0], a1 = acc[ai][0][m][1], b0 = acc[ai][1][m][0], b1 = acc[ai][1][m][1];
                if (mode == 0) { a0 = a0 * rs; a1 = a1 * rs; b0 = b0 * rs; b1 = b1 * rs; }
                if (mode != 0) {
                    const int pos = row & 4095;
                    const f32x4* tp = (mode == 1) ? (const f32x4*)(tabA + pos * 32 + fb) : (const f32x4*)(tabR + pos * 64 + fb);
                    const f32x4 t0 = tp[0], t1 = tp[1], t2 = tp[2], t3 = tp[3];
                    const f32x4 x0 = a0, x1 = a1, y0 = b0, y1 = b1;
                    a0 = (f32x4){(x0[0] * t0[0] - y0[0] * t0[1]) * scr, (x0[1] * t0[2] - y0[1] * t0[3]) * scr, (x0[2] * t1[0] - y0[2] * t1[1]) * scr, (x0[3] * t1[2] - y0[3] * t1[3]) * scr};
                    a1 = (f32x4){(x1[0] * t2[0] - y1[0] * t2[1]) * scr, (x1[1] * t2[2] - y1[1] * t2[3]) * scr, (x1[2] * t3[0] - y1[2] * t3[1]) * scr, (x1[3] * t3[2] - y1[3] * t3[3]) * scr};
                    b0 = (f32x4){(y0[0] * t0[0] + x0[0] * t0[1]) * scr, (y0[1] * t0[2] + x0[1] * t0[3]) * scr, (y0[2] * t1[0] + x0[2] * t1[1]) * scr, (y0[3] * t1[2] + x0[3] * t1[3]) * scr};
                    b1 = (f32x4){(y1[0] * t2[0] + x1[0] * t2[1]) * scr, (y1[1] * t2[2] + x1[1] * t2[3]) * scr, (y1[2] * t3[0] + x1[2] * t3[1]) * scr, (y1[3] * t3[2] + x1[3] * t3[3]) * scr};
                }
                u32x4 w; w.x = cvt_pk_bf16(a0[0], a0[1]); w.y = cvt_pk_bf16(a0[2], a0[3]); w.z = cvt_pk_bf16(a1[0], a1[1]); w.w = cvt_pk_bf16(a1[2], a1[3]);
                *(u32x4*)(rowp + c0) = w;
                w.x = cvt_pk_bf16(b0[0], b0[1]); w.y = cvt_pk_bf16(b0[2], b0[3]); w.z = cvt_pk_bf16(b1[0], b1[1]); w.w = cvt_pk_bf16(b1[2], b1[3]);
                *(u32x4*)(rowp + c1) = w; }
    }
};

__device__ __forceinline__ float row_rstd(const float* SS, int row) {
    const f32x4* s = (const f32x4*)(SS + (size_t)row * 16); const f32x4 a = s[0], b = s[1], c = s[2], d = s[3];
    const float t = ((a[0] + a[1]) + (a[2] + a[3])) + ((b[0] + b[1]) + (b[2] + b[3])) + ((c[0] + c[1]) + (c[2] + c[3])) + ((d[0] + d[1]) + (d[2] + d[3]));
    return 1.0f / sqrtf(t * (1.0f / 1024.0f) + 1e-6f);
}
__device__ __forceinline__ float row_rstd4(const float* SS, int row, int fq) {
    const f32x4 a = *(const f32x4*)(SS + (size_t)row * 16 + 4 * fq);
    float t = (a[0] + a[1]) + (a[2] + a[3]);
    t += __shfl_xor(t, 16); t += __shfl_xor(t, 32);
    return 1.0f / sqrtf(t * (1.0f / 1024.0f) + 1e-6f);
}
struct EpiResBf16 {
    static constexpr bool PERM = true, AFTER_DRAIN = false;
    bf16_t* X; float* SS; int ldc;
    static __device__ __forceinline__ float lo(unsigned w) { return __builtin_bit_cast(float, w << 16); }
    static __device__ __forceinline__ float hi(unsigned w) { return __builtin_bit_cast(float, w & 0xffff0000u); }
    __device__ __forceinline__ void operator()(const f32x4 (&acc)[2][2][4][2], const Unit& u, int wr, int wc, int fr, int fq) const {
        const int row0 = u.pm * BM + wr * 64 + fr; const int col0 = u.pn * BM + wc * 32 + 8 * fq;
#pragma unroll
        for (int ai = 0; ai < 2; ++ai)
#pragma unroll
            for (int m = 0; m < 4; ++m) { const int row = row0 + ai * HALF + m * 16; bf16_t* rowp = X + (size_t)row * ldc + col0; float ss = 0.f;
#pragma unroll
                for (int bj = 0; bj < 2; ++bj) { bf16_t* p = rowp + bj * HALF; const u32x4 b = *(const u32x4*)p; const f32x4 v0 = acc[ai][bj][m][0], v1 = acc[ai][bj][m][1];
                    const float o0 = lo(b.x) + v0[0], o1 = hi(b.x) + v0[1], o2 = lo(b.y) + v0[2], o3 = hi(b.y) + v0[3], o4 = lo(b.z) + v1[0], o5 = hi(b.z) + v1[1], o6 = lo(b.w) + v1[2], o7 = hi(b.w) + v1[3];
                    ss += ((o0 * o0 + o1 * o1) + (o2 * o2 + o3 * o3)) + ((o4 * o4 + o5 * o5) + (o6 * o6 + o7 * o7));
                    u32x4 w; w.x = cvt_pk_bf16(o0, o1); w.y = cvt_pk_bf16(o2, o3); w.z = cvt_pk_bf16(o4, o5); w.w = cvt_pk_bf16(o6, o7);
                    *(u32x4*)p = w; }
                ss += __shfl_xor(ss, 16); ss += __shfl_xor(ss, 32);
                if (fq == 0) SS[(size_t)row * 16 + u.pn * 4 + wc] = ss; }
    }
};

template <class Epi, class Sched, bool ALIGN_EPI, bool SP2, class GemmT>
__device__ __forceinline__ void gemm_phase(PG8_LAS unsigned char* lds, const GemmT g, const Sched& S, const Epi& E) {
    int tid_ = threadIdx.x; asm volatile("" : "+v"(tid_));
    const int tid = tid_, wid = __builtin_amdgcn_readfirstlane(tid >> 6), lane = tid & 63, wr = wid >> 2, wc = wid & 3, fr = lane & 15, fq = lane >> 4;
    constexpr int K = GemmT::K, nt = K / BK, lda = GemmT::lda;
    unsigned voffA[2], voffB[2];
#pragma unroll
    for (int i = 0; i < 2; ++i) { int R, C; stage_rc(tid * 16 + i * 8192, R, C); const int Rb = Epi::PERM ? ((R & ~31) + perm32(R & 31)) : R;
        voffA[i] = (unsigned)(R * lda + C) * 2u; voffB[i] = (unsigned)(Rb * K + C) * 2u; }
    constexpr size_t kstep = (size_t)(BK * 2);
    constexpr size_t hstepA = (size_t)HALF * lda * 2, hstepB = (size_t)HALF * K * 2;
    constexpr size_t tstepA = 2 * hstepA, tstepB = 2 * hstepB;
    const unsigned ldsw = (unsigned)wid * 1024u;
    const int aoff = lds_byte(wr * 64 + fr, fq * 8), boff = lds_byte(wc * 32 + fr, fq * 8);
#define PG8_SA(b, h) (((b) * 2 + (h)) * HTB)
#define PG8_SB(b, h) ((4 + (b) * 2 + (h)) * HTB)
#define PG8_STAGE(bufoff, gbase, voff) do { _Pragma("unroll") for (int _i = 0; _i < 2; ++_i) \
        __builtin_amdgcn_global_load_lds((const unsigned*)((const char*)(gbase) + (voff)[_i]), (PG8_LAS unsigned*)(lds + (bufoff) + ldsw + _i * 8192), 16, 0, 0); } while (0)
#define PG8_LDA(dst, b, h) do { _Pragma("unroll") for (int m = 0; m < 4; ++m) _Pragma("unroll") for (int k = 0; k < 2; ++k) dst[m][k] = *(const PG8_LAS bf16x8*)(lds + PG8_SA(b, h) + aoff + m * 2048 + k * 1024); } while (0)
#define PG8_LDB(dst, b, h) do { _Pragma("unroll") for (int n = 0; n < 2; ++n) _Pragma("unroll") for (int k = 0; k < 2; ++k) dst[n][k] = *(const PG8_LAS bf16x8*)(lds + PG8_SB(b, h) + boff + n * 2048 + k * 1024); } while (0)
#define PG8_MMA(ai, bj, At, Bt) do { __builtin_amdgcn_s_setprio(1); _Pragma("unroll") for (int m = 0; m < 4; ++m) _Pragma("unroll") for (int n = 0; n < 2; ++n) _Pragma("unroll") for (int k = 0; k < 2; ++k) \
        acc[ai][bj][m][n] = __builtin_amdgcn_mfma_f32_16x16x32_bf16(Bt[n][k], At[m][k], acc[ai][bj][m][n], 0, 0, 0); __builtin_amdgcn_s_setprio(0); } while (0)
#define PG8_WAIT_V(n) asm volatile("s_waitcnt vmcnt(" #n ")" ::: "memory")
#define PG8_WAIT_L(n) asm volatile("s_waitcnt lgkmcnt(" #n ")" ::: "memory")
#define PG8_BAR __builtin_amdgcn_s_barrier()
#define PG8_SCHED __builtin_amdgcn_sched_barrier(0)
    Unit cur, nxt; int ui = 0;
    if (!S.next(0, cur)) return;
    f32x4 acc[2][2][4][2];
#pragma unroll
    for (int a = 0; a < 2; ++a)
#pragma unroll
        for (int b = 0; b < 2; ++b)
#pragma unroll
            for (int m = 0; m < 4; ++m)
#pragma unroll
                for (int n = 0; n < 2; ++n) acc[a][b][m][n] = (f32x4){0.f, 0.f, 0.f, 0.f};
    bf16x8 At[4][2], B0[2][2], B1[2][2];
    const char* cA = (const char*)g.A + (size_t)cur.pm * tstepA; const char* cB = (const char*)g.Bt + (size_t)cur.pn * tstepB;
    S.a_ready(cur);
    if constexpr (SP2) {
        PG8_STAGE(PG8_SB(0, 0), cB, voffB); PG8_STAGE(PG8_SB(0, 1), cB + hstepB, voffB); PG8_STAGE(PG8_SA(0, 0), cA, voffA); PG8_STAGE(PG8_SA(0, 1), cA + hstepA, voffA);
        if (wr == 1) PG8_BAR;
        PG8_WAIT_V(2); PG8_BAR;
        PG8_STAGE(PG8_SB(1, 0), cB + kstep, voffB); PG8_STAGE(PG8_SA(1, 0), cA + kstep, voffA); PG8_STAGE(PG8_SB(1, 1), cB + hstepB + kstep, voffB);
        PG8_WAIT_V(6); PG8_BAR;
    } else {
        PG8_STAGE(PG8_SB(0, 0), cB, voffB); PG8_STAGE(PG8_SA(0, 0), cA, voffA); PG8_STAGE(PG8_SB(0, 1), cB + hstepB, voffB); PG8_STAGE(PG8_SA(0, 1), cA + hstepA, voffA);
        if (wr == 1) PG8_BAR;
        PG8_WAIT_V(4); PG8_BAR;
        PG8_STAGE(PG8_SB(1, 0), cB + kstep, voffB); PG8_STAGE(PG8_SA(1, 0), cA + kstep, voffA); PG8_STAGE(PG8_SB(1, 1), cB + hstepB + kstep, voffB);
        PG8_WAIT_V(6); PG8_BAR;
    }
    for (;;) {
        const bool has_next = S.next(ui + 1, nxt);
        const char* nA = has_next ? (const char*)g.A + (size_t)nxt.pm * tstepA : cA; const char* nB = has_next ? (const char*)g.Bt + (size_t)nxt.pn * tstepB : cB;
#pragma unroll 1
        for (int t = 0; t < nt; t += 2) {
            const bool last = (t == nt - 2);
            const char* a1 = cA + (size_t)(t + 1) * kstep;
            const char* a2 = last ? nA : cA + (size_t)(t + 2) * kstep; const char* b2 = last ? nB : cB + (size_t)(t + 2) * kstep;
            const char* a3 = a2 + kstep; const char* b3 = b2 + kstep;
            if (last && has_next) S.a_ready(nxt);
            if constexpr (SP2) {
            PG8_LDB(B0, 0, 0); PG8_LDB(B1, 0, 1); PG8_SCHED; PG8_LDA(At, 0, 0); PG8_STAGE(PG8_SA(1, 1), a1 + hstepA, voffA);
            PG8_WAIT_V(8); PG8_WAIT_L(0); PG8_BAR; PG8_MMA(0, 0, At, B0); PG8_MMA(0, 1, At, B1); PG8_BAR; PG8_SCHED;
            PG8_LDA(At, 0, 1); PG8_STAGE(PG8_SB(0, 0), b2, voffB); PG8_STAGE(PG8_SB(0, 1), b2 + hstepB, voffB); PG8_STAGE(PG8_SA(0, 0), a2, voffA);
            PG8_WAIT_V(8); PG8_WAIT_L(0); PG8_BAR; PG8_MMA(1, 0, At, B0); PG8_MMA(1, 1, At, B1); PG8_BAR; PG8_SCHED;
            PG8_LDB(B0, 1, 0); PG8_LDB(B1, 1, 1); PG8_SCHED; PG8_LDA(At, 1, 0); PG8_STAGE(PG8_SA(0, 1), a2 + hstepA, voffA);
            PG8_WAIT_V(8); PG8_WAIT_L(0); PG8_BAR; PG8_MMA(0, 0, At, B0); PG8_MMA(0, 1, At, B1); PG8_BAR; PG8_SCHED;
            PG8_LDA(At, 1, 1); PG8_STAGE(PG8_SB(1, 0), b3, voffB); PG8_STAGE(PG8_SB(1, 1), b3 + hstepB, voffB); PG8_STAGE(PG8_SA(1, 0), a3, voffA);
            PG8_WAIT_V(8); PG8_WAIT_L(0); PG8_BAR; PG8_MMA(1, 0, At, B0); PG8_MMA(1, 1, At, B1); PG8_BAR; PG8_SCHED;
            } else {
            PG8_LDB(B0, 0, 0); PG8_SCHED; PG8_LDA(At, 0, 0); PG8_STAGE(PG8_SA(1, 1), a1 + hstepA, voffA);
            PG8_WAIT_L(8); PG8_BAR; PG8_WAIT_L(0); PG8_MMA(0, 0, At, B0); PG8_BAR; PG8_SCHED;
            PG8_LDB(B1, 0, 1); PG8_STAGE(PG8_SB(0, 0), b2, voffB);
            PG8_BAR; PG8_WAIT_L(0); PG8_MMA(0, 1, At, B1); PG8_BAR;
            PG8_LDA(At, 0, 1); PG8_STAGE(PG8_SA(0, 0), a2, voffA);
            PG8_BAR; PG8_WAIT_L(0); PG8_MMA(1, 0, At, B0); PG8_BAR; PG8_SCHED;
            PG8_STAGE(PG8_SB(0, 1), b2 + hstepB, voffB);
            PG8_WAIT_V(6); PG8_BAR; PG8_MMA(1, 1, At, B1); PG8_BAR;
            PG8_LDB(B0, 1, 0); PG8_SCHED; PG8_LDA(At, 1, 0); PG8_STAGE(PG8_SA(0, 1), a2 + hstepA, voffA);
            PG8_WAIT_L(8); PG8_BAR; PG8_WAIT_L(0); PG8_MMA(0, 0, At, B0); PG8_BAR; PG8_SCHED;
            PG8_LDB(B1, 1, 1); PG8_STAGE(PG8_SB(1, 0), b3, voffB);
            PG8_BAR; PG8_WAIT_L(0); PG8_MMA(0, 1, At, B1); PG8_BAR;
            PG8_LDA(At, 1, 1); PG8_STAGE(PG8_SA(1, 0), a3, voffA);
            PG8_BAR; PG8_WAIT_L(0); PG8_MMA(1, 0, At, B0); PG8_BAR; PG8_SCHED;
            PG8_STAGE(PG8_SB(1, 1), b3 + hstepB, voffB);
            PG8_WAIT_V(6); PG8_BAR; PG8_MMA(1, 1, At, B1); PG8_BAR;
            }
        }
        if constexpr (ALIGN_EPI) { if (wr == 0) PG8_BAR; }
        if constexpr (!Epi::AFTER_DRAIN) { E(acc, cur, wr, wc, fr, fq); S.done(cur); }
        if (!has_next) break;
#pragma unroll
        for (int a = 0; a < 2; ++a)
#pragma unroll
            for (int b = 0; b < 2; ++b)
#pragma unroll
                for (int m = 0; m < 4; ++m)
#pragma unroll
                    for (int n = 0; n < 2; ++n) acc[a][b][m][n] = (f32x4){0.f, 0.f, 0.f, 0.f};
        cur = nxt; cA = nA; cB = nB; ++ui;
        if constexpr (ALIGN_EPI) { if (wr == 1) PG8_BAR; }
    }
    PG8_WAIT_V(0);
    if constexpr (!ALIGN_EPI) { if (wr == 0) PG8_BAR; }
    PG8_BAR;
    if constexpr (Epi::AFTER_DRAIN) { E.fused(acc, cur, wr, wc, fr, fq, lds, wid, lane); S.done(cur); }
#undef PG8_SA
#undef PG8_SB
#undef PG8_STAGE
#undef PG8_LDA
#undef PG8_LDB
#undef PG8_MMA
#undef PG8_WAIT_V
#undef PG8_WAIT_L
#undef PG8_BAR
#undef PG8_SCHED
}
template <int M_, int N_, int K1, int K2, int LDA, class Sched>
__device__ __forceinline__ void gemm_phase_gate(PG8_LAS unsigned char* lds, const bf16_t* A1, const bf16_t* B1t, const bf16_t* A2, const bf16_t* B2t, bf16_t* Zg, int ldc, int gboff, const Sched& S) {
    int tid_ = threadIdx.x; asm volatile("" : "+v"(tid_));
    const int tid = tid_, wid = __builtin_amdgcn_readfirstlane(tid >> 6), lane = tid & 63, wr = wid >> 2, wc = wid & 3, fr = lane & 15, fq = lane >> 4;
    constexpr int NT1 = K1 / BK, nt = (K1 + K2) / BK, lda = LDA;
    static_assert(NT1 % 2 == 0 && nt % 2 == 0, "segments are whole loop trips");
    unsigned voffA[2], voffB1[2], voffB2[2];
#pragma unroll
    for (int i = 0; i < 2; ++i) { int R, C; stage_rc(tid * 16 + i * 8192, R, C); const int Rb = (R & ~31) + perm32(R & 31);
        voffA[i] = (unsigned)(R * lda + C) * 2u; voffB1[i] = (unsigned)(Rb * K1 + C) * 2u; voffB2[i] = (unsigned)(Rb * K2 + C) * 2u; }
    constexpr size_t kstep = (size_t)(BK * 2);
    constexpr size_t hstepA = (size_t)HALF * lda * 2, hstepB1 = (size_t)HALF * K1 * 2, hstepB2 = (size_t)HALF * K2 * 2;
    constexpr size_t tstepA = 2 * hstepA, tstepB1 = 2 * hstepB1, tstepB2 = 2 * hstepB2;
    const unsigned ldsw = (unsigned)wid * 1024u;
    const int aoff = lds_byte(wr * 64 + fr, fq * 8), boff = lds_byte(wc * 32 + fr, fq * 8);
#define PG8_SA(b, h) (((b) * 2 + (h)) * HTB)
#define PG8_SB(b, h) ((4 + (b) * 2 + (h)) * HTB)
#define PG8_STAGE(bufoff, gbase, voff) do { _Pragma("unroll") for (int _i = 0; _i < 2; ++_i) \
        __builtin_amdgcn_global_load_lds((const unsigned*)((const char*)(gbase) + (voff)[_i]), (PG8_LAS unsigned*)(lds + (bufoff) + ldsw + _i * 8192), 16, 0, 0); } while (0)
#define PG8_LDA(dst, b, h) do { _Pragma("unroll") for (int m = 0; m < 4; ++m) _Pragma("unroll") for (int k = 0; k < 2; ++k) dst[m][k] = *(const PG8_LAS bf16x8*)(lds + PG8_SA(b, h) + aoff + m * 2048 + k * 1024); } while (0)
#define PG8_LDB(dst, b, h) do { _Pragma("unroll") for (int n = 0; n < 2; ++n) _Pragma("unroll") for (int k = 0; k < 2; ++k) dst[n][k] = *(const PG8_LAS bf16x8*)(lds + PG8_SB(b, h) + boff + n * 2048 + k * 1024); } while (0)
#define PG8_MMA(ai, bj, At, Bt) do { __builtin_amdgcn_s_setprio(1); _Pragma("unroll") for (int m = 0; m < 4; ++m) _Pragma("unroll") for (int n = 0; n < 2; ++n) _Pragma("unroll") for (int k = 0; k < 2; ++k) \
        acc[ai][bj][m][n] = __builtin_amdgcn_mfma_f32_16x16x32_bf16(Bt[n][k], At[m][k], acc[ai][bj][m][n], 0, 0, 0); __builtin_amdgcn_s_setprio(0); } while (0)
#define PG8_WAIT_V(n) asm volatile("s_waitcnt vmcnt(" #n ")" ::: "memory")
#define PG8_WAIT_L(n) asm volatile("s_waitcnt lgkmcnt(" #n ")" ::: "memory")
#define PG8_BAR __builtin_amdgcn_s_barrier()
#define PG8_SCHED __builtin_amdgcn_sched_barrier(0)
    Unit cur, nxt; int ui = 0;
    if (!S.next(0, cur)) return;
    f32x4 acc[2][2][4][2];
#pragma unroll
    for (int a = 0; a < 2; ++a)
#pragma unroll
        for (int b = 0; b < 2; ++b)
#pragma unroll
            for (int m = 0; m < 4; ++m)
#pragma unroll
                for (int n = 0; n < 2; ++n) acc[a][b][m][n] = (f32x4){0.f, 0.f, 0.f, 0.f};
    bf16x8 At[4][2], B0[2][2], B1[2][2];
    const char* cA1 = (const char*)A1 + (size_t)cur.pm * tstepA; const char* cB1 = (const char*)B1t + (size_t)cur.pn * tstepB1;
    const char* cA2 = (const char*)A2 + (size_t)cur.pm * tstepA; const char* cB2 = (const char*)B2t + (size_t)cur.pn * tstepB2;
    PG8_STAGE(PG8_SB(0, 0), cB1, voffB1); PG8_STAGE(PG8_SB(0, 1), cB1 + hstepB1, voffB1); PG8_STAGE(PG8_SA(0, 0), cA1, voffA); PG8_STAGE(PG8_SA(0, 1), cA1 + hstepA, voffA);
    if (wr == 1) PG8_BAR;
    PG8_WAIT_V(2); PG8_BAR;
    PG8_STAGE(PG8_SB(1, 0), cB1 + kstep, voffB1); PG8_STAGE(PG8_SA(1, 0), cA1 + kstep, voffA); PG8_STAGE(PG8_SB(1, 1), cB1 + hstepB1 + kstep, voffB1);
    PG8_WAIT_V(6); PG8_BAR;
    for (;;) {
        const bool has_next = S.next(ui + 1, nxt);
        const char* nA1 = has_next ? (const char*)A1 + (size_t)nxt.pm * tstepA : cA1; const char* nB1 = has_next ? (const char*)B1t + (size_t)nxt.pn * tstepB1 : cB1;
        const int row0 = cur.pm * BM + wr * 64 + fr, col0 = cur.pn * BM + wc * 32 + 8 * fq;
#pragma unroll 1
        for (int t = 0; t < nt; t += 2) {
            const bool last = (t == nt - 2);
            const bool seg2 = (t >= NT1);
            const bool nseg2 = !last && (t + 2 >= NT1);
            const char* a1 = seg2 ? cA2 + (size_t)(t + 1 - NT1) * kstep : cA1 + (size_t)(t + 1) * kstep;
            const char* a2 = last ? nA1 : (nseg2 ? cA2 + (size_t)(t + 2 - NT1) * kstep : cA1 + (size_t)(t + 2) * kstep);
            const char* b2 = last ? nB1 : (nseg2 ? cB2 + (size_t)(t + 2 - NT1) * kstep : cB1 + (size_t)(t + 2) * kstep);
            const char* a3 = a2 + kstep; const char* b3 = b2 + kstep;
            unsigned vB[2]; vB[0] = nseg2 ? voffB2[0] : voffB1[0]; vB[1] = nseg2 ? voffB2[1] : voffB1[1];
            const size_t hB = nseg2 ? hstepB2 : hstepB1;
            if (t == NT1) {
#pragma unroll
                for (int ai = 0; ai < 2; ++ai)
#pragma unroll
                    for (int m = 0; m < 4; ++m) { const bf16_t* rowp = Zg + (size_t)(row0 + ai * HALF + m * 16) * ldc + col0;
#pragma unroll
                        for (int bj = 0; bj < 2; ++bj) { const bf16_t* pp = rowp + bj * HALF; const u32x4 ga = *(const u32x4*)pp, gb = *(const u32x4*)(pp + gboff);
#define PG8_RHO(GA, GB, LOHI) ((1.f + __expf(-EpiGate<0>::LOHI(GB))) * __builtin_amdgcn_rcpf(1.f + __expf(-EpiGate<0>::LOHI(GA))))
                            f32x4 r0 = {PG8_RHO(ga.x, gb.x, lo), PG8_RHO(ga.x, gb.x, hi), PG8_RHO(ga.y, gb.y, lo), PG8_RHO(ga.y, gb.y, hi)};
                            f32x4 r1 = {PG8_RHO(ga.z, gb.z, lo), PG8_RHO(ga.z, gb.z, hi), PG8_RHO(ga.w, gb.w, lo), PG8_RHO(ga.w, gb.w, hi)};
#undef PG8_RHO
                            acc[ai][bj][m][0] = acc[ai][bj][m][0] * r0; acc[ai][bj][m][1] = acc[ai][bj][m][1] * r1; } }
            }
            PG8_LDB(B0, 0, 0); PG8_LDB(B1, 0, 1); PG8_SCHED; PG8_LDA(At, 0, 0); PG8_STAGE(PG8_SA(1, 1), a1 + hstepA, voffA);
            PG8_WAIT_V(8); PG8_WAIT_L(0); PG8_BAR; PG8_MMA(0, 0, At, B0); PG8_MMA(0, 1, At, B1); PG8_BAR; PG8_SCHED;
            PG8_LDA(At, 0, 1); PG8_STAGE(PG8_SB(0, 0), b2, vB); PG8_STAGE(PG8_SB(0, 1), b2 + hB, vB); PG8_STAGE(PG8_SA(0, 0), a2, voffA);
            PG8_WAIT_V(8); PG8_WAIT_L(0); PG8_BAR; PG8_MMA(1, 0, At, B0); PG8_MMA(1, 1, At, B1); PG8_BAR; PG8_SCHED;
            PG8_LDB(B0, 1, 0); PG8_LDB(B1, 1, 1); PG8_SCHED; PG8_LDA(At, 1, 0); PG8_STAGE(PG8_SA(0, 1), a2 + hstepA, voffA);
            PG8_WAIT_V(8); PG8_WAIT_L(0); PG8_BAR; PG8_MMA(0, 0, At, B0); PG8_MMA(0, 1, At, B1); PG8_BAR; PG8_SCHED;
            PG8_LDA(At, 1, 1); PG8_STAGE(PG8_SB(1, 0), b3, vB); PG8_STAGE(PG8_SB(1, 1), b3 + hB, vB); PG8_STAGE(PG8_SA(1, 0), a3, voffA);
            PG8_WAIT_V(8); PG8_WAIT_L(0); PG8_BAR; PG8_MMA(1, 0, At, B0); PG8_MMA(1, 1, At, B1); PG8_BAR; PG8_SCHED;
        }
        if (wr == 0) PG8_BAR;
        {
#pragma unroll
            for (int ai = 0; ai < 2; ++ai)
#pragma unroll
                for (int m = 0; m < 4; ++m) { bf16_t* rowp = Zg + (size_t)(row0 + ai * HALF + m * 16) * ldc + col0;
#pragma unroll
                    for (int bj = 0; bj < 2; ++bj) { bf16_t* pp = rowp + bj * HALF; const u32x4 gb = *(const u32x4*)(pp + gboff); const f32x4 v0 = acc[ai][bj][m][0], v1 = acc[ai][bj][m][1];
                        u32x4 w;
                        w.x = cvt_pk_bf16(EpiGate<0>::sig(EpiGate<0>::lo(gb.x)) * v0[0], EpiGate<0>::sig(EpiGate<0>::hi(gb.x)) * v0[1]); w.y = cvt_pk_bf16(EpiGate<0>::sig(EpiGate<0>::lo(gb.y)) * v0[2], EpiGate<0>::sig(EpiGate<0>::hi(gb.y)) * v0[3]);
                        w.z = cvt_pk_bf16(EpiGate<0>::sig(EpiGate<0>::lo(gb.z)) * v1[0], EpiGate<0>::sig(EpiGate<0>::hi(gb.z)) * v1[1]); w.w = cvt_pk_bf16(EpiGate<0>::sig(EpiGate<0>::lo(gb.w)) * v1[2], EpiGate<0>::sig(EpiGate<0>::hi(gb.w)) * v1[3]);
                        *(u32x4*)pp = w; } }
        }
        if (!has_next) break;
#pragma unroll
        for (int a = 0; a < 2; ++a)
#pragma unroll
            for (int b = 0; b < 2; ++b)
#pragma unroll
                for (int m = 0; m < 4; ++m)
#pragma unroll
                    for (int n = 0; n < 2; ++n) acc[a][b][m][n] = (f32x4){0.f, 0.f, 0.f, 0.f};
        cur = nxt; cA1 = nA1; cB1 = nB1;
        cA2 = (const char*)A2 + (size_t)cur.pm * tstepA; cB2 = (const char*)B2t + (size_t)cur.pn * tstepB2; ++ui;
        if (wr == 1) PG8_BAR;
    }
    PG8_WAIT_V(0);
    PG8_BAR;
#undef PG8_SA
#undef PG8_SB
#undef PG8_STAGE
#undef PG8_LDA
#undef PG8_LDB
#undef PG8_MMA
#undef PG8_WAIT_V
#undef PG8_WAIT_L
#undef PG8_BAR
#undef PG8_SCHED
}
}
constexpr int NWAVES = 8;
constexpr int BATCH = 8, SEQ = 4096, D = 1024, M = BATCH * SEQ, NZ = 5888, FF = 4096, DEPTH = 2;
constexpr int C_AQ = 0, C_AK = 512, C_AV = 640, C_RQ = 768, C_RK = 1280, C_RV = 1792, C_RG = 2816, C_GA = 3840, C_GB = 4864;
constexpr int C_YA = 768, C_YB = 1792;
constexpr float EPS = 1e-6f;

constexpr size_t MiB = 1u << 20;
constexpr size_t WS_CTL = 0, CTL_ZERO_BYTES = 1 * MiB;
constexpr size_t WS_TABA = 1 * MiB, WS_TABR = 2 * MiB;
constexpr size_t WS_SS = 4 * MiB;
constexpr size_t WS_W = 6 * MiB;
constexpr size_t W_WIN = 0, W_WA = 6029312, W_WB = 6553600, W_WOUT = 7602176, W_WUP = 8650752, W_WDOWN = 12845056, W_LAYER = 17039360;
constexpr size_t WS_H = 71 * MiB;
constexpr size_t WS_Z = 135 * MiB;
constexpr size_t WS_END = 503 * MiB;
static_assert(WS_W + 2 * W_LAYER * 2 <= WS_H && WS_H + (size_t)M * D * 2 <= WS_Z && WS_Z + (size_t)M * NZ * 2 <= WS_END, "d_ws map");
constexpr int CW_BAR = 4096;

constexpr int RING_OFF = 0, RING_BYTES = 131072;
constexpr int LDSCTL_OFF = RING_BYTES, MISC_OFF = LDSCTL_OFF + 320;
constexpr int LDS_BYTES = 147456;

#define GAS __attribute__((address_space(1)))
#define LAS __attribute__((address_space(3)))
typedef unsigned short bf16;
typedef unsigned v4u __attribute__((ext_vector_type(4)));
typedef unsigned v2u __attribute__((ext_vector_type(2)));
typedef float f32x4 __attribute__((ext_vector_type(4)));
typedef float f32x2 __attribute__((ext_vector_type(2)));
#define LDS_WAIT() asm volatile("s_waitcnt lgkmcnt(0)" ::: "memory")
#define VM_WAIT() asm volatile("s_waitcnt vmcnt(0)" ::: "memory")
__device__ __forceinline__ unsigned f2bf(float f) { unsigned u = __builtin_bit_cast(unsigned, f); return (u + 0x7fffu + ((u >> 16) & 1u)) >> 16; }
__device__ __forceinline__ unsigned pk2(float lo, float hi) { return f2bf(lo) | (f2bf(hi) << 16); }
__device__ __forceinline__ float bf2f(unsigned short b) { return __builtin_bit_cast(float, (unsigned)b << 16); }
__device__ __forceinline__ float bflo(unsigned w) { return __builtin_bit_cast(float, w << 16); }
__device__ __forceinline__ float bfhi(unsigned w) { return __builtin_bit_cast(float, w & 0xffff0000u); }

#define XB_TMO      128
#define XB_XCNT(j)  (256  + 64 * (j))
#define XB_XSUB(j)  (1280 + 64 * (j))
#define XB_XGEN(j)  (2304 + 64 * (j))
#define XB_TOP      3328
#define XB_TOPGEN   3392
#define XCD_BAR_WORDS 3456
#define XB_SPIN_CAP (1u << 24)

__device__ __forceinline__ unsigned xb_ld(unsigned* p)              { return __hip_atomic_load(p, __ATOMIC_RELAXED, __HIP_MEMORY_SCOPE_AGENT); }
__device__ __forceinline__ unsigned xb_add(unsigned* p, unsigned v) { return __hip_atomic_fetch_add(p, v, __ATOMIC_RELAXED, __HIP_MEMORY_SCOPE_AGENT); }
__device__ __forceinline__ unsigned xb_xcc_id() { return (unsigned)__builtin_amdgcn_s_getreg((3 << 11) | 20) & 0xFu; }
#define XB_SPIN(cond, bar) do { unsigned _sp = 0; while (cond) { __builtin_amdgcn_s_sleep(1); \
    if ((++_sp & 255u) == 0u) { if (xb_ld(&(bar)[XB_TMO])) break; if (_sp > XB_SPIN_CAP) { atomicAdd(&(bar)[XB_TMO], 1u); break; } } } } while (0)

struct XcdBarrier { unsigned* bar; unsigned x; volatile LAS unsigned* st; };

__device__ __forceinline__ XcdBarrier xcd_barrier_post(unsigned* bar, volatile LAS unsigned* st) {
    XcdBarrier b; b.bar = bar; b.x = xb_xcc_id(); b.st = st;
    if (threadIdx.x == 0) (void)xb_add(&bar[XB_XCNT(b.x)], 1u);
    return b;
}
__device__ __forceinline__ void xcd_barrier_complete(unsigned* bar, unsigned x, unsigned& nloc, unsigned& nx) {
    const unsigned G = gridDim.x * gridDim.y * gridDim.z;
    unsigned sum, cnt, mine, sp = 0u;
    for (;;) {
        sum = 0u; cnt = 0u; mine = 0u;
#pragma unroll 1
        for (unsigned j = 0; j < 16; ++j) { const unsigned c = xb_ld(&bar[XB_XCNT(j)]); sum += c; cnt += (c > 0u) ? 1u : 0u; mine = (j == x) ? c : mine; }
        if (sum == G) break;
        __builtin_amdgcn_s_sleep(1);
        if ((++sp & 255u) == 0u) { if (xb_ld(&bar[XB_TMO])) break; if (sp > XB_SPIN_CAP) { atomicAdd(&bar[XB_TMO], 1u); break; } }
    }
    nloc = mine > 0u ? mine : 1u; nx = cnt > 0u ? cnt : 1u;
}
__device__ __forceinline__ void xcd_barrier_census(const XcdBarrier& b) {
    if (threadIdx.x == 0) { unsigned nloc, nx; xcd_barrier_complete(b.bar, b.x, nloc, nx); b.st[0] = nloc; b.st[1] = nx; }
    __syncthreads();
}
__device__ __forceinline__ void xcd_barrier(const XcdBarrier& b) {
    asm volatile("s_waitcnt vmcnt(0)" ::: "memory");
    __syncthreads();
    if (threadIdx.x == 0) {
        unsigned* bar = b.bar;
        __builtin_amdgcn_s_waitcnt(0);
        const unsigned nloc = b.st[0], nx = b.st[1];
        const unsigned old = xb_add(&bar[XB_XSUB(b.x)], 1u);
        const unsigned gen = old / nloc;
        if (old + 1u == (gen + 1u) * nloc) {
            __builtin_amdgcn_fence(__ATOMIC_RELEASE, "agent");
            asm volatile("s_waitcnt vmcnt(0)" ::: "memory");
            const unsigned og = xb_add(&bar[XB_TOP], 1u);
            const unsigned tg = og / nx;
            if (og + 1u == (tg + 1u) * nx) xb_add(&bar[XB_TOPGEN], 1u);
            else XB_SPIN(xb_ld(&bar[XB_TOPGEN]) == tg, bar);
            __builtin_amdgcn_fence(__ATOMIC_ACQUIRE, "agent");
            xb_add(&bar[XB_XGEN(b.x)], 1u);
            asm volatile("s_waitcnt vmcnt(0)" ::: "memory");
        } else {
            XB_SPIN(xb_ld(&bar[XB_XGEN(b.x)]) == gen, bar);
            __builtin_amdgcn_fence(__ATOMIC_ACQUIRE, "agent");
            asm volatile("s_waitcnt vmcnt(0)" ::: "memory");
        }
    }
    __syncthreads();
}

__device__ __forceinline__ float wave_sum(float v) {
#pragma unroll
    for (int o = 1; o < 64; o <<= 1) v += __shfl_xor(v, o);
    return v;
}
template <bool WINMAP> __device__ __forceinline__ void p0_transpose_item(const float* W, int K, int N, bf16* WT, LAS float* scr, int item, int lane, const float* gk = nullptr) {
    const int nblk = N / 32, kb = item / nblk, nb = item % nblk, k0 = 64 * kb, n0 = 32 * nb;
    const int srcc = WINMAP ? pg8::win_colmap(n0 + (lane & 31)) : n0 + (lane & 31);
    float wv[32];
#pragma unroll
    for (int i = 0; i < 32; ++i) { const int kk = 2 * i + (lane >> 5); wv[i] = W[(size_t)(k0 + kk) * N + srcc]; }
    if (gk) {
#pragma unroll
        for (int i = 0; i < 32; ++i) wv[i] *= gk[k0 + 2 * i + (lane >> 5)];
    }
#pragma unroll
    for (int i = 0; i < 32; ++i) { const int kk = 2 * i + (lane >> 5); scr[kk * 33 + (lane & 31)] = wv[i]; }
    LDS_WAIT(); asm volatile("" ::: "memory");
    const int c = lane & 7;
#pragma unroll
    for (int j = 0; j < 4; ++j) { const int n = (lane >> 3) + 8 * j; const LAS float* s = scr + (8 * c) * 33 + n;
        v4u o; o.x = pk2(s[0 * 33], s[1 * 33]); o.y = pk2(s[2 * 33], s[3 * 33]); o.z = pk2(s[4 * 33], s[5 * 33]); o.w = pk2(s[6 * 33], s[7 * 33]);
        *(GAS v4u*)(WT + (size_t)(n0 + n) * K + k0 + 8 * c) = o; }
    LDS_WAIT(); asm volatile("" ::: "memory");
}
struct Ctx {
    LAS unsigned char* lds;
    int tid, lane, wave, vcu, G;
    const float* in[11]; float* out; unsigned char* ws;
};
#define CTXP const Ctx& F

__device__ __forceinline__ bf16* wsl(CTXP, int l, size_t off) { return (bf16*)(F.ws + WS_W) + (size_t)l * W_LAYER + off; }

constexpr int CI_IN = (D / 64) * (NZ / 32), CI_A = (512 / 64) * (D / 32), CI_B = (D / 64) * (D / 32), CI_O = CI_B, CI_U = (D / 64) * (FF / 32), CI_D = (FF / 64) * (D / 32);
constexpr int CI_LAYER = CI_IN + CI_A + CI_B + CI_O + CI_U + CI_D;
__device__ __forceinline__ void convert_items(CTXP, int lo, int hi) {
    LAS float* scr = (LAS float*)(F.lds + RING_OFF + F.wave * 16384);
    const int gw = F.vcu * NWAVES + F.wave, NGW = F.G * NWAVES;
    for (int it = lo + gw; it < hi; it += NGW) {
        const int l = it / CI_LAYER; int r = it % CI_LAYER;
        if (r < CI_IN) { p0_transpose_item<true>(F.in[2] + (size_t)l * D * NZ, D, NZ, wsl(F, l, W_WIN), scr, r, F.lane, F.in[1] + l * D); continue; } r -= CI_IN;
        if (r < CI_A) { p0_transpose_item<false>(F.in[4] + (size_t)l * 512 * D, 512, D, wsl(F, l, W_WA), scr, r, F.lane); continue; } r -= CI_A;
        if (r < CI_B) { p0_transpose_item<false>(F.in[5] + (size_t)l * D * D, D, D, wsl(F, l, W_WB), scr, r, F.lane); continue; } r -= CI_B;
        if (r < CI_O) { p0_transpose_item<false>(F.in[6] + (size_t)l * D * D, D, D, wsl(F, l, W_WOUT), scr, r, F.lane); continue; } r -= CI_O;
        if (r < CI_U) { p0_transpose_item<false>(F.in[8] + (size_t)l * D * FF, D, FF, wsl(F, l, W_WUP), scr, r, F.lane, F.in[7] + l * D); continue; } r -= CI_U;
        p0_transpose_item<false>(F.in[9] + (size_t)l * FF * D, FF, D, wsl(F, l, W_WDOWN), scr, r, F.lane);
    }
}
__device__ __forceinline__ void phase_prologue(CTXP) {
    const int gw = F.vcu * NWAVES + F.wave, NGW = F.G * NWAVES;
    convert_items(F, 0, CI_IN);
    {
        bf16* H = (bf16*)(F.ws + WS_H); float* SS = (float*)(F.ws + WS_SS);
        for (int m = gw; m < M; m += NGW) {
            const f32x4* xr = (const f32x4*)(F.in[0] + (size_t)m * D) + F.lane;
            unsigned long long* o8 = (unsigned long long*)(H + (size_t)m * D) + F.lane; float s = 0.f;
#pragma unroll
            for (int j = 0; j < 4; ++j) { const f32x4 v = xr[64 * j]; s += (v.x * v.x + v.y * v.y) + (v.z * v.z + v.w * v.w);
                o8[64 * j] = (unsigned long long)pk2(v.x, v.y) | ((unsigned long long)pk2(v.z, v.w) << 32); }
            s = wave_sum(s);
            if (F.lane < 16) SS[(size_t)m * 16 + F.lane] = (F.lane == 0) ? s : 0.f;
        }
    }
    f32x2* tabA = (f32x2*)(F.ws + WS_TABA); f32x2* tabR = (f32x2*)(F.ws + WS_TABR);
    const int gt = (F.vcu * NWAVES + F.wave) * 64 + F.lane, NGT = F.G * NWAVES * 64;
    for (int idx = gt; idx < SEQ * 96; idx += NGT) {
        const int pos = idx / 96, j = idx % 96;
        const float ex = (j < 32) ? (float)j * (1.f / 32.f) : (float)(j - 32) * (1.f / 63.f);
        const float inv = exp2f(-ex * 13.287712379549449f);
        const float ang = (float)pos * inv;
        float s, c; sincosf(ang, &s, &c);
        const f32x2 v = {c, s};
        if (j < 32) tabA[pos * 32 + j] = v; else tabR[pos * 64 + (j - 32)] = v;
    }
}

__device__ __forceinline__ void phase_rms_bf16(CTXP, const float* x, const float* g, bf16* H) {
    const int gw = F.vcu * NWAVES + F.wave, NGW = F.G * NWAVES;
    const f32x4* g4 = (const f32x4*)g + F.lane;
    for (int m = gw; m < M; m += NGW) {
        const f32x4* xr = (const f32x4*)(x + (size_t)m * D) + F.lane;
        f32x4 v[4]; float s = 0.f;
#pragma unroll
        for (int j = 0; j < 4; ++j) { v[j] = xr[64 * j]; s += (v[j].x * v[j].x + v[j].y * v[j].y) + (v[j].z * v[j].z + v[j].w * v[j].w); }
        const float rstd = 1.f / sqrtf(wave_sum(s) * (1.f / D) + EPS);
        unsigned long long* o8 = (unsigned long long*)(H + (size_t)m * D) + F.lane;
#pragma unroll
        for (int j = 0; j < 4; ++j) { const f32x4 gg = g4[64 * j];
            o8[64 * j] = (unsigned long long)pk2(v[j].x * rstd * gg.x, v[j].y * rstd * gg.y) | ((unsigned long long)pk2(v[j].z * rstd * gg.z, v[j].w * rstd * gg.w) << 32); }
    }
}
__device__ __forceinline__ void phase_rms_final(CTXP, const bf16* X, float* out, const float* g) {
    const int gw = F.vcu * NWAVES + F.wave, NGW = F.G * NWAVES;
    const f32x4* g4 = (const f32x4*)g + F.lane; const float* SS = (const float*)(F.ws + WS_SS);
    const f32x4 ga = g4[0], gb = g4[64], gc = g4[128], gd = g4[192];
    for (int m = gw; m < M; m += NGW) {
        const v2u* xr = (const v2u*)(X + (size_t)m * D) + F.lane; f32x4* orow = (f32x4*)(out + (size_t)m * D) + F.lane;
        const float rstd = pg8::row_rstd(SS, m);
        const v2u a = xr[0], b = xr[64], c = xr[128], d = xr[192];
        orow[0]   = (f32x4){bflo(a.x), bfhi(a.x), bflo(a.y), bfhi(a.y)} * rstd * ga;
        orow[64]  = (f32x4){bflo(b.x), bfhi(b.x), bflo(b.y), bfhi(b.y)} * rstd * gb;
        orow[128] = (f32x4){bflo(c.x), bfhi(c.x), bflo(c.y), bfhi(c.y)} * rstd * gc;
        orow[192] = (f32x4){bflo(d.x), bfhi(d.x), bflo(d.y), bfhi(d.y)} * rstd * gd;
    }
}

__device__ __forceinline__ void phase_rotary(CTXP, bf16* z) {
    const f32x2* tabA = (const f32x2*)(F.ws + WS_TABA); const f32x2* tabR = (const f32x2*)(F.ws + WS_TABR);
    const long gt = (long)(F.vcu * NWAVES + F.wave) * 64 + F.lane, NGT = (long)F.G * NWAVES * 64;
    for (long idx = gt; idx < (long)M * 832; idx += NGT) {
        const int m = (int)(idx / 832), p = (int)(idx % 832), pos = m % SEQ;
        int c1, c2; f32x2 cs; float sc = 1.f;
        if (p < 256)      { const int h = p / 32, i = p % 32; c1 = C_AQ + 64 * h + i; c2 = c1 + 32; cs = tabA[pos * 32 + i]; }
        else if (p < 320) { const int pp = p - 256, h = pp / 32, i = pp % 32; c1 = C_AK + 64 * h + i; c2 = c1 + 32; cs = tabA[pos * 32 + i]; }
        else if (p < 576) { const int pp = p - 320, h = pp / 64, i = pp % 64; c1 = C_RQ + 128 * h + 2 * i; c2 = c1 + 1; cs = tabR[pos * 64 + i]; }
        else              { const int pp = p - 576, h = pp / 64, i = pp % 64; c1 = C_RK + 128 * h + 2 * i; c2 = c1 + 1; cs = tabR[pos * 64 + i]; sc = 0.08838834764831845f; }
        bf16* zr = z + (size_t)m * NZ;
        const float x1 = bf2f(zr[c1]), x2 = bf2f(zr[c2]);
        zr[c1] = (bf16)f2bf((x1 * cs.x - x2 * cs.y) * sc); zr[c2] = (bf16)f2bf((x2 * cs.x + x1 * cs.y) * sc);
    }
}

__device__ __forceinline__ void phase_attn_naive(CTXP, bf16* z, const float* sinks) {
    const int gw = F.vcu * NWAVES + F.wave, NGW = F.G * NWAVES;
    for (int u = gw; u < BATCH * 64 * 8; u += NGW) {
        const int h = u % 8, tb = (u / 8) % 64, b = u / 512, g = h / 4;
        const int t = tb * 64 + F.lane; const size_t m = (size_t)b * SEQ + t;
        float q[64], o[64];
        { const v4u* qp = (const v4u*)(z + m * NZ + C_AQ + 64 * h);
#pragma unroll
          for (int c = 0; c < 8; ++c) { const v4u w = qp[c];
              q[8 * c + 0] = bflo(w.x) * 0.125f; q[8 * c + 1] = bfhi(w.x) * 0.125f; q[8 * c + 2] = bflo(w.y) * 0.125f; q[8 * c + 3] = bfhi(w.y) * 0.125f;
              q[8 * c + 4] = bflo(w.z) * 0.125f; q[8 * c + 5] = bfhi(w.z) * 0.125f; q[8 * c + 6] = bflo(w.w) * 0.125f; q[8 * c + 7] = bfhi(w.w) * 0.125f; } }
#pragma unroll
        for (int d = 0; d < 64; ++d) o[d] = 0.f;
        float mr = sinks[h], l = 1.f;
        const int k0 = (tb * 64 - 127) > 0 ? (tb * 64 - 127) : 0, k1 = tb * 64 + 63;
        for (int kk = k0; kk <= k1; ++kk) {
            const bf16* krow = z + ((size_t)b * SEQ + kk) * NZ + C_AK + 64 * g;
            const bf16* vrow = z + ((size_t)b * SEQ + kk) * NZ + C_AV + 64 * g;
            float s = 0.f;
#pragma unroll
            for (int c = 0; c < 8; ++c) { const v4u w = ((const v4u*)krow)[c];
                s += q[8 * c + 0] * bflo(w.x) + q[8 * c + 1] * bfhi(w.x) + q[8 * c + 2] * bflo(w.y) + q[8 * c + 3] * bfhi(w.y)
                   + q[8 * c + 4] * bflo(w.z) + q[8 * c + 5] * bfhi(w.z) + q[8 * c + 6] * bflo(w.w) + q[8 * c + 7] * bfhi(w.w); }
            const bool valid = (kk <= t) && (kk >= t - 127);
            if (valid) {
                const float mn = fmaxf(mr, s), corr = __expf(mr - mn), p = __expf(s - mn);
                l = l * corr + p; mr = mn;
#pragma unroll
                for (int c = 0; c < 8; ++c) { const v4u w = ((const v4u*)vrow)[c];
                    o[8 * c + 0] = o[8 * c + 0] * corr + p * bflo(w.x); o[8 * c + 1] = o[8 * c + 1] * corr + p * bfhi(w.x);
                    o[8 * c + 2] = o[8 * c + 2] * corr + p * bflo(w.y); o[8 * c + 3] = o[8 * c + 3] * corr + p * bfhi(w.y);
                    o[8 * c + 4] = o[8 * c + 4] * corr + p * bflo(w.z); o[8 * c + 5] = o[8 * c + 5] * corr + p * bfhi(w.z);
                    o[8 * c + 6] = o[8 * c + 6] * corr + p * bflo(w.w); o[8 * c + 7] = o[8 * c + 7] * corr + p * bfhi(w.w); }
            }
        }
        const float rl = 1.f / l;
        v4u* op = (v4u*)(z + m * NZ + C_AQ + 64 * h);
#pragma unroll
        for (int c = 0; c < 8; ++c) { v4u w; w.x = pk2(o[8 * c + 0] * rl, o[8 * c + 1] * rl); w.y = pk2(o[8 * c + 2] * rl, o[8 * c + 3] * rl);
            w.z = pk2(o[8 * c + 4] * rl, o[8 * c + 5] * rl); w.w = pk2(o[8 * c + 6] * rl, o[8 * c + 7] * rl); op[c] = w; }
    }
}

__device__ __forceinline__ void phase_ret_scan_naive(CTXP, const bf16* z, bf16* RP) {
    const int gt = (F.vcu * NWAVES + F.wave) * 64 + F.lane, NGT = F.G * NWAVES * 64;
    for (int idx = gt; idx < BATCH * 4 * 128 * 64; idx += NGT) {
        const int e0 = idx % 64, d = (idx / 64) % 128, h = (idx / 8192) % 4, b = idx / 32768;
        const float gamma = 1.f - exp2f(-5.f - (float)h);
        float S0 = 0.f, S1 = 0.f, S2 = 0.f, S3 = 0.f;
        const bf16* zk = z + (size_t)b * SEQ * NZ + C_RK + 128 * h + d;
        const bf16* zv = z + (size_t)b * SEQ * NZ + C_RV + 256 * h + e0;
        bf16* rp = RP + ((size_t)(b * 4 + h) * 32) * 32768 + d * 256 + e0;
        for (int n = 0; n < 32; ++n) {
            rp[0] = (bf16)f2bf(S0); rp[64] = (bf16)f2bf(S1); rp[128] = (bf16)f2bf(S2); rp[192] = (bf16)f2bf(S3); rp += 32768;
#pragma unroll 4
            for (int j = 0; j < 128; ++j) {
                const float kd = bf2f(*zk); const float v0 = bf2f(zv[0]), v1 = bf2f(zv[64]), v2 = bf2f(zv[128]), v3 = bf2f(zv[192]);
                S0 = gamma * S0 + kd * v0; S1 = gamma * S1 + kd * v1; S2 = gamma * S2 + kd * v2; S3 = gamma * S3 + kd * v3;
                zk += NZ; zv += NZ;
            }
        }
    }
}

__device__ __forceinline__ void phase_ret_out_naive(CTXP, bf16* z, const bf16* RP) {
    LAS float* Sl = (LAS float*)(F.lds + RING_OFF);
    LAS float* rowsq = (LAS float*)(F.lds + RING_OFF + 32768);
    const int tid = F.tid;
    for (int unit = F.vcu; unit < BATCH * 4 * 32 * 2; unit += F.G) {
        const int half = unit & 1, n = (unit >> 1) & 31, h = (unit >> 6) & 3, b = unit >> 8;
        const size_t m0 = (size_t)b * SEQ + n * 128;
        const float log2g = log2f(1.f - exp2f(-5.f - (float)h));
        {
            const int j = tid & 127, ig = tid >> 7;
            unsigned kreg[64];
            { const v4u* kp = (const v4u*)(z + (m0 + j) * NZ + C_RK + 128 * h);
#pragma unroll
              for (int c = 0; c < 16; ++c) { const v4u w = kp[c]; kreg[4 * c] = w.x; kreg[4 * c + 1] = w.y; kreg[4 * c + 2] = w.z; kreg[4 * c + 3] = w.w; } }
            for (int r = 0; r < 16; ++r) {
                const int i = ig + 4 * r, iglob = 64 * half + i;
                float s = 0.f;
                if (j <= iglob) {
                    const v4u* qp = (const v4u*)(z + (m0 + iglob) * NZ + C_RQ + 128 * h);
#pragma unroll
                    for (int c = 0; c < 16; ++c) { const v4u w = qp[c];
                        s += bflo(w.x) * bflo(kreg[4 * c]) + bfhi(w.x) * bfhi(kreg[4 * c]) + bflo(w.y) * bflo(kreg[4 * c + 1]) + bfhi(w.y) * bfhi(kreg[4 * c + 1])
                           + bflo(w.z) * bflo(kreg[4 * c + 2]) + bfhi(w.z) * bfhi(kreg[4 * c + 2]) + bflo(w.w) * bflo(kreg[4 * c + 3]) + bfhi(w.w) * bfhi(kreg[4 * c + 3]); }
                    s *= exp2f(log2g * (float)(iglob - j));
                }
                Sl[i * 128 + j] = s;
            }
            if (tid < 64) rowsq[tid] = 0.f;
        }
        __syncthreads();
        {
            const int e = tid & 255, rgp = tid >> 8;
            float acc[32], acc2[32];
#pragma unroll
            for (int rr = 0; rr < 32; ++rr) { acc[rr] = 0.f; acc2[rr] = 0.f; }
            const bf16* vp = z + m0 * NZ + C_RV + 256 * h + e;
            for (int j = 0; j < 128; ++j) {
                const float v = bf2f(vp[(size_t)j * NZ]);
#pragma unroll
                for (int rr = 0; rr < 32; ++rr) acc[rr] += Sl[(rgp * 32 + rr) * 128 + j] * v;
            }
            const bf16* rp = RP + ((size_t)((b * 4 + h) * 32 + n)) * 32768 + e;
            const bf16* qb = z + (m0 + 64 * half + rgp * 32) * NZ + C_RQ + 128 * h;
            for (int d = 0; d < 128; d += 2) {
                const float r0 = bf2f(rp[(size_t)d * 256]), r1 = bf2f(rp[(size_t)(d + 1) * 256]);
#pragma unroll
                for (int rr = 0; rr < 32; ++rr) { const unsigned w = *(const unsigned*)(qb + (size_t)rr * NZ + d); acc2[rr] += bflo(w) * r0 + bfhi(w) * r1; }
            }
#pragma unroll
            for (int rr = 0; rr < 32; ++rr) {
                const int iglob = 64 * half + rgp * 32 + rr;
                const float r = acc[rr] + exp2f(log2g * (float)(iglob + 1)) * acc2[rr];
                acc[rr] = r;
                const float ss = wave_sum(r * r);
                if (F.lane == 0) atomicAdd((float*)(rowsq + rgp * 32 + rr), ss);
            }
            __syncthreads();
#pragma unroll
            for (int rr = 0; rr < 32; ++rr) {
                const int iglob = 64 * half + rgp * 32 + rr;
                const float rstd = 1.f / sqrtf(rowsq[rgp * 32 + rr] * (1.f / 256.f) + EPS);
                bf16* gp = z + (m0 + iglob) * NZ + C_RG + 256 * h + e;
                const float gv = bf2f(*gp);
                const float sil = gv / (1.f + __expf(-gv));
                *gp = (bf16)f2bf(acc[rr] * rstd * sil);
            }
        }
        __syncthreads();
    }
}

__device__ __forceinline__ void phase_merge_naive(CTXP, bf16* z) {
    const long gt = (long)(F.vcu * NWAVES + F.wave) * 64 + F.lane, NGT = (long)F.G * NWAVES * 64;
    for (long idx = gt; idx < (long)M * (D / 8); idx += NGT) {
        const size_t m = (size_t)(idx / (D / 8)); const int c = (int)(idx % (D / 8)) * 8;
        bf16* zr = z + m * NZ;
        const v4u ya = *(const v4u*)(zr + C_YA + c), yb = *(const v4u*)(zr + C_YB + c), ga = *(const v4u*)(zr + C_GA + c), gb = *(const v4u*)(zr + C_GB + c);
        v4u o;
#define MRG(A, B, GA_, GB_, LOHI) ((1.f / (1.f + __expf(-LOHI(GA_)))) * LOHI(A) + (1.f / (1.f + __expf(-LOHI(GB_)))) * LOHI(B))
        o.x = pk2(MRG(ya.x, yb.x, ga.x, gb.x, bflo), MRG(ya.x, yb.x, ga.x, gb.x, bfhi));
        o.y = pk2(MRG(ya.y, yb.y, ga.y, gb.y, bflo), MRG(ya.y, yb.y, ga.y, gb.y, bfhi));
        o.z = pk2(MRG(ya.z, yb.z, ga.z, gb.z, bflo), MRG(ya.z, yb.z, ga.z, gb.z, bfhi));
        o.w = pk2(MRG(ya.w, yb.w, ga.w, gb.w, bflo), MRG(ya.w, yb.w, ga.w, gb.w, bfhi));
#undef MRG
        *(v4u*)(zr + C_GA + c) = o;
    }
}

typedef short bf16x8 __attribute__((ext_vector_type(8)));
typedef short s16x4 __attribute__((ext_vector_type(4)));
typedef float f32x16 __attribute__((ext_vector_type(16)));
typedef __bf16 bf16x2_t __attribute__((ext_vector_type(2)));
#define MFMA32(a, b, c) __builtin_amdgcn_mfma_f32_32x32x16_bf16((a), (b), (c), 0, 0, 0)
__device__ __forceinline__ int crow(int r, int h) { return (r & 3) + 8 * (r >> 2) + 4 * h; }
__device__ __forceinline__ unsigned cvtpk(float lo, float hi) { f32x2 v = {lo, hi}; bf16x2_t b = __builtin_convertvector(v, bf16x2_t); return __builtin_bit_cast(unsigned, b); }
__device__ __forceinline__ s16x4 tr_read(const LAS unsigned char* p) { return __builtin_bit_cast(s16x4, __builtin_amdgcn_ds_read_tr16_b64_v4i16((LAS s16x4*)p)); }
#define PACK_STEP(x, s) __builtin_bit_cast(bf16x8, (v4u){cvtpk((x)[8 * (s)], (x)[8 * (s) + 1]), cvtpk((x)[8 * (s) + 2], (x)[8 * (s) + 3]), cvtpk((x)[8 * (s) + 4], (x)[8 * (s) + 5]), cvtpk((x)[8 * (s) + 6], (x)[8 * (s) + 7])})

__device__ __forceinline__ void phase_attn_mfma(CTXP, bf16* z, const float* sinks) {
    const LAS unsigned char* Kl = F.lds + RING_OFF; const LAS unsigned char* Vl = F.lds + RING_OFF + 32768;
    const int tid = F.tid, lane = F.lane, r = lane & 31, h = lane >> 5, wave = F.wave;
    const int i16 = lane & 15, tq = i16 >> 2, tp = i16 & 3, blk = (lane >> 4) & 1;
    for (int unit = F.vcu; unit < BATCH * 32 * 2; unit += F.G) {
        const int g = unit & 1, n = (unit >> 1) & 31, b = unit >> 6;
        const size_t m0 = (size_t)b * SEQ + (size_t)n * 128;
        const int kj_lo = (n == 0) ? 128 : 0, kt_lo = (n == 0) ? 4 : 0;
#pragma unroll
        for (int p = 0; p < 4; ++p) { const int row = p * 64 + (tid >> 3), c = tid & 7;
            if (row >= kj_lo) { const bf16* src = z + (m0 - 128 + row) * NZ + 64 * g + 8 * c;
                const v4u kv = *(const v4u*)(src + C_AK), vv = *(const v4u*)(src + C_AV);
                *(LAS v4u*)(Kl + row * 128 + ((c ^ (row & 7)) * 16)) = kv; *(LAS v4u*)(Vl + row * 128 + c * 16) = vv; } }
        __syncthreads();
        const int hq = 4 * g + (wave >> 1);
        const float sinkl = sinks[hq] * 1.4426950408889634f;
#pragma unroll 1
        for (int qq = 0; qq < 2; ++qq) {
            const int qs = (wave & 1) * 2 + qq;
            bf16* qrow = z + (m0 + 32 * qs + r) * NZ + C_AQ + 64 * hq;
            bf16x8 qf[4];
#pragma unroll
            for (int ks = 0; ks < 4; ++ks) qf[ks] = *(const bf16x8*)(qrow + 16 * ks + 8 * h);
            f32x16 s[5];
            const int iq = 32 * qs + r;
#pragma unroll
            for (int t = 0; t < 5; ++t) {
                const int kt = qs + t;
                if (kt < kt_lo) {
#pragma unroll
                    for (int i = 0; i < 16; ++i) s[t][i] = -INFINITY;
                } else {
                    f32x16 acc;
#pragma unroll
                    for (int i = 0; i < 16; ++i) acc[i] = 0.f;
                    const int key = 32 * kt + r;
#pragma unroll
                    for (int ks = 0; ks < 4; ++ks) { const bf16x8 a = *(const LAS bf16x8*)(Kl + key * 128 + (((2 * ks + h) ^ (key & 7)) * 16)); acc = MFMA32(a, qf[ks], acc); }
#pragma unroll
                    for (int i = 0; i < 16; ++i) { const int kj = 32 * kt + crow(i, h); const bool valid = (kj >= iq + 1) && (kj <= iq + 128); s[t][i] = valid ? acc[i] * 0.18033688011112042f : -INFINITY; }
                }
            }
            float mx = sinkl;
#pragma unroll
            for (int t = 0; t < 5; ++t)
#pragma unroll
                for (int i = 0; i < 16; ++i) mx = fmaxf(mx, s[t][i]);
            mx = fmaxf(mx, __shfl_xor(mx, 32));
            float l = 0.f;
#pragma unroll
            for (int t = 0; t < 5; ++t)
#pragma unroll
                for (int i = 0; i < 16; ++i) { const float p = __builtin_amdgcn_exp2f(s[t][i] - mx); s[t][i] = p; l += p; }
            l += __shfl_xor(l, 32);
            l += __builtin_amdgcn_exp2f(sinkl - mx);
            f32x16 o[2];
#pragma unroll
            for (int i = 0; i < 16; ++i) { o[0][i] = 0.f; o[1][i] = 0.f; }
#pragma unroll
            for (int t = 0; t < 5; ++t) {
                const int kt = qs + t;
                if (kt >= kt_lo) {
#pragma unroll
                    for (int s2 = 0; s2 < 2; ++s2) {
                        const bf16x8 xs = PACK_STEP(s[t], s2);
#pragma unroll
                        for (int dt = 0; dt < 2; ++dt) {
                            const LAS unsigned char* vp = Vl + (32 * kt + 16 * s2 + 4 * h + tq) * 128 + (32 * dt + 16 * blk) * 2 + 8 * tp;
                            const s16x4 lo = tr_read(vp), hi = tr_read(vp + 8 * 128);
                            const bf16x8 pa = __builtin_shufflevector(lo, hi, 0, 1, 2, 3, 4, 5, 6, 7);
                            o[dt] = MFMA32(pa, xs, o[dt]);
                        }
                    }
                }
            }
            const float rl = 1.f / l;
#pragma unroll
            for (int dt = 0; dt < 2; ++dt)
#pragma unroll
                for (int g4 = 0; g4 < 4; ++g4) {
                    v2u w; w.x = cvtpk(o[dt][4 * g4] * rl, o[dt][4 * g4 + 1] * rl); w.y = cvtpk(o[dt][4 * g4 + 2] * rl, o[dt][4 * g4 + 3] * rl);
                    *(v2u*)(qrow + 32 * dt + 8 * g4 + 4 * h) = w;
                }
        }
        __syncthreads();
    }
}

__device__ __forceinline__ void phase_ret_kv_mfma(CTXP, const bf16* z, bf16* KV) {
    const LAS unsigned char* Vl = F.lds + RING_OFF; const LAS unsigned char* Kl = F.lds + RING_OFF + 65536;
    const int tid = F.tid, lane = F.lane, r = lane & 31, h = lane >> 5, wave = F.wave;
    const int i16 = lane & 15, tq = i16 >> 2, tp = i16 & 3, blk = (lane >> 4) & 1;
    for (int unit = F.vcu; unit < BATCH * 4 * 32; unit += F.G) {
        const int n = unit & 31, hd = (unit >> 5) & 3, b = unit >> 7;
        const size_t m0 = (size_t)b * SEQ + (size_t)n * 128;
        const float log2g = log2f(1.f - exp2f(-5.f - (float)hd));
#pragma unroll
        for (int p = 0; p < 4; ++p) { const int row = p * 32 + (tid >> 4), c = tid & 15;
            const v4u w = *(const v4u*)(z + (m0 + row) * NZ + C_RK + 128 * hd + 8 * c);
            const float zt = exp2f(log2g * (float)(127 - row));
            v4u o; o.x = cvtpk(bflo(w.x) * zt, bfhi(w.x) * zt); o.y = cvtpk(bflo(w.y) * zt, bfhi(w.y) * zt); o.z = cvtpk(bflo(w.z) * zt, bfhi(w.z) * zt); o.w = cvtpk(bflo(w.w) * zt, bfhi(w.w) * zt);
            *(LAS v4u*)(Kl + row * 256 + c * 16) = o; }
#pragma unroll
        for (int p = 0; p < 8; ++p) { const int row = p * 16 + (tid >> 5), c = tid & 31;
            *(LAS v4u*)(Vl + row * 512 + c * 16) = *(const v4u*)(z + (m0 + row) * NZ + C_RV + 256 * hd + 8 * c); }
        __syncthreads();
        f32x16 acc[4];
#pragma unroll
        for (int dt = 0; dt < 4; ++dt)
#pragma unroll
            for (int i = 0; i < 16; ++i) acc[dt][i] = 0.f;
#pragma unroll 2
        for (int s = 0; s < 8; ++s) {
            const LAS unsigned char* vp = Vl + (16 * s + 8 * h + tq) * 512 + (32 * wave + 16 * blk) * 2 + 8 * tp;
            const s16x4 vlo = tr_read(vp), vhi = tr_read(vp + 4 * 512);
            const bf16x8 bfrag = __builtin_shufflevector(vlo, vhi, 0, 1, 2, 3, 4, 5, 6, 7);
#pragma unroll
            for (int dt = 0; dt < 4; ++dt) {
                const LAS unsigned char* kp = Kl + (16 * s + 8 * h + tq) * 256 + (32 * dt + 16 * blk) * 2 + 8 * tp;
                const s16x4 klo = tr_read(kp), khi = tr_read(kp + 4 * 256);
                const bf16x8 afrag = __builtin_shufflevector(klo, khi, 0, 1, 2, 3, 4, 5, 6, 7);
                acc[dt] = MFMA32(afrag, bfrag, acc[dt]);
            }
        }
        bf16* out = KV + (size_t)unit * 32768 + (32 * wave + r) * 128;
#pragma unroll
        for (int dt = 0; dt < 4; ++dt)
#pragma unroll
            for (int g4 = 0; g4 < 4; ++g4) { v2u w; w.x = cvtpk(acc[dt][4 * g4], acc[dt][4 * g4 + 1]); w.y = cvtpk(acc[dt][4 * g4 + 2], acc[dt][4 * g4 + 3]);
                *(v2u*)(out + 32 * dt + 8 * g4 + 4 * h) = w; }
        __syncthreads();
    }
}
__device__ __forceinline__ void phase_ret_scan(CTXP, bf16* KV) {
    const int gt = (F.vcu * NWAVES + F.wave) * 64 + F.lane, NGT = F.G * NWAVES * 64;
    for (int idx = gt; idx < 32 * 4096; idx += NGT) {
        const int bh = idx >> 12, off = (idx & 4095) * 8, hd = bh & 3;
        const float gch = exp2f(128.f * log2f(1.f - exp2f(-5.f - (float)hd)));
        float R[8];
#pragma unroll
        for (int i = 0; i < 8; ++i) R[i] = 0.f;
        bf16* p = KV + (size_t)bh * 32 * 32768 + off;
#pragma unroll 4
        for (int n = 0; n < 32; ++n) {
            const v4u kv = *(const v4u*)p;
            v4u o; o.x = cvtpk(R[0], R[1]); o.y = cvtpk(R[2], R[3]); o.z = cvtpk(R[4], R[5]); o.w = cvtpk(R[6], R[7]);
            *(v4u*)p = o;
            R[0] = gch * R[0] + bflo(kv.x); R[1] = gch * R[1] + bfhi(kv.x); R[2] = gch * R[2] + bflo(kv.y); R[3] = gch * R[3] + bfhi(kv.y);
            R[4] = gch * R[4] + bflo(kv.z); R[5] = gch * R[5] + bfhi(kv.z); R[6] = gch * R[6] + bflo(kv.w); R[7] = gch * R[7] + bfhi(kv.w);
            p += 32768;
        }
    }
}
__device__ __forceinline__ void phase_ret_out_mfma(CTXP, bf16* z, const bf16* RP) {
    const LAS unsigned char* Vl = F.lds + RING_OFF; LAS float* red = (LAS float*)(F.lds + RING_OFF + 65536);
    const int tid = F.tid, lane = F.lane, r = lane & 31, h = lane >> 5, wave = F.wave, qb = wave & 3, eh = wave >> 2;
    const int i16 = lane & 15, tq = i16 >> 2, tp = i16 & 3, blk = (lane >> 4) & 1;
    for (int unit = F.vcu; unit < BATCH * 4 * 32; unit += F.G) {
        const int n = unit & 31, hd = (unit >> 5) & 3, b = unit >> 7;
        const size_t m0 = (size_t)b * SEQ + (size_t)n * 128;
        const float log2g = log2f(1.f - exp2f(-5.f - (float)hd));
#pragma unroll
        for (int p = 0; p < 8; ++p) { const int row = p * 16 + (tid >> 5), c = tid & 31;
            *(LAS v4u*)(Vl + row * 512 + c * 16) = *(const v4u*)(z + (m0 + row) * NZ + C_RV + 256 * hd + 8 * c); }
        const int iq = 32 * qb + r;
        const bf16* qrow = z + (m0 + iq) * NZ + C_RQ + 128 * hd + 8 * h;
        bf16x8 qf[8];
#pragma unroll
        for (int ks = 0; ks < 8; ++ks) qf[ks] = *(const bf16x8*)(qrow + 16 * ks);
        f32x16 acc[4];
        const bf16* rp = RP + (size_t)unit * 32768 + (128 * eh + r) * 128 + 8 * h;
        const float xi = exp2f(log2g * (float)(iq + 1));
#pragma unroll
        for (int et = 0; et < 4; ++et) {
#pragma unroll
            for (int i = 0; i < 16; ++i) acc[et][i] = 0.f;
#pragma unroll
            for (int ks = 0; ks < 8; ++ks) { const bf16x8 a = *(const bf16x8*)(rp + et * 32 * 128 + 16 * ks); acc[et] = MFMA32(a, qf[ks], acc[et]); }
#pragma unroll
            for (int i = 0; i < 16; ++i) acc[et][i] *= xi;
        }
        __syncthreads();
#pragma unroll 1
        for (int kt = 0; kt <= qb; ++kt) {
            f32x16 X;
#pragma unroll
            for (int i = 0; i < 16; ++i) X[i] = 0.f;
            const bf16* krow = z + (m0 + 32 * kt + r) * NZ + C_RK + 128 * hd + 8 * h;
#pragma unroll
            for (int ks = 0; ks < 8; ++ks) { const bf16x8 a = *(const bf16x8*)(krow + 16 * ks); X = MFMA32(a, qf[ks], X); }
#pragma unroll
            for (int i = 0; i < 16; ++i) { const int kj = 32 * kt + crow(i, h); X[i] = (kj <= iq) ? X[i] * exp2f(log2g * (float)(iq - kj)) : 0.f; }
#pragma unroll
            for (int s2 = 0; s2 < 2; ++s2) {
                const bf16x8 xs = PACK_STEP(X, s2);
#pragma unroll
                for (int et = 0; et < 4; ++et) {
                    const LAS unsigned char* vp = Vl + (32 * kt + 16 * s2 + 4 * h + tq) * 512 + (128 * eh + 32 * et + 16 * blk) * 2 + 8 * tp;
                    const s16x4 lo = tr_read(vp), hi = tr_read(vp + 8 * 512);
                    const bf16x8 pa = __builtin_shufflevector(lo, hi, 0, 1, 2, 3, 4, 5, 6, 7);
                    acc[et] = MFMA32(pa, xs, acc[et]);
                }
            }
        }
        float ss = 0.f;
#pragma unroll
        for (int et = 0; et < 4; ++et)
#pragma unroll
            for (int i = 0; i < 16; ++i) ss += acc[et][i] * acc[et][i];
        ss += __shfl_xor(ss, 32);
        if (h == 0) red[eh * 128 + iq] = ss;
        __syncthreads();
        const float rstd = 1.f / sqrtf((red[iq] + red[128 + iq]) * (1.f / 256.f) + EPS);
        bf16* grow = z + (m0 + iq) * NZ + C_RG + 256 * hd + 128 * eh + 4 * h;
#pragma unroll
        for (int et = 0; et < 4; ++et)
#pragma unroll
            for (int g4 = 0; g4 < 4; ++g4) {
                bf16* p = grow + 32 * et + 8 * g4;
                const v2u gv = *(const v2u*)p;
                const float g0 = bflo(gv.x), g1 = bfhi(gv.x), g2 = bflo(gv.y), g3 = bfhi(gv.y);
                const float o0 = acc[et][4 * g4] * rstd * (g0 / (1.f + __expf(-g0))), o1 = acc[et][4 * g4 + 1] * rstd * (g1 / (1.f + __expf(-g1)));
                const float o2 = acc[et][4 * g4 + 2] * rstd * (g2 / (1.f + __expf(-g2))), o3 = acc[et][4 * g4 + 3] * rstd * (g3 / (1.f + __expf(-g3)));
                v2u w; w.x = cvtpk(o0, o1); w.y = cvtpk(o2, o3);
                *(v2u*)p = w;
            }
        __syncthreads();
    }
}

__device__ __forceinline__ void glds16(const void* gsrc, LAS unsigned char* ldst) {
    unsigned keep; const unsigned dst = (unsigned)__builtin_amdgcn_readfirstlane((int)(unsigned)(size_t)ldst);
    asm volatile("s_mov_b32 %0, m0\n\ts_mov_b32 m0, %2\n\ts_nop 0\n\tglobal_load_lds_dwordx4 %1, off\n\ts_mov_b32 m0, %0" : "=&s"(keep) : "v"(gsrc), "s"(dst) : "memory");
}
__device__ __forceinline__ void phase_ret_state(CTXP, const bf16* z, bf16* KV) {
    constexpr int SLOT = 32768, KOFF = 0, VOFF = 16384;
    const int wave = F.wave;
    for (int unit = F.vcu; unit < BATCH * 4 * 8; unit += F.G) {
        int lane = F.lane; asm volatile("" : "+v"(lane));
        const int r = lane & 31, h = lane >> 5, i16 = lane & 15, tq = i16 >> 2, tp = i16 & 3, blk = (lane >> 4) & 1;
        const int eq = unit & 3, dh = (unit >> 2) & 1, hd = (unit >> 3) & 3, b = unit >> 5;
        const float log2g = log2f(1.f - exp2f(-5.f - (float)hd)), gch = exp2f(128.f * log2g);
        const bf16* ksrc = z + ((size_t)b * SEQ + (wave * 16 + (lane >> 3))) * NZ + C_RK + 128 * hd + 64 * dh + 8 * (lane & 7);
        const bf16* vsrc = z + ((size_t)b * SEQ + (wave * 16 + (lane >> 3))) * NZ + C_RV + 256 * hd + 64 * eq + 8 * (lane & 7);
#define RS_ISSUE(n_, slot_) do { const size_t ro_ = (size_t)(n_) * 128 * NZ; LAS unsigned char* sb_ = F.lds + RING_OFF + (slot_) * SLOT + wave * 2048; \
        glds16(ksrc + ro_, sb_ + KOFF); glds16(ksrc + ro_ + (size_t)8 * NZ, sb_ + KOFF + 1024); \
        glds16(vsrc + ro_, sb_ + VOFF); glds16(vsrc + ro_ + (size_t)8 * NZ, sb_ + VOFF + 1024); } while (0)
        RS_ISSUE(0, 0); RS_ISSUE(1, 1); RS_ISSUE(2, 2);
        f32x16 acc;
#pragma unroll
        for (int i = 0; i < 16; ++i) acc[i] = 0.f;
        float zb[8];
#pragma unroll
        for (int j = 0; j < 8; ++j) zb[j] = exp2f(log2g * (float)(127 - 8 * h - j));
        const int dt = wave & 1, et = (wave >> 1) & 1;
        bf16* outp = KV + ((size_t)(b * 4 + hd) * 32) * 32768 + (64 * eq + 32 * et + r) * 128 + 64 * dh + 32 * dt + 4 * h;
#pragma unroll 1
        for (int n = 0; n < 32; ++n) {
            if (n < 30) asm volatile("s_waitcnt vmcnt(8)" ::: "memory"); else if (n == 30) asm volatile("s_waitcnt vmcnt(4)" ::: "memory"); else asm volatile("s_waitcnt vmcnt(0)" ::: "memory");
            __builtin_amdgcn_s_barrier();
            if (wave < 4) {
#pragma unroll
                for (int g4 = 0; g4 < 4; ++g4) { v2u w; w.x = cvtpk(acc[4 * g4], acc[4 * g4 + 1]); w.y = cvtpk(acc[4 * g4 + 2], acc[4 * g4 + 3]); *(v2u*)(outp + 8 * g4) = w; }
            }
            outp += 32768;
            if (n + 3 < 32) RS_ISSUE(n + 3, (n + 3) & 3);
            if (wave < 4) {
                const LAS unsigned char* Kl = F.lds + RING_OFF + (n & 3) * SLOT + KOFF; const LAS unsigned char* Vl = F.lds + RING_OFF + (n & 3) * SLOT + VOFF;
#pragma unroll
                for (int i = 0; i < 16; ++i) acc[i] *= gch;
#pragma unroll
                for (int s = 0; s < 8; ++s) {
                    const LAS unsigned char* vp = Vl + (16 * s + 8 * h + tq) * 128 + (32 * et + 16 * blk) * 2 + 8 * tp;
                    const s16x4 vlo = tr_read(vp), vhi = tr_read(vp + 4 * 128);
                    const LAS unsigned char* kp = Kl + (16 * s + 8 * h + tq) * 128 + (32 * dt + 16 * blk) * 2 + 8 * tp;
                    const s16x4 klo = tr_read(kp), khi = tr_read(kp + 4 * 128);
                    const float fs = exp2f(log2g * (float)(-16 * s));
                    v4u bq;
                    bq.x = cvtpk(bf2f((unsigned short)vlo[0]) * (zb[0] * fs), bf2f((unsigned short)vlo[1]) * (zb[1] * fs)); bq.y = cvtpk(bf2f((unsigned short)vlo[2]) * (zb[2] * fs), bf2f((unsigned short)vlo[3]) * (zb[3] * fs));
                    bq.z = cvtpk(bf2f((unsigned short)vhi[0]) * (zb[4] * fs), bf2f((unsigned short)vhi[1]) * (zb[5] * fs)); bq.w = cvtpk(bf2f((unsigned short)vhi[2]) * (zb[6] * fs), bf2f((unsigned short)vhi[3]) * (zb[7] * fs));
                    const bf16x8 bfrag = __builtin_bit_cast(bf16x8, bq);
                    const bf16x8 afrag = __builtin_shufflevector(klo, khi, 0, 1, 2, 3, 4, 5, 6, 7);
                    acc = MFMA32(afrag, bfrag, acc);
                }
            }
        }
#undef RS_ISSUE
        asm volatile("s_waitcnt vmcnt(0)" ::: "memory");
        __builtin_amdgcn_s_barrier();
    }
}
#define RO_WAIT_BAR(N) asm volatile("s_waitcnt vmcnt(" #N ")\n\ts_barrier" ::: "memory")
__device__ __forceinline__ void ro_wait_bar(int ahead) {
    if (ahead >= 3) RO_WAIT_BAR(12); else if (ahead == 2) RO_WAIT_BAR(8); else if (ahead == 1) RO_WAIT_BAR(4); else RO_WAIT_BAR(0);
}
template <int KIND> __device__ __forceinline__ void ro_issue_slot(CTXP, const bf16* z, int ui) {
    int lane = F.lane; asm volatile("" : "+v"(lane));
    const int wave = F.wave;
    const int unit = F.vcu + ui * F.G;
    const int n = unit & 31, hd = (unit >> 5) & 3, b = unit >> 7;
    const size_t m0 = (size_t)b * SEQ + (size_t)n * 128;
    LAS unsigned char* sb = F.lds + RING_OFF + ((3 * ui + KIND) & 3) * 32768 + wave * 4096;
    if (KIND == 0) {
        const int row = 16 * wave + (lane >> 4);
        const bf16* src = z + (m0 + row) * NZ + C_RK + 128 * hd;
#pragma unroll
        for (int j = 0; j < 4; ++j) { const int c = (lane & 15) ^ ((row + 4 * j) & 15); glds16(src + (size_t)(4 * j) * NZ + 8 * c, sb + j * 1024); }
    } else {
        const int row = 8 * wave + (lane >> 5);
        const bf16* src = z + (m0 + 64 * (KIND - 1) + row) * NZ + C_RV + 256 * hd;
#pragma unroll
        for (int j = 0; j < 4; ++j) { const int c = (lane & 31) ^ (((row + 2 * j) & 3) << 2); glds16(src + (size_t)(2 * j) * NZ + 8 * c, sb + j * 1024); }
    }
}
__device__ __forceinline__ void phase_ret_out_ring(CTXP, bf16* z, const bf16* RP) {
    constexpr int SLOT = 32768;
    LAS float* red = (LAS float*)(F.lds + LDSCTL_OFF + 1024);
    const int wave = F.wave, qb = wave & 3, eh = wave >> 2;
    const int NU = (BATCH * 4 * 32 - F.vcu + F.G - 1) / F.G;
    if (NU <= 0) return;
    ro_issue_slot<0>(F, z, 0); ro_issue_slot<1>(F, z, 0); ro_issue_slot<2>(F, z, 0);
    if (NU > 1) ro_issue_slot<0>(F, z, 1);
#pragma unroll 1
    for (int ui = 0; ui < NU; ++ui) {
        int lane = F.lane; asm volatile("" : "+v"(lane));
        const int r = lane & 31, h = lane >> 5, i16 = lane & 15, tq = i16 >> 2, tp = i16 & 3, blk = (lane >> 4) & 1;
        const int unit = F.vcu + ui * F.G;
        const int n = unit & 31, hd = (unit >> 5) & 3, b = unit >> 7;
        const size_t m0 = (size_t)b * SEQ + (size_t)n * 128;
        const float log2g = log2f(1.f - exp2f(-5.f - (float)hd));
        const int iq = 32 * qb + r;
        const int more = (ui + 1 < NU) ? 1 : 0;
        const bf16* qrow = z + (m0 + iq) * NZ + C_RQ + 128 * hd + 8 * h;
        bf16x8 qf[8];
#pragma unroll
        for (int ks = 0; ks < 8; ++ks) qf[ks] = *(const bf16x8*)(qrow + 16 * ks);
        f32x16 acc[4];
        const bf16* rp = RP + (size_t)unit * 32768 + (128 * eh + r) * 128 + 8 * h;
        const float xi = exp2f(log2g * (float)(iq + 1));
#pragma unroll
        for (int et = 0; et < 4; ++et) {
            bf16x8 a[8];
#pragma unroll
            for (int ks = 0; ks < 8; ++ks) a[ks] = *(const bf16x8*)(rp + et * 32 * 128 + 16 * ks);
#pragma unroll
            for (int i = 0; i < 16; ++i) acc[et][i] = 0.f;
#pragma unroll
            for (int ks = 0; ks < 8; ++ks) acc[et] = MFMA32(a[ks], qf[ks], acc[et]);
#pragma unroll
            for (int i = 0; i < 16; ++i) acc[et][i] *= xi;
            asm volatile("" ::: "memory");
        }
        ro_wait_bar(2 + more);
        bf16x8 xf[4][2];
        {
            const LAS unsigned char* Kl = F.lds + RING_OFF + ((3 * ui) & 3) * SLOT;
#pragma unroll
            for (int kt = 0; kt < 4; ++kt) {
                if (kt <= qb) {
                    f32x16 X;
#pragma unroll
                    for (int i = 0; i < 16; ++i) X[i] = 0.f;
                    const int key = 32 * kt + r;
#pragma unroll
                    for (int ks = 0; ks < 8; ++ks) { const bf16x8 a = *(const LAS bf16x8*)(Kl + key * 256 + (((2 * ks + h) ^ (key & 15)) << 4)); X = MFMA32(a, qf[ks], X); }
#pragma unroll
                    for (int i = 0; i < 16; ++i) { const int kj = 32 * kt + crow(i, h); X[i] = (kj <= iq) ? X[i] * exp2f(log2g * (float)(iq - kj)) : 0.f; }
                    xf[kt][0] = PACK_STEP(X, 0); xf[kt][1] = PACK_STEP(X, 1);
                }
                __builtin_amdgcn_sched_barrier(0);
            }
        }
#pragma unroll
        for (int vh = 0; vh < 2; ++vh) {
            if (vh == 0) { ro_wait_bar(1 + more); if (more) ro_issue_slot<1>(F, z, ui + 1); }
            else         { ro_wait_bar(2 * more); if (more) ro_issue_slot<2>(F, z, ui + 1); }
            const LAS unsigned char* Vl = F.lds + RING_OFF + ((3 * ui + 1 + vh) & 3) * SLOT;
#pragma unroll
            for (int k2 = 0; k2 < 2; ++k2) {
                const int kt = 2 * vh + k2;
                if (kt <= qb) {
#pragma unroll
                    for (int s2 = 0; s2 < 2; ++s2) {
#pragma unroll
                        for (int et = 0; et < 4; ++et) {
                            const int row = 32 * k2 + 16 * s2 + 4 * h + tq, chunk = 16 * eh + 4 * et + 2 * blk + (tp >> 1);
                            const LAS unsigned char* vp = Vl + row * 512 + ((chunk ^ (tq << 2)) << 4) + 8 * (tp & 1);
                            const s16x4 lo = tr_read(vp), hi = tr_read(vp + 8 * 512);
                            const bf16x8 pa = __builtin_shufflevector(lo, hi, 0, 1, 2, 3, 4, 5, 6, 7);
                            acc[et] = MFMA32(pa, xf[kt][s2], acc[et]);
                        }
                    }
                }
            }
        }
        float ss = 0.f;
#pragma unroll
        for (int et = 0; et < 4; ++et)
#pragma unroll
            for (int i = 0; i < 16; ++i) ss += acc[et][i] * acc[et][i];
        ss += __shfl_xor(ss, 32);
        if (h == 0) red[eh * 128 + iq] = ss;
        asm volatile("s_waitcnt lgkmcnt(0)\n\ts_barrier" ::: "memory");
        if (ui + 2 < NU) ro_issue_slot<0>(F, z, ui + 2);
        const float rstd = 1.f / sqrtf((red[iq] + red[128 + iq]) * (1.f / 256.f) + EPS);
        bf16* grow = z + (m0 + iq) * NZ + C_RG + 256 * hd + 128 * eh + 4 * h;
#pragma unroll
        for (int et = 0; et < 4; ++et)
#pragma unroll
            for (int g4 = 0; g4 < 4; ++g4) {
                bf16* p = grow + 32 * et + 8 * g4;
                const v2u gv = *(const v2u*)p;
                const float g0_ = bflo(gv.x), g1 = bfhi(gv.x), g2 = bflo(gv.y), g3 = bfhi(gv.y);
                const float o0 = acc[et][4 * g4] * rstd * (g0_ / (1.f + __expf(-g0_))), o1 = acc[et][4 * g4 + 1] * rstd * (g1 / (1.f + __expf(-g1)));
                const float o2 = acc[et][4 * g4 + 2] * rstd * (g2 / (1.f + __expf(-g2))), o3 = acc[et][4 * g4 + 3] * rstd * (g3 / (1.f + __expf(-g3)));
                v2u w; w.x = cvtpk(o0, o1); w.y = cvtpk(o2, o3);
                *(v2u*)p = w;
            }
        asm volatile("s_waitcnt lgkmcnt(0)\n\ts_barrier" ::: "memory");
    }
    asm volatile("s_waitcnt vmcnt(0)\n\ts_barrier" ::: "memory");
}

__device__ __forceinline__ void ro2_wait_bar(int cnt) {
    if (cnt >= 24) RO_WAIT_BAR(24); else if (cnt >= 16) RO_WAIT_BAR(16); else if (cnt >= 8) RO_WAIT_BAR(8); else if (cnt >= 4) RO_WAIT_BAR(4); else RO_WAIT_BAR(0);
}
template <int KIND> __device__ __forceinline__ void ro2_issue(CTXP, const bf16* z, const bf16* RP, int ui) {
    int lane = F.lane; asm volatile("" : "+v"(lane));
    const int wave = F.wave;
    const int unit = F.vcu + ui * F.G;
    const int n = unit & 31, hd = (unit >> 5) & 3, b = unit >> 7;
    const size_t m0 = (size_t)b * SEQ + (size_t)n * 128;
    LAS unsigned char* sb = F.lds + RING_OFF + (KIND & 3) * 32768 + wave * 4096;
    if (KIND == 4 || KIND == 5) {
        const int row = 8 * wave + (lane >> 5);
        const bf16* src = z + (m0 + 64 * (KIND - 4) + row) * NZ + C_RV + 256 * hd;
#pragma unroll
        for (int j = 0; j < 4; ++j) { const int c = (lane & 31) ^ (((row + 2 * j) & 3) << 2); glds16(src + (size_t)(2 * j) * NZ + 8 * c, sb + j * 1024); }
    } else {
        const int row = 16 * wave + (lane >> 4);
#pragma unroll
        for (int j = 0; j < 4; ++j) { const int rw = row + 4 * j, c = (lane & 15) ^ (rw & 15);
            const bf16* src;
            if (KIND == 0) src = z + (m0 + rw) * NZ + C_RQ + 128 * hd + 8 * c;
            else if (KIND == 3) src = z + (m0 + rw) * NZ + C_RK + 128 * hd + 8 * c;
            else if (KIND == 1 || KIND == 2) { const int e = (rw < 64 ? rw : 64 + rw) + 64 * (KIND - 1); src = RP + (size_t)unit * 32768 + e * 128 + 8 * c; }
            else { const int e = 128 * (c >> 3) + 64 * (KIND - 6) + 8 * (c & 7); src = z + (m0 + rw) * NZ + C_RG + 256 * hd + e; }
            glds16(src, sb + j * 1024); }
    }
}
__device__ __forceinline__ void phase_ret_out_dma(CTXP, bf16* z, const bf16* RP) {
    constexpr int SLOT = 32768;
    LAS float* red = (LAS float*)(F.lds + LDSCTL_OFF + 1024);
    const int wave = F.wave, qb = wave & 3, eh = wave >> 2;
    const int NU = (BATCH * 4 * 32 - F.vcu + F.G - 1) / F.G;
    if (NU <= 0) return;
    ro2_issue<0>(F, z, RP, 0); ro2_issue<1>(F, z, RP, 0); ro2_issue<2>(F, z, RP, 0);
#pragma unroll 1
    for (int ui = 0; ui < NU; ++ui) {
        int lane = F.lane; asm volatile("" : "+v"(lane));
        const int r = lane & 31, h = lane >> 5, i16 = lane & 15, tq = i16 >> 2, tp = i16 & 3, blk = (lane >> 4) & 1;
        const int unit = F.vcu + ui * F.G;
        const int n = unit & 31, hd = (unit >> 5) & 3, b = unit >> 7;
        const size_t m0 = (size_t)b * SEQ + (size_t)n * 128;
        const float log2g = log2f(1.f - exp2f(-5.f - (float)hd));
        const int iq = 32 * qb + r;
        const int more = (ui + 1 < NU) ? 1 : 0, first = (ui == 0) ? 1 : 0;
        const LAS unsigned char* R0 = F.lds + RING_OFF;
        ro2_wait_bar(first ? 8 : 24);
        ro2_issue<3>(F, z, RP, ui);
        bf16x8 qf[8];
        { const int row = 32 * qb + r;
#pragma unroll
          for (int ks = 0; ks < 8; ++ks) qf[ks] = *(const LAS bf16x8*)(R0 + 0 * SLOT + row * 256 + (((2 * ks + h) ^ (row & 15)) << 4)); }
        f32x16 acc[4];
        const float xi = exp2f(log2g * (float)(iq + 1));
#pragma unroll
        for (int hf = 0; hf < 2; ++hf) {
            if (hf == 0) { ro2_wait_bar(first ? 8 : 24); ro2_issue<4>(F, z, RP, ui); }
            else         { ro2_wait_bar(first ? 8 : 16); ro2_issue<5>(F, z, RP, ui); }
            const LAS unsigned char* Rl = R0 + (1 + hf) * SLOT;
#pragma unroll
            for (int e2 = 0; e2 < 2; ++e2) {
                const int et = 2 * hf + e2, row = 64 * eh + 32 * e2 + r;
#pragma unroll
                for (int i = 0; i < 16; ++i) acc[et][i] = 0.f;
#pragma unroll
                for (int ks = 0; ks < 8; ++ks) { const bf16x8 a = *(const LAS bf16x8*)(Rl + row * 256 + (((2 * ks + h) ^ (row & 15)) << 4)); acc[et] = MFMA32(a, qf[ks], acc[et]); }
#pragma unroll
                for (int i = 0; i < 16; ++i) acc[et][i] *= xi;
            }
        }
        ro2_wait_bar(8);
        ro2_issue<6>(F, z, RP, ui);
        bf16x8 xf[4][2];
        {
            const LAS unsigned char* Kl = R0 + 3 * SLOT;
#pragma unroll
            for (int kt = 0; kt < 4; ++kt) {
                if (kt <= qb) {
                    f32x16 X;
#pragma unroll
                    for (int i = 0; i < 16; ++i) X[i] = 0.f;
                    const int key = 32 * kt + r;
#pragma unroll
                    for (int ks = 0; ks < 8; ++ks) { const bf16x8 a = *(const LAS bf16x8*)(Kl + key * 256 + (((2 * ks + h) ^ (key & 15)) << 4)); X = MFMA32(a, qf[ks], X); }
#pragma unroll
                    for (int i = 0; i < 16; ++i) { const int kj = 32 * kt + crow(i, h); X[i] = (kj <= iq) ? X[i] * exp2f(log2g * (float)(iq - kj)) : 0.f; }
                    xf[kt][0] = PACK_STEP(X, 0); xf[kt][1] = PACK_STEP(X, 1);
                }
                __builtin_amdgcn_sched_barrier(0);
            }
        }
#pragma unroll
        for (int vh = 0; vh < 2; ++vh) {
            ro2_wait_bar(8);
            if (vh == 0) ro2_issue<7>(F, z, RP, ui); else if (more) ro2_issue<0>(F, z, RP, ui + 1);
            const LAS unsigned char* Vl = R0 + vh * SLOT;
#pragma unroll
            for (int k2 = 0; k2 < 2; ++k2) {
                const int kt = 2 * vh + k2;
                if (kt <= qb) {
#pragma unroll
                    for (int s2 = 0; s2 < 2; ++s2) {
#pragma unroll
                        for (int et = 0; et < 4; ++et) {
                            const int row = 32 * k2 + 16 * s2 + 4 * h + tq, chunk = 16 * eh + 4 * et + 2 * blk + (tp >> 1);
                            const LAS unsigned char* vp = Vl + row * 512 + ((chunk ^ (tq << 2)) << 4) + 8 * (tp & 1);
                            const s16x4 lo = tr_read(vp), hi = tr_read(vp + 8 * 512);
                            const bf16x8 pa = __builtin_shufflevector(lo, hi, 0, 1, 2, 3, 4, 5, 6, 7);
                            acc[et] = MFMA32(pa, xf[kt][s2], acc[et]);
                        }
                    }
                }
            }
        }
        float ss = 0.f;
#pragma unroll
        for (int et = 0; et < 4; ++et)
#pragma unroll
            for (int i = 0; i < 16; ++i) ss += acc[et][i] * acc[et][i];
        ss += __shfl_xor(ss, 32);
        if (h == 0) red[eh * 128 + iq] = ss;
        bf16* grow = z + (m0 + iq) * NZ + C_RG + 256 * hd + 128 * eh + 4 * h;
        float rstd = 0.f;
#pragma unroll
        for (int hf = 0; hf < 2; ++hf) {
            if (hf == 0) { asm volatile("s_waitcnt lgkmcnt(0)" ::: "memory"); ro2_wait_bar(4 + 4 * more); if (more) ro2_issue<1>(F, z, RP, ui + 1);
                           rstd = 1.f / sqrtf((red[iq] + red[128 + iq]) * (1.f / 256.f) + EPS); }
            else         { ro2_wait_bar(8 + 8 * more); if (more) ro2_issue<2>(F, z, RP, ui + 1); }
            const LAS unsigned char* Gl = R0 + (2 + hf) * SLOT;
            const int row = 32 * qb + r;
#pragma unroll
            for (int e2 = 0; e2 < 2; ++e2)
#pragma unroll
                for (int g4 = 0; g4 < 4; ++g4) {
                    const int et = 2 * hf + e2, c = 8 * eh + 4 * e2 + g4;
                    const v2u gv = *(const LAS v2u*)(Gl + row * 256 + ((c ^ (row & 15)) << 4) + 8 * h);
                    const float g0_ = bflo(gv.x), g1 = bfhi(gv.x), g2 = bflo(gv.y), g3 = bfhi(gv.y);
                    const float o0 = acc[et][4 * g4] * rstd * (g0_ / (1.f + __expf(-g0_))), o1 = acc[et][4 * g4 + 1] * rstd * (g1 / (1.f + __expf(-g1)));
                    const float o2 = acc[et][4 * g4 + 2] * rstd * (g2 / (1.f + __expf(-g2))), o3 = acc[et][4 * g4 + 3] * rstd * (g3 / (1.f + __expf(-g3)));
                    v2u w; w.x = cvtpk(o0, o1); w.y = cvtpk(o2, o3);
                    *(v2u*)(grow + 32 * et + 8 * g4) = w;
                }
        }
    }
    asm volatile("s_waitcnt vmcnt(0) lgkmcnt(0)\n\ts_barrier" ::: "memory");
}
#ifndef PROBE_AMP
#define PROBE_AMP 0
#define PROBE_MASK 0
#endif
#ifndef MK_PER_PHASE
#define MK_PER_PHASE 0
#endif
constexpr int PPL = 7;
constexpr int NPH = 1 + DEPTH * PPL + 1;
struct Args { const float* in[11]; float* out; unsigned char* ws; int ph_lo, ph_hi; };
typedef __attribute__((address_space(4))) const Args CArgs;
__global__ void __launch_bounds__(NWAVES * 64, 2) mega_fwd(Args args) {
    extern __shared__ __attribute__((aligned(16))) unsigned char lds[];
    volatile LAS unsigned* MISC = (volatile LAS unsigned*)((LAS unsigned char*)lds + MISC_OFF);
    for (int u = threadIdx.x; u < (LDS_BYTES - LDSCTL_OFF) / 4; u += NWAVES * 64) ((LAS unsigned*)((LAS unsigned char*)lds + LDSCTL_OFF))[u] = 0u;
    __syncthreads();
    const int lo = args.ph_lo, hi = args.ph_hi;
    unsigned* ctl = (unsigned*)(args.ws + WS_CTL);
    XcdBarrier bar; bar.bar = ctl + CW_BAR; bar.x = 0; bar.st = nullptr;
    if (hi - lo > 1) { bar = xcd_barrier_post(ctl + CW_BAR, MISC + 8); xcd_barrier_census(bar); }
#pragma unroll 1
    for (int ph = lo; ph < hi; ++ph) {
        CArgs* ap = (CArgs*)__builtin_amdgcn_kernarg_segment_ptr(); asm volatile("" : "+s"(ap));
        int tid = threadIdx.x; asm volatile("" : "+v"(tid));
        Ctx F;
        F.lds = (LAS unsigned char*)lds;
        F.tid = tid; F.lane = tid & 63; F.wave = __builtin_amdgcn_readfirstlane(tid >> 6);
        F.G = gridDim.x; { const int bx = blockIdx.x; F.vcu = (F.G % 8 == 0) ? (bx % 8) * (F.G / 8) + bx / 8 : bx; }
#pragma unroll
        for (int i = 0; i < 11; ++i) F.in[i] = ap->in[i];
        F.out = ap->out; F.ws = ap->ws;
        bf16* const H = (bf16*)(F.ws + WS_H);
        bf16* const Z = (bf16*)(F.ws + WS_Z);
        const int bx = (int)blockIdx.x;
#if PROBE_AMP
        const unsigned long long pt0 = __builtin_amdgcn_s_memrealtime();
#endif
        if (ph == 0) phase_prologue(F);
        else if (ph == NPH - 1) phase_rms_final(F, H, F.out, F.in[10]);
        else {
            const int l = (ph - 1) / PPL, k = (ph - 1) % PPL;
            bf16* const KVb = (bf16*)F.out;
            float* const SS = (float*)(F.ws + WS_SS);
            switch (k) {
            case 0: { pg8::Gemm<M, NZ, D, D> g{H, wsl(F, l, W_WIN)}; pg8::StaticOrder<M, NZ> S; S.init(F.G, bx);
                      pg8::EpiWin E{Z, NZ, (const f32x2*)(F.ws + WS_TABA), (const f32x2*)(F.ws + WS_TABR), SS}; pg8::gemm_phase<pg8::EpiWin, pg8::StaticOrder<M, NZ>, true, true>(F.lds + RING_OFF, g, S, E); } break;
            case 1: phase_ret_state(F, Z, KVb); phase_attn_mfma(F, Z, F.in[3] + l * 8);
                    convert_items(F, l * CI_LAYER + CI_IN, l * CI_LAYER + CI_IN + CI_A + CI_B + CI_O + CI_U); break;
            case 2: phase_ret_out_dma(F, Z, KVb);
                    convert_items(F, l * CI_LAYER + CI_IN + CI_A + CI_B + CI_O + CI_U, (l + 1 < DEPTH) ? (l + 1) * CI_LAYER + CI_IN : (l + 1) * CI_LAYER); break;
            case 3: { pg8::StaticOrder<M, D> S; S.init(F.G, bx);
                      pg8::gemm_phase_gate<M, D, 512, D, NZ, pg8::StaticOrder<M, D>>(F.lds + RING_OFF, Z + C_AQ, wsl(F, l, W_WA), Z + C_RG, wsl(F, l, W_WB), Z + C_GA, NZ, C_GB - C_GA, S); } break;
            case 4: { pg8::Gemm<M, D, D, NZ> g{Z + C_GA, wsl(F, l, W_WOUT)}; pg8::StaticOrder<M, D> S; S.init(F.G, bx);
                      pg8::EpiResBf16 E{H, SS, D}; pg8::gemm_phase<pg8::EpiResBf16, pg8::StaticOrder<M, D>, true, true>(F.lds + RING_OFF, g, S, E); } break;
            case 5: { pg8::Gemm<M, FF, D, D> g{H, wsl(F, l, W_WUP)}; pg8::StaticOrder<M, FF> S; S.init(F.G, bx);
                      pg8::EpiBf16<2> E{Z, FF, SS}; pg8::gemm_phase<pg8::EpiBf16<2>, pg8::StaticOrder<M, FF>, true, true>(F.lds + RING_OFF, g, S, E); } break;
            default: { pg8::Gemm<M, D, FF, FF> g{Z, wsl(F, l, W_WDOWN)}; pg8::StaticOrder<M, D> S; S.init(F.G, bx);
                      pg8::EpiResBf16 E{H, SS, D}; pg8::gemm_phase<pg8::EpiResBf16, pg8::StaticOrder<M, D>, true, true>(F.lds + RING_OFF, g, S, E); } break;
            }
        }
#if PROBE_AMP
        {
            const int cls = (ph == 0) ? 0 : (ph == NPH - 1) ? 9 : 1 + (ph - 1) % PPL;
            __syncthreads();
            const unsigned long long pt1 = __builtin_amdgcn_s_memrealtime();
            if ((PROBE_MASK >> cls) & 1) { const unsigned long long dt = (pt1 - pt0) * PROBE_AMP; while (__builtin_amdgcn_s_memrealtime() - pt1 < dt) __builtin_amdgcn_s_sleep(8); }
        }
#endif
        if (ph + 1 < hi) xcd_barrier(bar);
    }
}

extern "C" void kernel_launch(void* const* d_in, const int* in_sizes, int n_in, void* d_out, int out_size, void* d_ws, size_t ws_size, hipStream_t stream) {
    static int grid = 0;
    if (grid == 0) {
        if (n_in != 11 || in_sizes[0] != M * D || out_size != M * D || ws_size < WS_END) {
            fprintf(stderr, "kernel_launch: unexpected shapes: n_in %d in0 %d out %d ws %zu (need %zu)\n", n_in, n_in > 0 ? in_sizes[0] : -1, out_size, ws_size, (size_t)WS_END); grid = -1; return; }
        int dev = 0, cus = 0, per_cu = 0;
        if (hipGetDevice(&dev) != hipSuccess || hipDeviceGetAttribute(&cus, hipDeviceAttributeMultiprocessorCount, dev) != hipSuccess) { grid = -1; return; }
        if (hipFuncSetAttribute((const void*)mega_fwd, hipFuncAttributeMaxDynamicSharedMemorySize, LDS_BYTES) != hipSuccess) { fprintf(stderr, "kernel_launch: hipFuncSetAttribute failed\n"); grid = -1; return; }
        if (hipOccupancyMaxActiveBlocksPerMultiprocessor(&per_cu, (const void*)mega_fwd, NWAVES * 64, LDS_BYTES) != hipSuccess || per_cu < 1)
            fprintf(stderr, "kernel_launch: occupancy query reports %d workgroups per CU\n", per_cu);
        (void)hipGetLastError();
        grid = cus;
    }
    if (grid < 0) return;
    if (hipMemsetAsync((char*)d_ws + WS_CTL, 0, CTL_ZERO_BYTES, stream) != hipSuccess) return;
    Args a{};
    for (int i = 0; i < 11; ++i) a.in[i] = (const float*)d_in[i];
    a.out = (float*)d_out; a.ws = (unsigned char*)d_ws;
#if MK_PER_PHASE
    for (int p = 0; p < NPH; ++p) { a.ph_lo = p; a.ph_hi = p + 1; hipLaunchKernelGGL(mega_fwd, dim3(grid), dim3(NWAVES * 64), LDS_BYTES, stream, a); }
#else
    a.ph_lo = 0; a.ph_hi = NPH;
    hipLaunchKernelGGL(mega_fwd, dim3(grid), dim3(NWAVES * 64), LDS_BYTES, stream, a);
#endif
}
```

```cpp
#include <hip/hip_runtime.h>
#include <cstdio>
#include <cstdint>
namespace pg8 {
#define PG8_LAS __attribute__((address_space(3)))
typedef unsigned short bf16_t;
typedef short bf16x8 __attribute__((ext_vector_type(8)));
typedef float f32x4 __attribute__((ext_vector_type(4)));
typedef float f32x2 __attribute__((ext_vector_type(2)));
typedef unsigned u32x4 __attribute__((ext_vector_type(4)));
constexpr int BM = 256, BK = 64, HALF = 128, HTB = HALF * BK * 2  , STAGE_BYTES = 8 * HTB, NXCD = 8, WGM = 2;

__host__ __device__ __forceinline__ int lds_byte(int r, int c) { const int st = (r >> 4) * 2 + (c >> 5), rr = r & 15, cc = c & 31, ob = rr * 64 + cc * 2; return st * 1024 + (ob ^ (((ob >> 9) & 1) << 5)); }
__host__ __device__ __forceinline__ void stage_rc(int b, int& R, int& C) { const int st = b / 1024, sb = b % 1024, swz = sb ^ (((sb >> 9) & 1) << 5); R = (st >> 1) * 16 + swz / 64; C = (st & 1) * 32 + (swz % 64) / 2; }
__host__ __device__ __forceinline__ int perm32(int rho) { const int n = rho >> 4, i = rho & 15; return 8 * (i >> 2) + 4 * n + (i & 3); }

struct Unit { int pm, pn; };
template <int M_, int N_, int K_, int LDA_> struct Gemm { const bf16_t* A; const bf16_t* Bt; static constexpr int M = M_, N = N_, K = K_, lda = LDA_; };

template <int M_, int N_> struct StaticOrder {
    static constexpr int nM = M_ / BM, nN = N_ / BM, nwg = nM * nN; int G, c;
    __host__ __device__ void init(int G_, int c_) { G = G_; c = c_; }
    __host__ __device__ bool next(int i, Unit& u) const {
        const long L = (long)i * G + c; if (L >= nwg) return false;
        int wgid = (int)L; { const int q = nwg / NXCD, r = nwg % NXCD, xcd = wgid % NXCD, off = wgid / NXCD; wgid = (xcd < r ? xcd * (q + 1) : r * (q + 1) + (xcd - r) * q) + off; }
        const int nig = WGM * nN, gid = wgid / nig, fm = gid * WGM, gsz = (nM - fm) < WGM ? (nM - fm) : WGM;
        u.pm = fm + ((wgid % nig) % gsz); u.pn = (wgid % nig) / gsz; return true;
    }
    __device__ __forceinline__ void a_ready(const Unit&) const {}
    __device__ __forceinline__ void done(const Unit&) const {}
};

__device__ __forceinline__ unsigned cvt_pk_bf16(float lo, float hi) { unsigned r; asm volatile("v_cvt_pk_bf16_f32 %0, %1, %2" : "=v"(r) : "v"(lo), "v"(hi)); return r; }

__device__ __forceinline__ float row_rstd4(const float* SS, int row, int fq);
template <int ACT  > struct EpiBf16 {
    static constexpr bool PERM = true, AFTER_DRAIN = false;
    bf16_t* O; int ldc; const float* SS;
    __device__ __forceinline__ void operator()(const f32x4 (&acc)[2][2][4][2], const Unit& u, int wr, int wc, int fr, int fq) const {
        const int row0 = u.pm * BM + wr * 64 + fr; const int col0 = u.pn * BM + wc * 32 + 8 * fq;
        float rs[2][4];
        if (SS) {
            f32x4 sv[2][4];
#pragma unroll
            for (int ai = 0; ai < 2; ++ai)
#pragma unroll
                for (int m = 0; m < 4; ++m) sv[ai][m] = *(const f32x4*)(SS + (size_t)(row0 + ai * HALF + m * 16) * 16 + 4 * fq);
#pragma unroll
            for (int ai = 0; ai < 2; ++ai)
#pragma unroll
                for (int m = 0; m < 4; ++m) { float t = (sv[ai][m][0] + sv[ai][m][1]) + (sv[ai][m][2] + sv[ai][m][3]); t += __shfl_xor(t, 16); t += __shfl_xor(t, 32); rs[ai][m] = 1.0f / sqrtf(t * (1.0f / 1024.0f) + 1e-6f); }
        } else {
#pragma unroll
            for (int ai = 0; ai < 2; ++ai)
#pragma unroll
                for (int m = 0; m < 4; ++m) rs[ai][m] = 1.f;
        }
        asm volatile("" ::: "memory");
#pragma unroll
        for (int ai = 0; ai < 2; ++ai)
#pragma unroll
            for (int m = 0; m < 4; ++m) { bf16_t* rowp = O + (size_t)(row0 + ai * HALF + m * 16) * ldc + col0;
#pragma unroll
                for (int bj = 0; bj < 2; ++bj) { f32x4 v0 = acc[ai][bj][m][0] * rs[ai][m], v1 = acc[ai][bj][m][1] * rs[ai][m];
                    if (ACT == 2) {
#pragma unroll
                        for (int i = 0; i < 4; ++i) { const float a = fmaxf(v0[i], 0.f), b = fmaxf(v1[i], 0.f); v0[i] = a * a; v1[i] = b * b; } }
                    u32x4 w; w.x = cvt_pk_bf16(v0[0], v0[1]); w.y = cvt_pk_bf16(v0[2], v0[3]); w.z = cvt_pk_bf16(v1[0], v1[1]); w.w = cvt_pk_bf16(v1[2], v1[3]);
                    *(u32x4*)(rowp + bj * HALF) = w; } }
    }
};
struct EpiResF32 {
    static constexpr bool PERM = false, AFTER_DRAIN = false;
    const float* base; float* out; int ldc;
    __device__ __forceinline__ void operator()(const f32x4 (&acc)[2][2][4][2], const Unit& u, int wr, int wc, int fr, int fq) const {
        const int col0 = u.pn * BM + wc * 32 + 4 * fq;
#pragma unroll
        for (int ai = 0; ai < 2; ++ai)
#pragma unroll
            for (int m = 0; m < 4; ++m) { const int r = ai * HALF + wr * 64 + m * 16 + fr; const size_t off = (size_t)(u.pm * BM + r) * ldc + col0;
#pragma unroll
                for (int bj = 0; bj < 2; ++bj)
#pragma unroll
                    for (int n = 0; n < 2; ++n) { const f32x4 bs = *(const f32x4*)(base + off + bj * HALF + n * 16); *(f32x4*)(out + off + bj * HALF + n * 16) = bs + acc[ai][bj][m][n]; } }
    }
};

template <int PASS> struct EpiGate {
    static constexpr bool PERM = true, AFTER_DRAIN = false;
    bf16_t* Zg; int ldc; int gboff;
    static __device__ __forceinline__ float sig(float x) { return __builtin_amdgcn_rcpf(1.f + __expf(-x)); }
    static __device__ __forceinline__ float lo(unsigned w) { return __builtin_bit_cast(float, w << 16); }
    static __device__ __forceinline__ float hi(unsigned w) { return __builtin_bit_cast(float, w & 0xffff0000u); }
    __device__ __forceinline__ void operator()(const f32x4 (&acc)[2][2][4][2], const Unit& u, int wr, int wc, int fr, int fq) const {
        const int row0 = u.pm * BM + wr * 64 + fr; const int col0 = u.pn * BM + wc * 32 + 8 * fq;
#pragma unroll
        for (int ai = 0; ai < 2; ++ai)
#pragma unroll
            for (int m = 0; m < 4; ++m) { bf16_t* rowp = Zg + (size_t)(row0 + ai * HALF + m * 16) * ldc + col0;
#pragma unroll
                for (int bj = 0; bj < 2; ++bj) { const f32x4 v0 = acc[ai][bj][m][0], v1 = acc[ai][bj][m][1]; bf16_t* p = rowp + bj * HALF;
                    const u32x4 g = *(const u32x4*)(p + (PASS == 0 ? 0 : gboff));
                    float o[8] = {sig(lo(g.x)) * v0[0], sig(hi(g.x)) * v0[1], sig(lo(g.y)) * v0[2], sig(hi(g.y)) * v0[3], sig(lo(g.z)) * v1[0], sig(hi(g.z)) * v1[1], sig(lo(g.w)) * v1[2], sig(hi(g.w)) * v1[3]};
                    if (PASS == 1) { const u32x4 t = *(const u32x4*)p; o[0] += lo(t.x); o[1] += hi(t.x); o[2] += lo(t.y); o[3] += hi(t.y); o[4] += lo(t.z); o[5] += hi(t.z); o[6] += lo(t.w); o[7] += hi(t.w); }
                    u32x4 w; w.x = cvt_pk_bf16(o[0], o[1]); w.y = cvt_pk_bf16(o[2], o[3]); w.z = cvt_pk_bf16(o[4], o[5]); w.w = cvt_pk_bf16(o[6], o[7]);
                    *(u32x4*)p = w; } }
    }
};
__host__ __device__ __forceinline__ int win_colmap(int rho) {
    const int pn = rho >> 8, bj = (rho >> 7) & 1, p = rho & 127;
    if (pn <= 1) return 256 * pn + 64 * (p >> 5) + (p & 31) + 32 * bj;
    if (pn == 2) return (p < 64) ? 512 + 64 * (p >> 5) + (p & 31) + 32 * bj : 640 + (p - 64) + 64 * bj;
    if (pn <= 4) return 768 + 256 * (pn - 3) + 128 * (p >> 6) + 2 * (p & 63) + bj;
    if (pn <= 6) return 1280 + 256 * (pn - 5) + 128 * (p >> 6) + 2 * (p & 63) + bj;
    return rho;
}
struct EpiWin {
    static constexpr bool PERM = true, AFTER_DRAIN = false;
    bf16_t* Z; int ldc; const f32x2* tabA; const f32x2* tabR; const float* SS;
    __device__ __forceinline__ void operator()(const f32x4 (&acc)[2][2][4][2], const Unit& u, int wr, int wc, int fr, int fq) const {
        const int row0 = u.pm * BM + wr * 64 + fr, pn = u.pn;
        int mode, c0, c1, fb = 0; float sc = 1.f;
        if (pn <= 1)      { mode = 1; c0 = 256 * pn + 64 * wc + 8 * fq; c1 = c0 + 32; fb = 8 * fq; }
        else if (pn == 2) { if (wc < 2) { mode = 1; c0 = 512 + 64 * wc + 8 * fq; c1 = c0 + 32; fb = 8 * fq; } else { mode = 0; c0 = 640 + 32 * (wc - 2) + 8 * fq; c1 = c0 + 64; } }
        else if (pn <= 6) { mode = 2; const int base = (pn <= 4) ? 768 + 256 * (pn - 3) : 1280 + 256 * (pn - 5); c0 = base + 128 * (wc >> 1) + 32 * (wc & 1) + 8 * fq; c1 = c0 + 64; fb = 32 * (wc & 1) + 8 * fq;
                            sc = (pn >= 5) ? 0.08838834764831845f : 1.f; }
        else              { mode = 0; c0 = 256 * pn + 32 * wc + 8 * fq; c1 = c0 + HALF; }
        f32x4 sv[2][4];
#pragma unroll
        for (int ai = 0; ai < 2; ++ai)
#pragma unroll
            for (int m = 0; m < 4; ++m) sv[ai][m] = *(const f32x4*)(SS + (size_t)(row0 + ai * HALF + m * 16) * 16 + 4 * fq);
        float rs[2][4];
#pragma unroll
        for (int ai = 0; ai < 2; ++ai)
#pragma unroll
            for (int m = 0; m < 4; ++m) { float t = (sv[ai][m][0] + sv[ai][m][1]) + (sv[ai][m][2] + sv[ai][m][3]); t += __shfl_xor(t, 16); t += __shfl_xor(t, 32); rs[ai][m] = 1.0f / sqrtf(t * (1.0f / 1024.0f) + 1e-6f); }
        if (mode == 0) {
#pragma unroll
            for (int ai = 0; ai < 2; ++ai)
#pragma unroll
                for (int m = 0; m < 4; ++m) { bf16_t* rowp = Z + (size_t)(row0 + ai * HALF + m * 16) * ldc; const float r_ = rs[ai][m];
                    const f32x4 a0 = acc[ai][0][m][0] * r_, a1 = acc[ai][0][m][1] * r_, b0 = acc[ai][1][m][0] * r_, b1 = acc[ai][1][m][1] * r_;
                    *(u32x4*)(rowp + c0) = (u32x4){cvt_pk_bf16(a0[0], a0[1]), cvt_pk_bf16(a0[2], a0[3]), cvt_pk_bf16(a1[0], a1[1]), cvt_pk_bf16(a1[2], a1[3])};
                    *(u32x4*)(rowp + c1) = (u32x4){cvt_pk_bf16(b0[0], b0[1]), cvt_pk_bf16(b0[2], b0[3]), cvt_pk_bf16(b1[0], b1[1]), cvt_pk_bf16(b1[2], b1[3])}; }
        } else {
#pragma unroll
            for (int ai = 0; ai < 2; ++ai)
#pragma unroll
                for (int m = 0; m < 4; ++m) { const int row = row0 + ai * HALF + m * 16, pos = row & 4095; bf16_t* rowp = Z + (size_t)row * ldc; const float scr = sc * rs[ai][m];
                    const f32x4* tp = (mode == 1) ? (const f32x4*)(tabA + pos * 32 + fb) : (const f32x4*)(tabR + pos * 64 + fb);
                    const f32x4 t0 = tp[0], t1 = tp[1], t2 = tp[2], t3 = tp[3];
                    const f32x4 x0 = acc[ai][0][m][0], x1 = acc[ai][0][m][1], y0 = acc[ai][1][m][0], y1 = acc[ai][1][m][1];
                    const f32x4 a0 = {(x0[0] * t0[0] - y0[0] * t0[1]) * scr, (x0[1] * t0[2] - y0[1] * t0[3]) * scr, (x0[2] * t1[0] - y0[2] * t1[1]) * scr, (x0[3] * t1[2] - y0[3] * t1[3]) * scr};
                    const f32x4 a1 = {(x1[0] * t2[0] - y1[0] * t2[1]) * scr, (x1[1] * t2[2] - y1[1] * t2[3]) * scr, (x1[2] * t3[0] - y1[2] * t3[1]) * scr, (x1[3] * t3[2] - y1[3] * t3[3]) * scr};
                    const f32x4 b0 = {(y0[0] * t0[0] + x0[0] * t0[1]) * scr, (y0[1] * t0[2] + x0[1] * t0[3]) * scr, (y0[2] * t1[0] + x0[2] * t1[1]) * scr, (y0[3] * t1[2] + x0[3] * t1[3]) * scr};
                    const f32x4 b1 = {(y1[0] * t2[0] + x1[0] * t2[1]) * scr, (y1[1] * t2[2] + x1[1] * t2[3]) * scr, (y1[2] * t3[0] + x1[2] * t3[1]) * scr, (y1[3] * t3[2] + x1[3] * t3[3]) * scr};
                    *(u32x4*)(rowp + c0) = (u32x4){cvt_pk_bf16(a0[0], a0[1]), cvt_pk_bf16(a0[2], a0[3]), cvt_pk_bf16(a1[0], a1[1]), cvt_pk_bf16(a1[2], a1[3])};
                    *(u32x4*)(rowp + c1) = (u32x4){cvt_pk_bf16(b0[0], b0[1]), cvt_pk_bf16(b0[2], b0[3]), cvt_pk_bf16(b1[0], b1[1]), cvt_pk_bf16(b1[2], b1[3])}; }
        }
    }
};

__device__ __forceinline__ float row_rstd(const float* SS, int row) {
    const f32x4* s = (const f32x4*)(SS + (size_t)row * 16); const f32x4 a = s[0], b = s[1], c = s[2], d = s[3];
    const float t = ((a[0] + a[1]) + (a[2] + a[3])) + ((b[0] + b[1]) + (b[2] + b[3])) + ((c[0] + c[1]) + (c[2] + c[3])) + ((d[0] + d[1]) + (d[2] + d[3]));
    return 1.0f / sqrtf(t * (1.0f / 1024.0f) + 1e-6f);
}
__device__ __forceinline__ float row_rstd4(const float* SS, int row, int fq) {
    const f32x4 a = *(const f32x4*)(SS + (size_t)row * 16 + 4 * fq);
    float t = (a[0] + a[1]) + (a[2] + a[3]);
    t += __shfl_xor(t, 16); t += __shfl_xor(t, 32);
    return 1.0f / sqrtf(t * (1.0f / 1024.0f) + 1e-6f);
}
struct EpiResBf16 {
    static constexpr bool PERM = true, AFTER_DRAIN = false;
    bf16_t* X; float* SS; int ldc;
    static __device__ __forceinline__ float lo(unsigned w) { return __builtin_bit_cast(float, w << 16); }
    static __device__ __forceinline__ float hi(unsigned w) { return __builtin_bit_cast(float, w & 0xffff0000u); }
    __device__ __forceinline__ void operator()(const f32x4 (&acc)[2][2][4][2], const Unit& u, int wr, int wc, int fr, int fq) const {
        const int row0 = u.pm * BM + wr * 64 + fr; const int col0 = u.pn * BM + wc * 32 + 8 * fq;
        u32x4 bv[2][4][2];
#pragma unroll
        for (int ai = 0; ai < 2; ++ai)
#pragma unroll
            for (int m = 0; m < 4; ++m)
#pragma unroll
                for (int bj = 0; bj < 2; ++bj) bv[ai][m][bj] = *(const u32x4*)(X + (size_t)(row0 + ai * HALF + m * 16) * ldc + col0 + bj * HALF);
        asm volatile("" ::: "memory");
#pragma unroll
        for (int ai = 0; ai < 2; ++ai)
#pragma unroll
            for (int m = 0; m < 4; ++m) { const int row = row0 + ai * HALF + m * 16; bf16_t* rowp = X + (size_t)row * ldc + col0; float ss = 0.f;
#pragma unroll
                for (int bj = 0; bj < 2; ++bj) { bf16_t* p = rowp + bj * HALF; const u32x4 b = bv[ai][m][bj]; const f32x4 v0 = acc[ai][bj][m][0], v1 = acc[ai][bj][m][1];
                    const float o0 = lo(b.x) + v0[0], o1 = hi(b.x) + v0[1], o2 = lo(b.y) + v0[2], o3 = hi(b.y) + v0[3], o4 = lo(b.z) + v1[0], o5 = hi(b.z) + v1[1], o6 = lo(b.w) + v1[2], o7 = hi(b.w) + v1[3];
                    ss += ((o0 * o0 + o1 * o1) + (o2 * o2 + o3 * o3)) + ((o4 * o4 + o5 * o5) + (o6 * o6 + o7 * o7));
                    u32x4 w; w.x = cvt_pk_bf16(o0, o1); w.y = cvt_pk_bf16(o2, o3); w.z = cvt_pk_bf16(o4, o5); w.w = cvt_pk_bf16(o6, o7);
                    *(u32x4*)p = w; }
                ss += __shfl_xor(ss, 16); ss += __shfl_xor(ss, 32);
                if (fq == 0) SS[(size_t)row * 16 + u.pn * 4 + wc] = ss; }
    }
};

template <class Epi, class Sched, bool ALIGN_EPI, bool SP2, class GemmT>
__device__ __forceinline__ void gemm_phase(PG8_LAS unsigned char* lds, const GemmT g, const Sched& S, const Epi& E) {
    int tid_ = threadIdx.x; asm volatile("" : "+v"(tid_));
    const int tid = tid_, wid = __builtin_amdgcn_readfirstlane(tid >> 6), lane = tid & 63, wr = wid >> 2, wc = wid & 3, fr = lane & 15, fq = lane >> 4;
    constexpr int K = GemmT::K, nt = K / BK, lda = GemmT::lda;
    unsigned voffA[2], voffB[2];
#pragma unroll
    for (int i = 0; i < 2; ++i) { int R, C; stage_rc(tid * 16 + i * 8192, R, C); const int Rb = Epi::PERM ? ((R & ~31) + perm32(R & 31)) : R;
        voffA[i] = (unsigned)(R * lda + C) * 2u; voffB[i] = (unsigned)(Rb * K + C) * 2u; }
    constexpr size_t kstep = (size_t)(BK * 2);
    constexpr size_t hstepA = (size_t)HALF * lda * 2, hstepB = (size_t)HALF * K * 2;
    constexpr size_t tstepA = 2 * hstepA, tstepB = 2 * hstepB;
    const unsigned ldsw = (unsigned)wid * 1024u;
    const int aoff = lds_byte(wr * 64 + fr, fq * 8), boff = lds_byte(wc * 32 + fr, fq * 8);
#define PG8_SA(b, h) (((b) * 2 + (h)) * HTB)
#define PG8_SB(b, h) ((4 + (b) * 2 + (h)) * HTB)
#define PG8_STAGE(bufoff, gbase, voff) do { _Pragma("unroll") for (int _i = 0; _i < 2; ++_i) \
        __builtin_amdgcn_global_load_lds((const unsigned*)((const char*)(gbase) + (voff)[_i]), (PG8_LAS unsigned*)(lds + (bufoff) + ldsw + _i * 8192), 16, 0, 0); } while (0)
#define PG8_LDA(dst, b, h) do { _Pragma("unroll") for (int m = 0; m < 4; ++m) _Pragma("unroll") for (int k = 0; k < 2; ++k) dst[m][k] = *(const PG8_LAS bf16x8*)(lds + PG8_SA(b, h) + aoff + m * 2048 + k * 1024); } while (0)
#define PG8_LDB(dst, b, h) do { _Pragma("unroll") for (int n = 0; n < 2; ++n) _Pragma("unroll") for (int k = 0; k < 2; ++k) dst[n][k] = *(const PG8_LAS bf16x8*)(lds + PG8_SB(b, h) + boff + n * 2048 + k * 1024); } while (0)
#define PG8_MMA(ai, bj, At, Bt) do { __builtin_amdgcn_s_setprio(1); _Pragma("unroll") for (int m = 0; m < 4; ++m) _Pragma("unroll") for (int n = 0; n < 2; ++n) _Pragma("unroll") for (int k = 0; k < 2; ++k) \
        acc[ai][bj][m][n] = __builtin_amdgcn_mfma_f32_16x16x32_bf16(Bt[n][k], At[m][k], acc[ai][bj][m][n], 0, 0, 0); __builtin_amdgcn_s_setprio(0); } while (0)
#define PG8_WAIT_V(n) asm volatile("s_waitcnt vmcnt(" #n ")" ::: "memory")
#define PG8_WAIT_L(n) asm volatile("s_waitcnt lgkmcnt(" #n ")" ::: "memory")
#define PG8_BAR __builtin_amdgcn_s_barrier()
#define PG8_SCHED __builtin_amdgcn_sched_barrier(0)
    Unit cur, nxt; int ui = 0;
    if (!S.next(0, cur)) return;
    f32x4 acc[2][2][4][2];
#pragma unroll
    for (int a = 0; a < 2; ++a)
#pragma unroll
        for (int b = 0; b < 2; ++b)
#pragma unroll
            for (int m = 0; m < 4; ++m)
#pragma unroll
                for (int n = 0; n < 2; ++n) acc[a][b][m][n] = (f32x4){0.f, 0.f, 0.f, 0.f};
    bf16x8 At[4][2], B0[2][2], B1[2][2];
    const char* cA = (const char*)g.A + (size_t)cur.pm * tstepA; const char* cB = (const char*)g.Bt + (size_t)cur.pn * tstepB;
    S.a_ready(cur);
    if constexpr (SP2) {
        PG8_STAGE(PG8_SB(0, 0), cB, voffB); PG8_STAGE(PG8_SB(0, 1), cB + hstepB, voffB); PG8_STAGE(PG8_SA(0, 0), cA, voffA); PG8_STAGE(PG8_SA(0, 1), cA + hstepA, voffA);
        if (wr == 1) PG8_BAR;
        PG8_WAIT_V(2); PG8_BAR;
        PG8_STAGE(PG8_SB(1, 0), cB + kstep, voffB); PG8_STAGE(PG8_SA(1, 0), cA + kstep, voffA); PG8_STAGE(PG8_SB(1, 1), cB + hstepB + kstep, voffB);
        PG8_WAIT_V(6); PG8_BAR;
    } else {
        PG8_STAGE(PG8_SB(0, 0), cB, voffB); PG8_STAGE(PG8_SA(0, 0), cA, voffA); PG8_STAGE(PG8_SB(0, 1), cB + hstepB, voffB); PG8_STAGE(PG8_SA(0, 1), cA + hstepA, voffA);
        if (wr == 1) PG8_BAR;
        PG8_WAIT_V(4); PG8_BAR;
        PG8_STAGE(PG8_SB(1, 0), cB + kstep, voffB); PG8_STAGE(PG8_SA(1, 0), cA + kstep, voffA); PG8_STAGE(PG8_SB(1, 1), cB + hstepB + kstep, voffB);
        PG8_WAIT_V(6); PG8_BAR;
    }
    for (;;) {
        const bool has_next = S.next(ui + 1, nxt);
        const char* nA = has_next ? (const char*)g.A + (size_t)nxt.pm * tstepA : cA; const char* nB = has_next ? (const char*)g.Bt + (size_t)nxt.pn * tstepB : cB;
#pragma unroll 1
        for (int t = 0; t < nt; t += 2) {
            const bool last = (t == nt - 2);
            const char* a1 = cA + (size_t)(t + 1) * kstep;
            const char* a2 = last ? nA : cA + (size_t)(t + 2) * kstep; const char* b2 = last ? nB : cB + (size_t)(t + 2) * kstep;
            const char* a3 = a2 + kstep; const char* b3 = b2 + kstep;
            if (last && has_next) S.a_ready(nxt);
            if constexpr (SP2) {
            PG8_LDB(B0, 0, 0); PG8_LDB(B1, 0, 1); PG8_SCHED; PG8_LDA(At, 0, 0); PG8_STAGE(PG8_SA(1, 1), a1 + hstepA, voffA);
            PG8_WAIT_V(8); PG8_WAIT_L(0); PG8_BAR; PG8_MMA(0, 0, At, B0); PG8_MMA(0, 1, At, B1); PG8_BAR; PG8_SCHED;
            PG8_LDA(At, 0, 1); PG8_STAGE(PG8_SB(0, 0), b2, voffB); PG8_STAGE(PG8_SB(0, 1), b2 + hstepB, voffB); PG8_STAGE(PG8_SA(0, 0), a2, voffA);
            PG8_WAIT_V(8); PG8_WAIT_L(0); PG8_BAR; PG8_MMA(1, 0, At, B0); PG8_MMA(1, 1, At, B1); PG8_BAR; PG8_SCHED;
            PG8_LDB(B0, 1, 0); PG8_LDB(B1, 1, 1); PG8_SCHED; PG8_LDA(At, 1, 0); PG8_STAGE(PG8_SA(0, 1), a2 + hstepA, voffA);
            PG8_WAIT_V(8); PG8_WAIT_L(0); PG8_BAR; PG8_MMA(0, 0, At, B0); PG8_MMA(0, 1, At, B1); PG8_BAR; PG8_SCHED;
            PG8_LDA(At, 1, 1); PG8_STAGE(PG8_SB(1, 0), b3, voffB); PG8_STAGE(PG8_SB(1, 1), b3 + hstepB, voffB); PG8_STAGE(PG8_SA(1, 0), a3, voffA);
            PG8_WAIT_V(8); PG8_WAIT_L(0); PG8_BAR; PG8_MMA(1, 0, At, B0); PG8_MMA(1, 1, At, B1); PG8_BAR; PG8_SCHED;
            } else {
            PG8_LDB(B0, 0, 0); PG8_SCHED; PG8_LDA(At, 0, 0); PG8_STAGE(PG8_SA(1, 1), a1 + hstepA, voffA);
            PG8_WAIT_L(8); PG8_BAR; PG8_WAIT_L(0); PG8_MMA(0, 0, At, B0); PG8_BAR; PG8_SCHED;
            PG8_LDB(B1, 0, 1); PG8_STAGE(PG8_SB(0, 0), b2, voffB);
            PG8_BAR; PG8_WAIT_L(0); PG8_MMA(0, 1, At, B1); PG8_BAR;
            PG8_LDA(At, 0, 1); PG8_STAGE(PG8_SA(0, 0), a2, voffA);
            PG8_BAR; PG8_WAIT_L(0); PG8_MMA(1, 0, At, B0); PG8_BAR; PG8_SCHED;
            PG8_STAGE(PG8_SB(0, 1), b2 + hstepB, voffB);
            PG8_WAIT_V(6); PG8_BAR; PG8_MMA(1, 1, At, B1); PG8_BAR;
            PG8_LDB(B0, 1, 0); PG8_SCHED; PG8_LDA(At, 1, 0); PG8_STAGE(PG8_SA(0, 1), a2 + hstepA, voffA);
            PG8_WAIT_L(8); PG8_BAR; PG8_WAIT_L(0); PG8_MMA(0, 0, At, B0); PG8_BAR; PG8_SCHED;
            PG8_LDB(B1, 1, 1); PG8_STAGE(PG8_SB(1, 0), b3, voffB);
            PG8_BAR; PG8_WAIT_L(0); PG8_MMA(0, 1, At, B1); PG8_BAR;
            PG8_LDA(At, 1, 1); PG8_STAGE(PG8_SA(1, 0), a3, voffA);
            PG8_BAR; PG8_WAIT_L(0); PG8_MMA(1, 0, At, B0); PG8_BAR; PG8_SCHED;
            PG8_STAGE(PG8_SB(1, 1), b3 + hstepB, voffB);
            PG8_WAIT_V(6); PG8_BAR; PG8_MMA(1, 1, At, B1); PG8_BAR;
            }
        }
        if constexpr (ALIGN_EPI) { if (wr == 0) PG8_BAR; }
        if constexpr (!Epi::AFTER_DRAIN) { E(acc, cur, wr, wc, fr, fq); S.done(cur); }
        if (!has_next) break;
#pragma unroll
        for (int a = 0; a < 2; ++a)
#pragma unroll
            for (int b = 0; b < 2; ++b)
#pragma unroll
                for (int m = 0; m < 4; ++m)
#pragma unroll
                    for (int n = 0; n < 2; ++n) acc[a][b][m][n] = (f32x4){0.f, 0.f, 0.f, 0.f};
        cur = nxt; cA = nA; cB = nB; ++ui;
        if constexpr (ALIGN_EPI) { if (wr == 1) PG8_BAR; }
    }
    PG8_WAIT_V(0);
    if constexpr (!ALIGN_EPI) { if (wr == 0) PG8_BAR; }
    PG8_BAR;
    if constexpr (Epi::AFTER_DRAIN) { E.fused(acc, cur, wr, wc, fr, fq, lds, wid, lane); S.done(cur); }
#undef PG8_SA
#undef PG8_SB
#undef PG8_STAGE
#undef PG8_LDA
#undef PG8_LDB
#undef PG8_MMA
#undef PG8_WAIT_V
#undef PG8_WAIT_L
#undef PG8_BAR
#undef PG8_SCHED
}
template <int M_, int N_, int K1, int K2, int LDA, class Sched>
__device__ __forceinline__ void gemm_phase_gate(PG8_LAS unsigned char* lds, const bf16_t* A1, const bf16_t* B1t, const bf16_t* A2, const bf16_t* B2t, bf16_t* Zg, int ldc, int gboff, const Sched& S) {
    int tid_ = threadIdx.x; asm volatile("" : "+v"(tid_));
    const int tid = tid_, wid = __builtin_amdgcn_readfirstlane(tid >> 6), lane = tid & 63, wr = wid >> 2, wc = wid & 3, fr = lane & 15, fq = lane >> 4;
    constexpr int NT1 = K1 / BK, nt = (K1 + K2) / BK, lda = LDA;
    static_assert(NT1 % 2 == 0 && nt % 2 == 0, "segments are whole loop trips");
    unsigned voffA[2], voffB1[2], voffB2[2];
#pragma unroll
    for (int i = 0; i < 2; ++i) { int R, C; stage_rc(tid * 16 + i * 8192, R, C); const int Rb = (R & ~31) + perm32(R & 31);
        voffA[i] = (unsigned)(R * lda + C) * 2u; voffB1[i] = (unsigned)(Rb * K1 + C) * 2u; voffB2[i] = (unsigned)(Rb * K2 + C) * 2u; }
    constexpr size_t kstep = (size_t)(BK * 2);
    constexpr size_t hstepA = (size_t)HALF * lda * 2, hstepB1 = (size_t)HALF * K1 * 2, hstepB2 = (size_t)HALF * K2 * 2;
    constexpr size_t tstepA = 2 * hstepA, tstepB1 = 2 * hstepB1, tstepB2 = 2 * hstepB2;
    const unsigned ldsw = (unsigned)wid * 1024u;
    const int aoff = lds_byte(wr * 64 + fr, fq * 8), boff = lds_byte(wc * 32 + fr, fq * 8);
#define PG8_SA(b, h) (((b) * 2 + (h)) * HTB)
#define PG8_SB(b, h) ((4 + (b) * 2 + (h)) * HTB)
#define PG8_STAGE(bufoff, gbase, voff) do { _Pragma("unroll") for (int _i = 0; _i < 2; ++_i) \
        __builtin_amdgcn_global_load_lds((const unsigned*)((const char*)(gbase) + (voff)[_i]), (PG8_LAS unsigned*)(lds + (bufoff) + ldsw + _i * 8192), 16, 0, 0); } while (0)
#define PG8_LDA(dst, b, h) do { _Pragma("unroll") for (int m = 0; m < 4; ++m) _Pragma("unroll") for (int k = 0; k < 2; ++k) dst[m][k] = *(const PG8_LAS bf16x8*)(lds + PG8_SA(b, h) + aoff + m * 2048 + k * 1024); } while (0)
#define PG8_LDB(dst, b, h) do { _Pragma("unroll") for (int n = 0; n < 2; ++n) _Pragma("unroll") for (int k = 0; k < 2; ++k) dst[n][k] = *(const PG8_LAS bf16x8*)(lds + PG8_SB(b, h) + boff + n * 2048 + k * 1024); } while (0)
#define PG8_MMA(ai, bj, At, Bt) do { __builtin_amdgcn_s_setprio(1); _Pragma("unroll") for (int m = 0; m < 4; ++m) _Pragma("unroll") for (int n = 0; n < 2; ++n) _Pragma("unroll") for (int k = 0; k < 2; ++k) \
        acc[ai][bj][m][n] = __builtin_amdgcn_mfma_f32_16x16x32_bf16(Bt[n][k], At[m][k], acc[ai][bj][m][n], 0, 0, 0); __builtin_amdgcn_s_setprio(0); } while (0)
#define PG8_WAIT_V(n) asm volatile("s_waitcnt vmcnt(" #n ")" ::: "memory")
#define PG8_WAIT_L(n) asm volatile("s_waitcnt lgkmcnt(" #n ")" ::: "memory")
#define PG8_BAR __builtin_amdgcn_s_barrier()
#define PG8_SCHED __builtin_amdgcn_sched_barrier(0)
    Unit cur, nxt; int ui = 0;
    if (!S.next(0, cur)) return;
    f32x4 acc[2][2][4][2];
#pragma unroll
    for (int a = 0; a < 2; ++a)
#pragma unroll
        for (int b = 0; b < 2; ++b)
#pragma unroll
            for (int m = 0; m < 4; ++m)
#pragma unroll
                for (int n = 0; n < 2; ++n) acc[a][b][m][n] = (f32x4){0.f, 0.f, 0.f, 0.f};
    bf16x8 At[4][2], B0[2][2], B1[2][2];
    const char* cA1 = (const char*)A1 + (size_t)cur.pm * tstepA; const char* cB1 = (const char*)B1t + (size_t)cur.pn * tstepB1;
    const char* cA2 = (const char*)A2 + (size_t)cur.pm * tstepA; const char* cB2 = (const char*)B2t + (size_t)cur.pn * tstepB2;
    PG8_STAGE(PG8_SB(0, 0), cB1, voffB1); PG8_STAGE(PG8_SB(0, 1), cB1 + hstepB1, voffB1); PG8_STAGE(PG8_SA(0, 0), cA1, voffA); PG8_STAGE(PG8_SA(0, 1), cA1 + hstepA, voffA);
    if (wr == 1) PG8_BAR;
    PG8_WAIT_V(2); PG8_BAR;
    PG8_STAGE(PG8_SB(1, 0), cB1 + kstep, voffB1); PG8_STAGE(PG8_SA(1, 0), cA1 + kstep, voffA); PG8_STAGE(PG8_SB(1, 1), cB1 + hstepB1 + kstep, voffB1);
    PG8_WAIT_V(6); PG8_BAR;
    for (;;) {
        const bool has_next = S.next(ui + 1, nxt);
        const char* nA1 = has_next ? (const char*)A1 + (size_t)nxt.pm * tstepA : cA1; const char* nB1 = has_next ? (const char*)B1t + (size_t)nxt.pn * tstepB1 : cB1;
        const int row0 = cur.pm * BM + wr * 64 + fr, col0 = cur.pn * BM + wc * 32 + 8 * fq;
#pragma unroll 1
        for (int t = 0; t < nt; t += 2) {
            const bool last = (t == nt - 2);
            const bool seg2 = (t >= NT1);
            const bool nseg2 = !last && (t + 2 >= NT1);
            const char* a1 = seg2 ? cA2 + (size_t)(t + 1 - NT1) * kstep : cA1 + (size_t)(t + 1) * kstep;
            const char* a2 = last ? nA1 : (nseg2 ? cA2 + (size_t)(t + 2 - NT1) * kstep : cA1 + (size_t)(t + 2) * kstep);
            const char* b2 = last ? nB1 : (nseg2 ? cB2 + (size_t)(t + 2 - NT1) * kstep : cB1 + (size_t)(t + 2) * kstep);
            const char* a3 = a2 + kstep; const char* b3 = b2 + kstep;
            unsigned vB[2]; vB[0] = nseg2 ? voffB2[0] : voffB1[0]; vB[1] = nseg2 ? voffB2[1] : voffB1[1];
            const size_t hB = nseg2 ? hstepB2 : hstepB1;
            if (t == NT1) {
#pragma unroll
                for (int ai = 0; ai < 2; ++ai)
#pragma unroll
                    for (int m = 0; m < 4; ++m) { const bf16_t* rowp = Zg + (size_t)(row0 + ai * HALF + m * 16) * ldc + col0;
#pragma unroll
                        for (int bj = 0; bj < 2; ++bj) { const bf16_t* pp = rowp + bj * HALF; const u32x4 ga = *(const u32x4*)pp, gb = *(const u32x4*)(pp + gboff);
#define PG8_RHO(GA, GB, LOHI) ((1.f + __expf(-fmaxf(EpiGate<0>::LOHI(GB), -30.f))) * __builtin_amdgcn_rcpf(1.f + __expf(-EpiGate<0>::LOHI(GA))))
                            f32x4 r0 = {PG8_RHO(ga.x, gb.x, lo), PG8_RHO(ga.x, gb.x, hi), PG8_RHO(ga.y, gb.y, lo), PG8_RHO(ga.y, gb.y, hi)};
                            f32x4 r1 = {PG8_RHO(ga.z, gb.z, lo), PG8_RHO(ga.z, gb.z, hi), PG8_RHO(ga.w, gb.w, lo), PG8_RHO(ga.w, gb.w, hi)};
#undef PG8_RHO
                            acc[ai][bj][m][0] = acc[ai][bj][m][0] * r0; acc[ai][bj][m][1] = acc[ai][bj][m][1] * r1; } }
            }
            PG8_LDB(B0, 0, 0); PG8_LDB(B1, 0, 1); PG8_SCHED; PG8_LDA(At, 0, 0); PG8_STAGE(PG8_SA(1, 1), a1 + hstepA, voffA);
            PG8_WAIT_V(8); PG8_WAIT_L(0); PG8_BAR; PG8_MMA(0, 0, At, B0); PG8_MMA(0, 1, At, B1); PG8_BAR; PG8_SCHED;
            PG8_LDA(At, 0, 1); PG8_STAGE(PG8_SB(0, 0), b2, vB); PG8_STAGE(PG8_SB(0, 1), b2 + hB, vB); PG8_STAGE(PG8_SA(0, 0), a2, voffA);
            PG8_WAIT_V(8); PG8_WAIT_L(0); PG8_BAR; PG8_MMA(1, 0, At, B0); PG8_MMA(1, 1, At, B1); PG8_BAR; PG8_SCHED;
            PG8_LDB(B0, 1, 0); PG8_LDB(B1, 1, 1); PG8_SCHED; PG8_LDA(At, 1, 0); PG8_STAGE(PG8_SA(0, 1), a2 + hstepA, voffA);
            PG8_WAIT_V(8); PG8_WAIT_L(0); PG8_BAR; PG8_MMA(0, 0, At, B0); PG8_MMA(0, 1, At, B1); PG8_BAR; PG8_SCHED;
            PG8_LDA(At, 1, 1); PG8_STAGE(PG8_SB(1, 0), b3, vB); PG8_STAGE(PG8_SB(1, 1), b3 + hB, vB); PG8_STAGE(PG8_SA(1, 0), a3, voffA);
            PG8_WAIT_V(8); PG8_WAIT_L(0); PG8_BAR; PG8_MMA(1, 0, At, B0); PG8_MMA(1, 1, At, B1); PG8_BAR; PG8_SCHED;
        }
        if (wr == 0) PG8_BAR;
#define GBC(x) fmaxf((x), -30.f)
        {
            u32x4 gv[2][4][2];
#pragma unroll
            for (int ai = 0; ai < 2; ++ai)
#pragma unroll
                for (int m = 0; m < 4; ++m)
#pragma unroll
                    for (int bj = 0; bj < 2; ++bj) gv[ai][m][bj] = *(const u32x4*)(Zg + (size_t)(row0 + ai * HALF + m * 16) * ldc + col0 + bj * HALF + gboff);
            asm volatile("" ::: "memory");
#pragma unroll
            for (int ai = 0; ai < 2; ++ai)
#pragma unroll
                for (int m = 0; m < 4; ++m) { bf16_t* rowp = Zg + (size_t)(row0 + ai * HALF + m * 16) * ldc + col0;
#pragma unroll
                    for (int bj = 0; bj < 2; ++bj) { bf16_t* pp = rowp + bj * HALF; const u32x4 gb = gv[ai][m][bj]; const f32x4 v0 = acc[ai][bj][m][0], v1 = acc[ai][bj][m][1];
                        u32x4 w;
                        w.x = cvt_pk_bf16(EpiGate<0>::sig(GBC(EpiGate<0>::lo(gb.x))) * v0[0], EpiGate<0>::sig(GBC(EpiGate<0>::hi(gb.x))) * v0[1]); w.y = cvt_pk_bf16(EpiGate<0>::sig(GBC(EpiGate<0>::lo(gb.y))) * v0[2], EpiGate<0>::sig(GBC(EpiGate<0>::hi(gb.y))) * v0[3]);
                        w.z = cvt_pk_bf16(EpiGate<0>::sig(GBC(EpiGate<0>::lo(gb.z))) * v1[0], EpiGate<0>::sig(GBC(EpiGate<0>::hi(gb.z))) * v1[1]); w.w = cvt_pk_bf16(EpiGate<0>::sig(GBC(EpiGate<0>::lo(gb.w))) * v1[2], EpiGate<0>::sig(GBC(EpiGate<0>::hi(gb.w))) * v1[3]);
                        *(u32x4*)pp = w; } }
        }
#undef GBC
        if (!has_next) break;
#pragma unroll
        for (int a = 0; a < 2; ++a)
#pragma unroll
            for (int b = 0; b < 2; ++b)
#pragma unroll
                for (int m = 0; m < 4; ++m)
#pragma unroll
                    for (int n = 0; n < 2; ++n) acc[a][b][m][n] = (f32x4){0.f, 0.f, 0.f, 0.f};
        cur = nxt; cA1 = nA1; cB1 = nB1;
        cA2 = (const char*)A2 + (size_t)cur.pm * tstepA; cB2 = (const char*)B2t + (size_t)cur.pn * tstepB2; ++ui;
        if (wr == 1) PG8_BAR;
    }
    PG8_WAIT_V(0);
    PG8_BAR;
#undef PG8_SA
#undef PG8_SB
#undef PG8_STAGE
#undef PG8_LDA
#undef PG8_LDB
#undef PG8_MMA
#undef PG8_WAIT_V
#undef PG8_WAIT_L
#undef PG8_BAR
#undef PG8_SCHED
}
}
constexpr int NWAVES = 8;
constexpr int BATCH = 8, SEQ = 4096, D = 1024, M = BATCH * SEQ, NZ = 5888, FF = 4096, DEPTH = 2;
constexpr int C_AQ = 0, C_AK = 512, C_AV = 640, C_RQ = 768, C_RK = 1280, C_RV = 1792, C_RG = 2816, C_GA = 3840, C_GB = 4864;
constexpr int C_YA = 768, C_YB = 1792;
constexpr float EPS = 1e-6f;

constexpr size_t MiB = 1u << 20;
constexpr size_t WS_CTL = 0, CTL_ZERO_BYTES = 1 * MiB;
constexpr size_t WS_TABA = 1 * MiB, WS_TABR = 2 * MiB;
constexpr size_t WS_SS = 4 * MiB;
constexpr size_t WS_W = 6 * MiB;
constexpr size_t W_WIN = 0, W_WA = 6029312, W_WB = 6553600, W_WOUT = 7602176, W_WUP = 8650752, W_WDOWN = 12845056, W_LAYER = 17039360;
constexpr size_t WS_H = 71 * MiB;
constexpr size_t WS_Z = 135 * MiB;
constexpr size_t WS_END = 503 * MiB;
static_assert(WS_W + 2 * W_LAYER * 2 <= WS_H && WS_H + (size_t)M * D * 2 <= WS_Z && WS_Z + (size_t)M * NZ * 2 <= WS_END, "d_ws map");
constexpr int CW_BAR = 4096;

constexpr int RING_OFF = 0, RING_BYTES = 131072;
constexpr int LDSCTL_OFF = RING_BYTES, MISC_OFF = LDSCTL_OFF + 320;
constexpr int LDS_BYTES = 147456;

#define GAS __attribute__((address_space(1)))
#define LAS __attribute__((address_space(3)))
typedef unsigned short bf16;
typedef unsigned v4u __attribute__((ext_vector_type(4)));
typedef unsigned v2u __attribute__((ext_vector_type(2)));
typedef float f32x4 __attribute__((ext_vector_type(4)));
typedef float f32x2 __attribute__((ext_vector_type(2)));
#define LDS_WAIT() asm volatile("s_waitcnt lgkmcnt(0)" ::: "memory")
#define VM_WAIT() asm volatile("s_waitcnt vmcnt(0)" ::: "memory")
__device__ __forceinline__ unsigned f2bf(float f) { unsigned u = __builtin_bit_cast(unsigned, f); return (u + 0x7fffu + ((u >> 16) & 1u)) >> 16; }
__device__ __forceinline__ unsigned pk2(float lo, float hi) { return f2bf(lo) | (f2bf(hi) << 16); }
__device__ __forceinline__ float bf2f(unsigned short b) { return __builtin_bit_cast(float, (unsigned)b << 16); }
__device__ __forceinline__ float bflo(unsigned w) { return __builtin_bit_cast(float, w << 16); }
__device__ __forceinline__ float bfhi(unsigned w) { return __builtin_bit_cast(float, w & 0xffff0000u); }

#define XB_TMO      128
#define XB_XCNT(j)  (256  + 64 * (j))
#define XB_XSUB(j)  (1280 + 64 * (j))
#define XB_XGEN(j)  (2304 + 64 * (j))
#define XB_TOP      3328
#define XB_TOPGEN   3392
#define XCD_BAR_WORDS 3456
#define XB_SPIN_CAP (1u << 24)

__device__ __forceinline__ unsigned xb_ld(unsigned* p)              { return __hip_atomic_load(p, __ATOMIC_RELAXED, __HIP_MEMORY_SCOPE_AGENT); }
__device__ __forceinline__ unsigned xb_add(unsigned* p, unsigned v) { return __hip_atomic_fetch_add(p, v, __ATOMIC_RELAXED, __HIP_MEMORY_SCOPE_AGENT); }
__device__ __forceinline__ unsigned xb_xcc_id() { return (unsigned)__builtin_amdgcn_s_getreg((3 << 11) | 20) & 0xFu; }
#define XB_SPIN(cond, bar) do { unsigned _sp = 0; while (cond) { __builtin_amdgcn_s_sleep(1); \
    if ((++_sp & 255u) == 0u) { if (xb_ld(&(bar)[XB_TMO])) break; if (_sp > XB_SPIN_CAP) { atomicAdd(&(bar)[XB_TMO], 1u); break; } } } } while (0)

struct XcdBarrier { unsigned* bar; unsigned x; volatile LAS unsigned* st; };

__device__ __forceinline__ XcdBarrier xcd_barrier_post(unsigned* bar, volatile LAS unsigned* st) {
    XcdBarrier b; b.bar = bar; b.x = xb_xcc_id(); b.st = st;
    if (threadIdx.x == 0) (void)xb_add(&bar[XB_XCNT(b.x)], 1u);
    return b;
}
__device__ __forceinline__ void xcd_barrier_complete(unsigned* bar, unsigned x, unsigned& nloc, unsigned& nx) {
    const unsigned G = gridDim.x * gridDim.y * gridDim.z;
    unsigned sum, cnt, mine, sp = 0u;
    for (;;) {
        sum = 0u; cnt = 0u; mine = 0u;
#pragma unroll 1
        for (unsigned j = 0; j < 16; ++j) { const unsigned c = xb_ld(&bar[XB_XCNT(j)]); sum += c; cnt += (c > 0u) ? 1u : 0u; mine = (j == x) ? c : mine; }
        if (sum == G) break;
        __builtin_amdgcn_s_sleep(1);
        if ((++sp & 255u) == 0u) { if (xb_ld(&bar[XB_TMO])) break; if (sp > XB_SPIN_CAP) { atomicAdd(&bar[XB_TMO], 1u); break; } }
    }
    nloc = mine > 0u ? mine : 1u; nx = cnt > 0u ? cnt : 1u;
}
__device__ __forceinline__ void xcd_barrier_census(const XcdBarrier& b) {
    if (threadIdx.x == 0) { unsigned nloc, nx; xcd_barrier_complete(b.bar, b.x, nloc, nx); b.st[0] = nloc; b.st[1] = nx; }
    __syncthreads();
}
__device__ __forceinline__ void xcd_barrier(const XcdBarrier& b) {
    asm volatile("s_waitcnt vmcnt(0)" ::: "memory");
    __syncthreads();
    if (threadIdx.x == 0) {
        unsigned* bar = b.bar;
        __builtin_amdgcn_s_waitcnt(0);
        const unsigned nloc = b.st[0], nx = b.st[1];
        const unsigned old = xb_add(&bar[XB_XSUB(b.x)], 1u);
        const unsigned gen = old / nloc;
        if (old + 1u == (gen + 1u) * nloc) {
            __builtin_amdgcn_fence(__ATOMIC_RELEASE, "agent");
            asm volatile("s_waitcnt vmcnt(0)" ::: "memory");
            const unsigned og = xb_add(&bar[XB_TOP], 1u);
            const unsigned tg = og / nx;
            if (og + 1u == (tg + 1u) * nx) xb_add(&bar[XB_TOPGEN], 1u);
            else XB_SPIN(xb_ld(&bar[XB_TOPGEN]) == tg, bar);
            __builtin_amdgcn_fence(__ATOMIC_ACQUIRE, "agent");
            xb_add(&bar[XB_XGEN(b.x)], 1u);
            asm volatile("s_waitcnt vmcnt(0)" ::: "memory");
        } else {
            XB_SPIN(xb_ld(&bar[XB_XGEN(b.x)]) == gen, bar);
            __builtin_amdgcn_fence(__ATOMIC_ACQUIRE, "agent");
            asm volatile("s_waitcnt vmcnt(0)" ::: "memory");
        }
    }
    __syncthreads();
}

__device__ __forceinline__ float wave_sum(float v) {
#pragma unroll
    for (int o = 1; o < 64; o <<= 1) v += __shfl_xor(v, o);
    return v;
}
template <bool WINMAP> __device__ __forceinline__ void p0_transpose_item(const float* W, int K, int N, bf16* WT, LAS float* scr, int item, int lane, const float* gk = nullptr) {
    const int nblk = N / 32, kb = item / nblk, nb = item % nblk, k0 = 64 * kb, n0 = 32 * nb;
    const int srcc = WINMAP ? pg8::win_colmap(n0 + (lane & 31)) : n0 + (lane & 31);
    float wv[32];
#pragma unroll
    for (int i = 0; i < 32; ++i) { const int kk = 2 * i + (lane >> 5); wv[i] = W[(size_t)(k0 + kk) * N + srcc]; }
    if (gk) {
#pragma unroll
        for (int i = 0; i < 32; ++i) wv[i] *= gk[k0 + 2 * i + (lane >> 5)];
    }
#pragma unroll
    for (int i = 0; i < 32; ++i) { const int kk = 2 * i + (lane >> 5); scr[kk * 33 + (lane & 31)] = wv[i]; }
    LDS_WAIT(); asm volatile("" ::: "memory");
    const int c = lane & 7;
#pragma unroll
    for (int j = 0; j < 4; ++j) { const int n = (lane >> 3) + 8 * j; const LAS float* s = scr + (8 * c) * 33 + n;
        v4u o; o.x = pk2(s[0 * 33], s[1 * 33]); o.y = pk2(s[2 * 33], s[3 * 33]); o.z = pk2(s[4 * 33], s[5 * 33]); o.w = pk2(s[6 * 33], s[7 * 33]);
        *(GAS v4u*)(WT + (size_t)(n0 + n) * K + k0 + 8 * c) = o; }
    LDS_WAIT(); asm volatile("" ::: "memory");
}
struct Ctx {
    LAS unsigned char* lds;
    int tid, lane, wave, vcu, G;
    const float* in[11]; float* out; unsigned char* ws;
};
#define CTXP const Ctx& F

__device__ __forceinline__ bf16* wsl(CTXP, int l, size_t off) { return (bf16*)(F.ws + WS_W) + (size_t)l * W_LAYER + off; }

constexpr int CI_IN = (D / 64) * (NZ / 32), CI_A = (512 / 64) * (D / 32), CI_B = (D / 64) * (D / 32), CI_O = CI_B, CI_U = (D / 64) * (FF / 32), CI_D = (FF / 64) * (D / 32);
constexpr int CI_LAYER = CI_IN + CI_A + CI_B + CI_O + CI_U + CI_D;
__device__ __forceinline__ void convert_items(CTXP, int lo, int hi, int gw = -1, int NGW = 0) {
    LAS float* scr = (LAS float*)(F.lds + RING_OFF + F.wave * 16384);
    if (gw < 0) { gw = F.vcu * NWAVES + F.wave; NGW = F.G * NWAVES; }
    for (int it = lo + gw; it < hi; it += NGW) {
        const int l = it / CI_LAYER; int r = it % CI_LAYER;
        if (r < CI_IN) { p0_transpose_item<true>(F.in[2] + (size_t)l * D * NZ, D, NZ, wsl(F, l, W_WIN), scr, r, F.lane, F.in[1] + l * D); continue; } r -= CI_IN;
        if (r < CI_A) { p0_transpose_item<false>(F.in[4] + (size_t)l * 512 * D, 512, D, wsl(F, l, W_WA), scr, r, F.lane); continue; } r -= CI_A;
        if (r < CI_B) { p0_transpose_item<false>(F.in[5] + (size_t)l * D * D, D, D, wsl(F, l, W_WB), scr, r, F.lane); continue; } r -= CI_B;
        if (r < CI_O) { p0_transpose_item<false>(F.in[6] + (size_t)l * D * D, D, D, wsl(F, l, W_WOUT), scr, r, F.lane); continue; } r -= CI_O;
        if (r < CI_U) { p0_transpose_item<false>(F.in[8] + (size_t)l * D * FF, D, FF, wsl(F, l, W_WUP), scr, r, F.lane, F.in[7] + l * D); continue; } r -= CI_U;
        p0_transpose_item<false>(F.in[9] + (size_t)l * FF * D, FF, D, wsl(F, l, W_WDOWN), scr, r, F.lane);
    }
}
__device__ __forceinline__ void phase_prologue(CTXP) {
    const int gw = F.vcu * NWAVES + F.wave, NGW = F.G * NWAVES;
    convert_items(F, 0, CI_IN);
    {
        bf16* H = (bf16*)(F.ws + WS_H); float* SS = (float*)(F.ws + WS_SS);
        for (int m = gw; m < M; m += NGW) {
            const f32x4* xr = (const f32x4*)(F.in[0] + (size_t)m * D) + F.lane;
            unsigned long long* o8 = (unsigned long long*)(H + (size_t)m * D) + F.lane; float s = 0.f;
#pragma unroll
            for (int j = 0; j < 4; ++j) { const f32x4 v = xr[64 * j]; s += (v.x * v.x + v.y * v.y) + (v.z * v.z + v.w * v.w);
                o8[64 * j] = (unsigned long long)pk2(v.x, v.y) | ((unsigned long long)pk2(v.z, v.w) << 32); }
            s = wave_sum(s);
            if (F.lane < 16) SS[(size_t)m * 16 + F.lane] = (F.lane == 0) ? s : 0.f;
        }
    }
    f32x2* tabA = (f32x2*)(F.ws + WS_TABA); f32x2* tabR = (f32x2*)(F.ws + WS_TABR);
    const int gt = (F.vcu * NWAVES + F.wave) * 64 + F.lane, NGT = F.G * NWAVES * 64;
    for (int idx = gt; idx < SEQ * 96; idx += NGT) {
        const int pos = idx / 96, j = idx % 96;
        const float ex = (j < 32) ? (float)j * (1.f / 32.f) : (float)(j - 32) * (1.f / 63.f);
        const float inv = exp2f(-ex * 13.287712379549449f);
        const float ang = (float)pos * inv;
        float s, c; sincosf(ang, &s, &c);
        const f32x2 v = {c, s};
        if (j < 32) tabA[pos * 32 + j] = v; else tabR[pos * 64 + (j - 32)] = v;
    }
}

__device__ __forceinline__ void phase_rms_bf16(CTXP, const float* x, const float* g, bf16* H) {
    const int gw = F.vcu * NWAVES + F.wave, NGW = F.G * NWAVES;
    const f32x4* g4 = (const f32x4*)g + F.lane;
    for (int m = gw; m < M; m += NGW) {
        const f32x4* xr = (const f32x4*)(x + (size_t)m * D) + F.lane;
        f32x4 v[4]; float s = 0.f;
#pragma unroll
        for (int j = 0; j < 4; ++j) { v[j] = xr[64 * j]; s += (v[j].x * v[j].x + v[j].y * v[j].y) + (v[j].z * v[j].z + v[j].w * v[j].w); }
        const float rstd = 1.f / sqrtf(wave_sum(s) * (1.f / D) + EPS);
        unsigned long long* o8 = (unsigned long long*)(H + (size_t)m * D) + F.lane;
#pragma unroll
        for (int j = 0; j < 4; ++j) { const f32x4 gg = g4[64 * j];
            o8[64 * j] = (unsigned long long)pk2(v[j].x * rstd * gg.x, v[j].y * rstd * gg.y) | ((unsigned long long)pk2(v[j].z * rstd * gg.z, v[j].w * rstd * gg.w) << 32); }
    }
}
__device__ __forceinline__ void phase_rms_final(CTXP, const bf16* X, float* out, const float* g) {
    const int gw = F.vcu * NWAVES + F.wave, NGW = F.G * NWAVES;
    const f32x4* g4 = (const f32x4*)g + F.lane; const float* SS = (const float*)(F.ws + WS_SS);
    const f32x4 ga = g4[0], gb = g4[64], gc = g4[128], gd = g4[192];
    for (int m = gw; m < M; m += NGW) {
        const v2u* xr = (const v2u*)(X + (size_t)m * D) + F.lane; f32x4* orow = (f32x4*)(out + (size_t)m * D) + F.lane;
        const float rstd = pg8::row_rstd(SS, m);
        const v2u a = xr[0], b = xr[64], c = xr[128], d = xr[192];
        orow[0]   = (f32x4){bflo(a.x), bfhi(a.x), bflo(a.y), bfhi(a.y)} * rstd * ga;
        orow[64]  = (f32x4){bflo(b.x), bfhi(b.x), bflo(b.y), bfhi(b.y)} * rstd * gb;
        orow[128] = (f32x4){bflo(c.x), bfhi(c.x), bflo(c.y), bfhi(c.y)} * rstd * gc;
        orow[192] = (f32x4){bflo(d.x), bfhi(d.x), bflo(d.y), bfhi(d.y)} * rstd * gd;
    }
}

__device__ __forceinline__ void phase_rotary(CTXP, bf16* z) {
    const f32x2* tabA = (const f32x2*)(F.ws + WS_TABA); const f32x2* tabR = (const f32x2*)(F.ws + WS_TABR);
    const long gt = (long)(F.vcu * NWAVES + F.wave) * 64 + F.lane, NGT = (long)F.G * NWAVES * 64;
    for (long idx = gt; idx < (long)M * 832; idx += NGT) {
        const int m = (int)(idx / 832), p = (int)(idx % 832), pos = m % SEQ;
        int c1, c2; f32x2 cs; float sc = 1.f;
        if (p < 256)      { const int h = p / 32, i = p % 32; c1 = C_AQ + 64 * h + i; c2 = c1 + 32; cs = tabA[pos * 32 + i]; }
        else if (p < 320) { const int pp = p - 256, h = pp / 32, i = pp % 32; c1 = C_AK + 64 * h + i; c2 = c1 + 32; cs = tabA[pos * 32 + i]; }
        else if (p < 576) { const int pp = p - 320, h = pp / 64, i = pp % 64; c1 = C_RQ + 128 * h + 2 * i; c2 = c1 + 1; cs = tabR[pos * 64 + i]; }
        else              { const int pp = p - 576, h = pp / 64, i = pp % 64; c1 = C_RK + 128 * h + 2 * i; c2 = c1 + 1; cs = tabR[pos * 64 + i]; sc = 0.08838834764831845f; }
        bf16* zr = z + (size_t)m * NZ;
        const float x1 = bf2f(zr[c1]), x2 = bf2f(zr[c2]);
        zr[c1] = (bf16)f2bf((x1 * cs.x - x2 * cs.y) * sc); zr[c2] = (bf16)f2bf((x2 * cs.x + x1 * cs.y) * sc);
    }
}

__device__ __forceinline__ void phase_attn_naive(CTXP, bf16* z, const float* sinks) {
    const int gw = F.vcu * NWAVES + F.wave, NGW = F.G * NWAVES;
    for (int u = gw; u < BATCH * 64 * 8; u += NGW) {
        const int h = u % 8, tb = (u / 8) % 64, b = u / 512, g = h / 4;
        const int t = tb * 64 + F.lane; const size_t m = (size_t)b * SEQ + t;
        float q[64], o[64];
        { const v4u* qp = (const v4u*)(z + m * NZ + C_AQ + 64 * h);
#pragma unroll
          for (int c = 0; c < 8; ++c) { const v4u w = qp[c];
              q[8 * c + 0] = bflo(w.x) * 0.125f; q[8 * c + 1] = bfhi(w.x) * 0.125f; q[8 * c + 2] = bflo(w.y) * 0.125f; q[8 * c + 3] = bfhi(w.y) * 0.125f;
              q[8 * c + 4] = bflo(w.z) * 0.125f; q[8 * c + 5] = bfhi(w.z) * 0.125f; q[8 * c + 6] = bflo(w.w) * 0.125f; q[8 * c + 7] = bfhi(w.w) * 0.125f; } }
#pragma unroll
        for (int d = 0; d < 64; ++d) o[d] = 0.f;
        float mr = sinks[h], l = 1.f;
        const int k0 = (tb * 64 - 127) > 0 ? (tb * 64 - 127) : 0, k1 = tb * 64 + 63;
        for (int kk = k0; kk <= k1; ++kk) {
            const bf16* krow = z + ((size_t)b * SEQ + kk) * NZ + C_AK + 64 * g;
            const bf16* vrow = z + ((size_t)b * SEQ + kk) * NZ + C_AV + 64 * g;
            float s = 0.f;
#pragma unroll
            for (int c = 0; c < 8; ++c) { const v4u w = ((const v4u*)krow)[c];
                s += q[8 * c + 0] * bflo(w.x) + q[8 * c + 1] * bfhi(w.x) + q[8 * c + 2] * bflo(w.y) + q[8 * c + 3] * bfhi(w.y)
                   + q[8 * c + 4] * bflo(w.z) + q[8 * c + 5] * bfhi(w.z) + q[8 * c + 6] * bflo(w.w) + q[8 * c + 7] * bfhi(w.w); }
            const bool valid = (kk <= t) && (kk >= t - 127);
            if (valid) {
                const float mn = fmaxf(mr, s), corr = __expf(mr - mn), p = __expf(s - mn);
                l = l * corr + p; mr = mn;
#pragma unroll
                for (int c = 0; c < 8; ++c) { const v4u w = ((const v4u*)vrow)[c];
                    o[8 * c + 0] = o[8 * c + 0] * corr + p * bflo(w.x); o[8 * c + 1] = o[8 * c + 1] * corr + p * bfhi(w.x);
                    o[8 * c + 2] = o[8 * c + 2] * corr + p * bflo(w.y); o[8 * c + 3] = o[8 * c + 3] * corr + p * bfhi(w.y);
                    o[8 * c + 4] = o[8 * c + 4] * corr + p * bflo(w.z); o[8 * c + 5] = o[8 * c + 5] * corr + p * bfhi(w.z);
                    o[8 * c + 6] = o[8 * c + 6] * corr + p * bflo(w.w); o[8 * c + 7] = o[8 * c + 7] * corr + p * bfhi(w.w); }
            }
        }
        const float rl = 1.f / l;
        v4u* op = (v4u*)(z + m * NZ + C_AQ + 64 * h);
#pragma unroll
        for (int c = 0; c < 8; ++c) { v4u w; w.x = pk2(o[8 * c + 0] * rl, o[8 * c + 1] * rl); w.y = pk2(o[8 * c + 2] * rl, o[8 * c + 3] * rl);
            w.z = pk2(o[8 * c + 4] * rl, o[8 * c + 5] * rl); w.w = pk2(o[8 * c + 6] * rl, o[8 * c + 7] * rl); op[c] = w; }
    }
}

__device__ __forceinline__ void phase_ret_scan_naive(CTXP, const bf16* z, bf16* RP) {
    const int gt = (F.vcu * NWAVES + F.wave) * 64 + F.lane, NGT = F.G * NWAVES * 64;
    for (int idx = gt; idx < BATCH * 4 * 128 * 64; idx += NGT) {
        const int e0 = idx % 64, d = (idx / 64) % 128, h = (idx / 8192) % 4, b = idx / 32768;
        const float gamma = 1.f - exp2f(-5.f - (float)h);
        float S0 = 0.f, S1 = 0.f, S2 = 0.f, S3 = 0.f;
        const bf16* zk = z + (size_t)b * SEQ * NZ + C_RK + 128 * h + d;
        const bf16* zv = z + (size_t)b * SEQ * NZ + C_RV + 256 * h + e0;
        bf16* rp = RP + ((size_t)(b * 4 + h) * 32) * 32768 + d * 256 + e0;
        for (int n = 0; n < 32; ++n) {
            rp[0] = (bf16)f2bf(S0); rp[64] = (bf16)f2bf(S1); rp[128] = (bf16)f2bf(S2); rp[192] = (bf16)f2bf(S3); rp += 32768;
#pragma unroll 4
            for (int j = 0; j < 128; ++j) {
                const float kd = bf2f(*zk); const float v0 = bf2f(zv[0]), v1 = bf2f(zv[64]), v2 = bf2f(zv[128]), v3 = bf2f(zv[192]);
                S0 = gamma * S0 + kd * v0; S1 = gamma * S1 + kd * v1; S2 = gamma * S2 + kd * v2; S3 = gamma * S3 + kd * v3;
                zk += NZ; zv += NZ;
            }
        }
    }
}

__device__ __forceinline__ void phase_ret_out_naive(CTXP, bf16* z, const bf16* RP) {
    LAS float* Sl = (LAS float*)(F.lds + RING_OFF);
    LAS float* rowsq = (LAS float*)(F.lds + RING_OFF + 32768);
    const int tid = F.tid;
    for (int unit = F.vcu; unit < BATCH * 4 * 32 * 2; unit += F.G) {
        const int half = unit & 1, n = (unit >> 1) & 31, h = (unit >> 6) & 3, b = unit >> 8;
        const size_t m0 = (size_t)b * SEQ + n * 128;
        const float log2g = log2f(1.f - exp2f(-5.f - (float)h));
        {
            const int j = tid & 127, ig = tid >> 7;
            unsigned kreg[64];
            { const v4u* kp = (const v4u*)(z + (m0 + j) * NZ + C_RK + 128 * h);
#pragma unroll
              for (int c = 0; c < 16; ++c) { const v4u w = kp[c]; kreg[4 * c] = w.x; kreg[4 * c + 1] = w.y; kreg[4 * c + 2] = w.z; kreg[4 * c + 3] = w.w; } }
            for (int r = 0; r < 16; ++r) {
                const int i = ig + 4 * r, iglob = 64 * half + i;
                float s = 0.f;
                if (j <= iglob) {
                    const v4u* qp = (const v4u*)(z + (m0 + iglob) * NZ + C_RQ + 128 * h);
#pragma unroll
                    for (int c = 0; c < 16; ++c) { const v4u w = qp[c];
                        s += bflo(w.x) * bflo(kreg[4 * c]) + bfhi(w.x) * bfhi(kreg[4 * c]) + bflo(w.y) * bflo(kreg[4 * c + 1]) + bfhi(w.y) * bfhi(kreg[4 * c + 1])
                           + bflo(w.z) * bflo(kreg[4 * c + 2]) + bfhi(w.z) * bfhi(kreg[4 * c + 2]) + bflo(w.w) * bflo(kreg[4 * c + 3]) + bfhi(w.w) * bfhi(kreg[4 * c + 3]); }
                    s *= exp2f(log2g * (float)(iglob - j));
                }
                Sl[i * 128 + j] = s;
            }
            if (tid < 64) rowsq[tid] = 0.f;
        }
        __syncthreads();
        {
            const int e = tid & 255, rgp = tid >> 8;
            float acc[32], acc2[32];
#pragma unroll
            for (int rr = 0; rr < 32; ++rr) { acc[rr] = 0.f; acc2[rr] = 0.f; }
            const bf16* vp = z + m0 * NZ + C_RV + 256 * h + e;
            for (int j = 0; j < 128; ++j) {
                const float v = bf2f(vp[(size_t)j * NZ]);
#pragma unroll
                for (int rr = 0; rr < 32; ++rr) acc[rr] += Sl[(rgp * 32 + rr) * 128 + j] * v;
            }
            const bf16* rp = RP + ((size_t)((b * 4 + h) * 32 + n)) * 32768 + e;
            const bf16* qb = z + (m0 + 64 * half + rgp * 32) * NZ + C_RQ + 128 * h;
            for (int d = 0; d < 128; d += 2) {
                const float r0 = bf2f(rp[(size_t)d * 256]), r1 = bf2f(rp[(size_t)(d + 1) * 256]);
#pragma unroll
                for (int rr = 0; rr < 32; ++rr) { const unsigned w = *(const unsigned*)(qb + (size_t)rr * NZ + d); acc2[rr] += bflo(w) * r0 + bfhi(w) * r1; }
            }
#pragma unroll
            for (int rr = 0; rr < 32; ++rr) {
                const int iglob = 64 * half + rgp * 32 + rr;
                const float r = acc[rr] + exp2f(log2g * (float)(iglob + 1)) * acc2[rr];
                acc[rr] = r;
                const float ss = wave_sum(r * r);
                if (F.lane == 0) atomicAdd((float*)(rowsq + rgp * 32 + rr), ss);
            }
            __syncthreads();
#pragma unroll
            for (int rr = 0; rr < 32; ++rr) {
                const int iglob = 64 * half + rgp * 32 + rr;
                const float rstd = 1.f / sqrtf(rowsq[rgp * 32 + rr] * (1.f / 256.f) + EPS);
                bf16* gp = z + (m0 + iglob) * NZ + C_RG + 256 * h + e;
                const float gv = bf2f(*gp);
                const float sil = gv / (1.f + __expf(-gv));
                *gp = (bf16)f2bf(acc[rr] * rstd * sil);
            }
        }
        __syncthreads();
    }
}

__device__ __forceinline__ void phase_merge_naive(CTXP, bf16* z) {
    const long gt = (long)(F.vcu * NWAVES + F.wave) * 64 + F.lane, NGT = (long)F.G * NWAVES * 64;
    for (long idx = gt; idx < (long)M * (D / 8); idx += NGT) {
        const size_t m = (size_t)(idx / (D / 8)); const int c = (int)(idx % (D / 8)) * 8;
        bf16* zr = z + m * NZ;
        const v4u ya = *(const v4u*)(zr + C_YA + c), yb = *(const v4u*)(zr + C_YB + c), ga = *(const v4u*)(zr + C_GA + c), gb = *(const v4u*)(zr + C_GB + c);
        v4u o;
#define MRG(A, B, GA_, GB_, LOHI) ((1.f / (1.f + __expf(-LOHI(GA_)))) * LOHI(A) + (1.f / (1.f + __expf(-LOHI(GB_)))) * LOHI(B))
        o.x = pk2(MRG(ya.x, yb.x, ga.x, gb.x, bflo), MRG(ya.x, yb.x, ga.x, gb.x, bfhi));
        o.y = pk2(MRG(ya.y, yb.y, ga.y, gb.y, bflo), MRG(ya.y, yb.y, ga.y, gb.y, bfhi));
        o.z = pk2(MRG(ya.z, yb.z, ga.z, gb.z, bflo), MRG(ya.z, yb.z, ga.z, gb.z, bfhi));
        o.w = pk2(MRG(ya.w, yb.w, ga.w, gb.w, bflo), MRG(ya.w, yb.w, ga.w, gb.w, bfhi));
#undef MRG
        *(v4u*)(zr + C_GA + c) = o;
    }
}

typedef short bf16x8 __attribute__((ext_vector_type(8)));
typedef short s16x4 __attribute__((ext_vector_type(4)));
typedef float f32x16 __attribute__((ext_vector_type(16)));
typedef __bf16 bf16x2_t __attribute__((ext_vector_type(2)));
#define MFMA32(a, b, c) __builtin_amdgcn_mfma_f32_32x32x16_bf16((a), (b), (c), 0, 0, 0)
__device__ __forceinline__ int crow(int r, int h) { return (r & 3) + 8 * (r >> 2) + 4 * h; }
__device__ __forceinline__ unsigned cvtpk(float lo, float hi) { f32x2 v = {lo, hi}; bf16x2_t b = __builtin_convertvector(v, bf16x2_t); return __builtin_bit_cast(unsigned, b); }
__device__ __forceinline__ s16x4 tr_read(const LAS unsigned char* p) { return __builtin_bit_cast(s16x4, __builtin_amdgcn_ds_read_tr16_b64_v4i16((LAS s16x4*)p)); }
#define PACK_STEP(x, s) __builtin_bit_cast(bf16x8, (v4u){cvtpk((x)[8 * (s)], (x)[8 * (s) + 1]), cvtpk((x)[8 * (s) + 2], (x)[8 * (s) + 3]), cvtpk((x)[8 * (s) + 4], (x)[8 * (s) + 5]), cvtpk((x)[8 * (s) + 6], (x)[8 * (s) + 7])})

__device__ __forceinline__ void phase_attn_mfma(CTXP, bf16* z, const float* sinks) {
    const LAS unsigned char* Kl = F.lds + RING_OFF; const LAS unsigned char* Vl = F.lds + RING_OFF + 32768;
    const int tid = F.tid, lane = F.lane, r = lane & 31, h = lane >> 5, wave = F.wave;
    const int i16 = lane & 15, tq = i16 >> 2, tp = i16 & 3, blk = (lane >> 4) & 1;
    for (int unit = F.vcu; unit < BATCH * 32 * 2; unit += F.G) {
        const int g = unit & 1, n = (unit >> 1) & 31, b = unit >> 6;
        const size_t m0 = (size_t)b * SEQ + (size_t)n * 128;
        const int kj_lo = (n == 0) ? 128 : 0, kt_lo = (n == 0) ? 4 : 0;
#pragma unroll
        for (int p = 0; p < 4; ++p) { const int row = p * 64 + (tid >> 3), c = tid & 7;
            if (row >= kj_lo) { const bf16* src = z + (m0 - 128 + row) * NZ + 64 * g + 8 * c;
                const v4u kv = *(const v4u*)(src + C_AK), vv = *(const v4u*)(src + C_AV);
                *(LAS v4u*)(Kl + row * 128 + ((c ^ (row & 7)) * 16)) = kv; *(LAS v4u*)(Vl + row * 128 + c * 16) = vv; } }
        __syncthreads();
        const int hq = 4 * g + (wave >> 1);
        const float sinkl = sinks[hq] * 1.4426950408889634f;
#pragma unroll 1
        for (int qq = 0; qq < 2; ++qq) {
            const int qs = (wave & 1) * 2 + qq;
            bf16* qrow = z + (m0 + 32 * qs + r) * NZ + C_AQ + 64 * hq;
            bf16x8 qf[4];
#pragma unroll
            for (int ks = 0; ks < 4; ++ks) qf[ks] = *(const bf16x8*)(qrow + 16 * ks + 8 * h);
            f32x16 s[5];
            const int iq = 32 * qs + r;
#pragma unroll
            for (int t = 0; t < 5; ++t) {
                const int kt = qs + t;
                if (kt < kt_lo) {
#pragma unroll
                    for (int i = 0; i < 16; ++i) s[t][i] = -INFINITY;
                } else {
                    f32x16 acc;
#pragma unroll
                    for (int i = 0; i < 16; ++i) acc[i] = 0.f;
                    const int key = 32 * kt + r;
#pragma unroll
                    for (int ks = 0; ks < 4; ++ks) { const bf16x8 a = *(const LAS bf16x8*)(Kl + key * 128 + (((2 * ks + h) ^ (key & 7)) * 16)); acc = MFMA32(a, qf[ks], acc); }
#pragma unroll
                    for (int i = 0; i < 16; ++i) { const int kj = 32 * kt + crow(i, h); const bool valid = (kj >= iq + 1) && (kj <= iq + 128); s[t][i] = valid ? acc[i] * 0.18033688011112042f : -INFINITY; }
                }
            }
            float mx = sinkl;
#pragma unroll
            for (int t = 0; t < 5; ++t)
#pragma unroll
                for (int i = 0; i < 16; ++i) mx = fmaxf(mx, s[t][i]);
            mx = fmaxf(mx, __shfl_xor(mx, 32));
            float l = 0.f;
#pragma unroll
            for (int t = 0; t < 5; ++t)
#pragma unroll
                for (int i = 0; i < 16; ++i) { const float p = __builtin_amdgcn_exp2f(s[t][i] - mx); s[t][i] = p; l += p; }
            l += __shfl_xor(l, 32);
            l += __builtin_amdgcn_exp2f(sinkl - mx);
            f32x16 o[2];
#pragma unroll
            for (int i = 0; i < 16; ++i) { o[0][i] = 0.f; o[1][i] = 0.f; }
#pragma unroll
            for (int t = 0; t < 5; ++t) {
                const int kt = qs + t;
                if (kt >= kt_lo) {
#pragma unroll
                    for (int s2 = 0; s2 < 2; ++s2) {
                        const bf16x8 xs = PACK_STEP(s[t], s2);
#pragma unroll
                        for (int dt = 0; dt < 2; ++dt) {
                            const LAS unsigned char* vp = Vl + (32 * kt + 16 * s2 + 4 * h + tq) * 128 + (32 * dt + 16 * blk) * 2 + 8 * tp;
                            const s16x4 lo = tr_read(vp), hi = tr_read(vp + 8 * 128);
                            const bf16x8 pa = __builtin_shufflevector(lo, hi, 0, 1, 2, 3, 4, 5, 6, 7);
                            o[dt] = MFMA32(pa, xs, o[dt]);
                        }
                    }
                }
            }
            const float rl = 1.f / l;
#pragma unroll
            for (int dt = 0; dt < 2; ++dt)
#pragma unroll
                for (int g4 = 0; g4 < 4; ++g4) {
                    v2u w; w.x = cvtpk(o[dt][4 * g4] * rl, o[dt][4 * g4 + 1] * rl); w.y = cvtpk(o[dt][4 * g4 + 2] * rl, o[dt][4 * g4 + 3] * rl);
                    *(v2u*)(qrow + 32 * dt + 8 * g4 + 4 * h) = w;
                }
        }
        __syncthreads();
    }
}

__device__ __forceinline__ void phase_ret_kv_mfma(CTXP, const bf16* z, bf16* KV) {
    const LAS unsigned char* Vl = F.lds + RING_OFF; const LAS unsigned char* Kl = F.lds + RING_OFF + 65536;
    const int tid = F.tid, lane = F.lane, r = lane & 31, h = lane >> 5, wave = F.wave;
    const int i16 = lane & 15, tq = i16 >> 2, tp = i16 & 3, blk = (lane >> 4) & 1;
    for (int unit = F.vcu; unit < BATCH * 4 * 32; unit += F.G) {
        const int n = unit & 31, hd = (unit >> 5) & 3, b = unit >> 7;
        const size_t m0 = (size_t)b * SEQ + (size_t)n * 128;
        const float log2g = log2f(1.f - exp2f(-5.f - (float)hd));
#pragma unroll
        for (int p = 0; p < 4; ++p) { const int row = p * 32 + (tid >> 4), c = tid & 15;
            const v4u w = *(const v4u*)(z + (m0 + row) * NZ + C_RK + 128 * hd + 8 * c);
            const float zt = exp2f(log2g * (float)(127 - row));
            v4u o; o.x = cvtpk(bflo(w.x) * zt, bfhi(w.x) * zt); o.y = cvtpk(bflo(w.y) * zt, bfhi(w.y) * zt); o.z = cvtpk(bflo(w.z) * zt, bfhi(w.z) * zt); o.w = cvtpk(bflo(w.w) * zt, bfhi(w.w) * zt);
            *(LAS v4u*)(Kl + row * 256 + c * 16) = o; }
#pragma unroll
        for (int p = 0; p < 8; ++p) { const int row = p * 16 + (tid >> 5), c = tid & 31;
            *(LAS v4u*)(Vl + row * 512 + c * 16) = *(const v4u*)(z + (m0 + row) * NZ + C_RV + 256 * hd + 8 * c); }
        __syncthreads();
        f32x16 acc[4];
#pragma unroll
        for (int dt = 0; dt < 4; ++dt)
#pragma unroll
            for (int i = 0; i < 16; ++i) acc[dt][i] = 0.f;
#pragma unroll 2
        for (int s = 0; s < 8; ++s) {
            const LAS unsigned char* vp = Vl + (16 * s + 8 * h + tq) * 512 + (32 * wave + 16 * blk) * 2 + 8 * tp;
            const s16x4 vlo = tr_read(vp), vhi = tr_read(vp + 4 * 512);
            const bf16x8 bfrag = __builtin_shufflevector(vlo, vhi, 0, 1, 2, 3, 4, 5, 6, 7);
#pragma unroll
            for (int dt = 0; dt < 4; ++dt) {
                const LAS unsigned char* kp = Kl + (16 * s + 8 * h + tq) * 256 + (32 * dt + 16 * blk) * 2 + 8 * tp;
                const s16x4 klo = tr_read(kp), khi = tr_read(kp + 4 * 256);
                const bf16x8 afrag = __builtin_shufflevector(klo, khi, 0, 1, 2, 3, 4, 5, 6, 7);
                acc[dt] = MFMA32(afrag, bfrag, acc[dt]);
            }
        }
        bf16* out = KV + (size_t)unit * 32768 + (32 * wave + r) * 128;
#pragma unroll
        for (int dt = 0; dt < 4; ++dt)
#pragma unroll
            for (int g4 = 0; g4 < 4; ++g4) { v2u w; w.x = cvtpk(acc[dt][4 * g4], acc[dt][4 * g4 + 1]); w.y = cvtpk(acc[dt][4 * g4 + 2], acc[dt][4 * g4 + 3]);
                *(v2u*)(out + 32 * dt + 8 * g4 + 4 * h) = w; }
        __syncthreads();
    }
}
__device__ __forceinline__ void phase_ret_scan(CTXP, bf16* KV) {
    const int gt = (F.vcu * NWAVES + F.wave) * 64 + F.lane, NGT = F.G * NWAVES * 64;
    for (int idx = gt; idx < 32 * 4096; idx += NGT) {
        const int bh = idx >> 12, off = (idx & 4095) * 8, hd = bh & 3;
        const float gch = exp2f(128.f * log2f(1.f - exp2f(-5.f - (float)hd)));
        float R[8];
#pragma unroll
        for (int i = 0; i < 8; ++i) R[i] = 0.f;
        bf16* p = KV + (size_t)bh * 32 * 32768 + off;
#pragma unroll 4
        for (int n = 0; n < 32; ++n) {
            const v4u kv = *(const v4u*)p;
            v4u o; o.x = cvtpk(R[0], R[1]); o.y = cvtpk(R[2], R[3]); o.z = cvtpk(R[4], R[5]); o.w = cvtpk(R[6], R[7]);
            *(v4u*)p = o;
            R[0] = gch * R[0] + bflo(kv.x); R[1] = gch * R[1] + bfhi(kv.x); R[2] = gch * R[2] + bflo(kv.y); R[3] = gch * R[3] + bfhi(kv.y);
            R[4] = gch * R[4] + bflo(kv.z); R[5] = gch * R[5] + bfhi(kv.z); R[6] = gch * R[6] + bflo(kv.w); R[7] = gch * R[7] + bfhi(kv.w);
            p += 32768;
        }
    }
}
__device__ __forceinline__ void phase_ret_out_mfma(CTXP, bf16* z, const bf16* RP) {
    const LAS unsigned char* Vl = F.lds + RING_OFF; LAS float* red = (LAS float*)(F.lds + RING_OFF + 65536);
    const int tid = F.tid, lane = F.lane, r = lane & 31, h = lane >> 5, wave = F.wave, qb = wave & 3, eh = wave >> 2;
    const int i16 = lane & 15, tq = i16 >> 2, tp = i16 & 3, blk = (lane >> 4) & 1;
    for (int unit = F.vcu; unit < BATCH * 4 * 32; unit += F.G) {
        const int n = unit & 31, hd = (unit >> 5) & 3, b = unit >> 7;
        const size_t m0 = (size_t)b * SEQ + (size_t)n * 128;
        const float log2g = log2f(1.f - exp2f(-5.f - (float)hd));
#pragma unroll
        for (int p = 0; p < 8; ++p) { const int row = p * 16 + (tid >> 5), c = tid & 31;
            *(LAS v4u*)(Vl + row * 512 + c * 16) = *(const v4u*)(z + (m0 + row) * NZ + C_RV + 256 * hd + 8 * c); }
        const int iq = 32 * qb + r;
        const bf16* qrow = z + (m0 + iq) * NZ + C_RQ + 128 * hd + 8 * h;
        bf16x8 qf[8];
#pragma unroll
        for (int ks = 0; ks < 8; ++ks) qf[ks] = *(const bf16x8*)(qrow + 16 * ks);
        f32x16 acc[4];
        const bf16* rp = RP + (size_t)unit * 32768 + (128 * eh + r) * 128 + 8 * h;
        const float xi = exp2f(log2g * (float)(iq + 1));
#pragma unroll
        for (int et = 0; et < 4; ++et) {
#pragma unroll
            for (int i = 0; i < 16; ++i) acc[et][i] = 0.f;
#pragma unroll
            for (int ks = 0; ks < 8; ++ks) { const bf16x8 a = *(const bf16x8*)(rp + et * 32 * 128 + 16 * ks); acc[et] = MFMA32(a, qf[ks], acc[et]); }
#pragma unroll
            for (int i = 0; i < 16; ++i) acc[et][i] *= xi;
        }
        __syncthreads();
#pragma unroll 1
        for (int kt = 0; kt <= qb; ++kt) {
            f32x16 X;
#pragma unroll
            for (int i = 0; i < 16; ++i) X[i] = 0.f;
            const bf16* krow = z + (m0 + 32 * kt + r) * NZ + C_RK + 128 * hd + 8 * h;
#pragma unroll
            for (int ks = 0; ks < 8; ++ks) { const bf16x8 a = *(const bf16x8*)(krow + 16 * ks); X = MFMA32(a, qf[ks], X); }
#pragma unroll
            for (int i = 0; i < 16; ++i) { const int kj = 32 * kt + crow(i, h); X[i] = (kj <= iq) ? X[i] * exp2f(log2g * (float)(iq - kj)) : 0.f; }
#pragma unroll
            for (int s2 = 0; s2 < 2; ++s2) {
                const bf16x8 xs = PACK_STEP(X, s2);
#pragma unroll
                for (int et = 0; et < 4; ++et) {
                    const LAS unsigned char* vp = Vl + (32 * kt + 16 * s2 + 4 * h + tq) * 512 + (128 * eh + 32 * et + 16 * blk) * 2 + 8 * tp;
                    const s16x4 lo = tr_read(vp), hi = tr_read(vp + 8 * 512);
                    const bf16x8 pa = __builtin_shufflevector(lo, hi, 0, 1, 2, 3, 4, 5, 6, 7);
                    acc[et] = MFMA32(pa, xs, acc[et]);
                }
            }
        }
        float ss = 0.f;
#pragma unroll
        for (int et = 0; et < 4; ++et)
#pragma unroll
            for (int i = 0; i < 16; ++i) ss += acc[et][i] * acc[et][i];
        ss += __shfl_xor(ss, 32);
        if (h == 0) red[eh * 128 + iq] = ss;
        __syncthreads();
        const float rstd = 1.f / sqrtf((red[iq] + red[128 + iq]) * (1.f / 256.f) + EPS);
        bf16* grow = z + (m0 + iq) * NZ + C_RG + 256 * hd + 128 * eh + 4 * h;
#pragma unroll
        for (int et = 0; et < 4; ++et)
#pragma unroll
            for (int g4 = 0; g4 < 4; ++g4) {
                bf16* p = grow + 32 * et + 8 * g4;
                const v2u gv = *(const v2u*)p;
                const float g0 = bflo(gv.x), g1 = bfhi(gv.x), g2 = bflo(gv.y), g3 = bfhi(gv.y);
                const float o0 = acc[et][4 * g4] * rstd * (g0 / (1.f + __expf(-g0))), o1 = acc[et][4 * g4 + 1] * rstd * (g1 / (1.f + __expf(-g1)));
                const float o2 = acc[et][4 * g4 + 2] * rstd * (g2 / (1.f + __expf(-g2))), o3 = acc[et][4 * g4 + 3] * rstd * (g3 / (1.f + __expf(-g3)));
                v2u w; w.x = cvtpk(o0, o1); w.y = cvtpk(o2, o3);
                *(v2u*)p = w;
            }
        __syncthreads();
    }
}

__device__ __forceinline__ void glds16(const void* gsrc, LAS unsigned char* ldst) {
    unsigned keep; const unsigned dst = (unsigned)__builtin_amdgcn_readfirstlane((int)(unsigned)(size_t)ldst);
    asm volatile("s_mov_b32 %0, m0\n\ts_mov_b32 m0, %2\n\ts_nop 0\n\tglobal_load_lds_dwordx4 %1, off\n\ts_mov_b32 m0, %0" : "=&s"(keep) : "v"(gsrc), "s"(dst) : "memory");
}
__device__ __forceinline__ void phase_ret_state(CTXP, const bf16* z, bf16* KV) {
    constexpr int SLOT = 32768, KOFF = 0, VOFF = 16384;
    const int wave = F.wave;
    for (int unit = F.vcu; unit < BATCH * 4 * 8; unit += F.G) {
        int lane = F.lane; asm volatile("" : "+v"(lane));
        const int r = lane & 31, h = lane >> 5, i16 = lane & 15, tq = i16 >> 2, tp = i16 & 3, blk = (lane >> 4) & 1;
        const int eq = unit & 3, dh = (unit >> 2) & 1, hd = (unit >> 3) & 3, b = unit >> 5;
        const float log2g = log2f(1.f - exp2f(-5.f - (float)hd)), gch = exp2f(128.f * log2g);
        const bf16* ksrc = z + ((size_t)b * SEQ + (wave * 16 + (lane >> 3))) * NZ + C_RK + 128 * hd + 64 * dh + 8 * (lane & 7);
        const bf16* vsrc = z + ((size_t)b * SEQ + (wave * 16 + (lane >> 3))) * NZ + C_RV + 256 * hd + 64 * eq + 8 * (lane & 7);
#define RS_ISSUE(n_, slot_) do { const size_t ro_ = (size_t)(n_) * 128 * NZ; LAS unsigned char* sb_ = F.lds + RING_OFF + (slot_) * SLOT + wave * 2048; \
        glds16(ksrc + ro_, sb_ + KOFF); glds16(ksrc + ro_ + (size_t)8 * NZ, sb_ + KOFF + 1024); \
        glds16(vsrc + ro_, sb_ + VOFF); glds16(vsrc + ro_ + (size_t)8 * NZ, sb_ + VOFF + 1024); } while (0)
        RS_ISSUE(0, 0); RS_ISSUE(1, 1); RS_ISSUE(2, 2);
        f32x16 acc;
#pragma unroll
        for (int i = 0; i < 16; ++i) acc[i] = 0.f;
        float zb[8];
#pragma unroll
        for (int j = 0; j < 8; ++j) zb[j] = exp2f(log2g * (float)(127 - 8 * h - j));
        const int dt = wave & 1, et = (wave >> 1) & 1;
        bf16* outp = KV + ((size_t)(b * 4 + hd) * 32) * 32768 + (64 * eq + 32 * et + r) * 128 + 64 * dh + 32 * dt + 4 * h;
#pragma unroll 1
        for (int n = 0; n < 32; ++n) {
            if (n < 30) asm volatile("s_waitcnt vmcnt(8)" ::: "memory"); else if (n == 30) asm volatile("s_waitcnt vmcnt(4)" ::: "memory"); else asm volatile("s_waitcnt vmcnt(0)" ::: "memory");
            __builtin_amdgcn_s_barrier();
            if (wave < 4) {
#pragma unroll
                for (int g4 = 0; g4 < 4; ++g4) { v2u w; w.x = cvtpk(acc[4 * g4], acc[4 * g4 + 1]); w.y = cvtpk(acc[4 * g4 + 2], acc[4 * g4 + 3]); *(v2u*)(outp + 8 * g4) = w; }
            }
            outp += 32768;
            if (n + 3 < 32) RS_ISSUE(n + 3, (n + 3) & 3);
            if (wave < 4) {
                const LAS unsigned char* Kl = F.lds + RING_OFF + (n & 3) * SLOT + KOFF; const LAS unsigned char* Vl = F.lds + RING_OFF + (n & 3) * SLOT + VOFF;
#pragma unroll
                for (int i = 0; i < 16; ++i) acc[i] *= gch;
#pragma unroll
                for (int s = 0; s < 8; ++s) {
                    const LAS unsigned char* vp = Vl + (16 * s + 8 * h + tq) * 128 + (32 * et + 16 * blk) * 2 + 8 * tp;
                    const s16x4 vlo = tr_read(vp), vhi = tr_read(vp + 4 * 128);
                    const LAS unsigned char* kp = Kl + (16 * s + 8 * h + tq) * 128 + (32 * dt + 16 * blk) * 2 + 8 * tp;
                    const s16x4 klo = tr_read(kp), khi = tr_read(kp + 4 * 128);
                    const float fs = exp2f(log2g * (float)(-16 * s));
                    v4u bq;
                    bq.x = cvtpk(bf2f((unsigned short)vlo[0]) * (zb[0] * fs), bf2f((unsigned short)vlo[1]) * (zb[1] * fs)); bq.y = cvtpk(bf2f((unsigned short)vlo[2]) * (zb[2] * fs), bf2f((unsigned short)vlo[3]) * (zb[3] * fs));
                    bq.z = cvtpk(bf2f((unsigned short)vhi[0]) * (zb[4] * fs), bf2f((unsigned short)vhi[1]) * (zb[5] * fs)); bq.w = cvtpk(bf2f((unsigned short)vhi[2]) * (zb[6] * fs), bf2f((unsigned short)vhi[3]) * (zb[7] * fs));
                    const bf16x8 bfrag = __builtin_bit_cast(bf16x8, bq);
                    const bf16x8 afrag = __builtin_shufflevector(klo, khi, 0, 1, 2, 3, 4, 5, 6, 7);
                    acc = MFMA32(afrag, bfrag, acc);
                }
            }
        }
#undef RS_ISSUE
        asm volatile("s_waitcnt vmcnt(0)" ::: "memory");
        __builtin_amdgcn_s_barrier();
    }
}
#define RO_WAIT_BAR(N) asm volatile("s_waitcnt vmcnt(" #N ")\n\ts_barrier" ::: "memory")
__device__ __forceinline__ void ro_wait_bar(int ahead) {
    if (ahead >= 3) RO_WAIT_BAR(12); else if (ahead == 2) RO_WAIT_BAR(8); else if (ahead == 1) RO_WAIT_BAR(4); else RO_WAIT_BAR(0);
}
template <int KIND> __device__ __forceinline__ void ro_issue_slot(CTXP, const bf16* z, int ui) {
    int lane = F.lane; asm volatile("" : "+v"(lane));
    const int wave = F.wave;
    const int unit = F.vcu + ui * F.G;
    const int n = unit & 31, hd = (unit >> 5) & 3, b = unit >> 7;
    const size_t m0 = (size_t)b * SEQ + (size_t)n * 128;
    LAS unsigned char* sb = F.lds + RING_OFF + ((3 * ui + KIND) & 3) * 32768 + wave * 4096;
    if (KIND == 0) {
        const int row = 16 * wave + (lane >> 4);
        const bf16* src = z + (m0 + row) * NZ + C_RK + 128 * hd;
#pragma unroll
        for (int j = 0; j < 4; ++j) { const int c = (lane & 15) ^ ((row + 4 * j) & 15); glds16(src + (size_t)(4 * j) * NZ + 8 * c, sb + j * 1024); }
    } else {
        const int row = 8 * wave + (lane >> 5);
        const bf16* src = z + (m0 + 64 * (KIND - 1) + row) * NZ + C_RV + 256 * hd;
#pragma unroll
        for (int j = 0; j < 4; ++j) { const int c = (lane & 31) ^ (((row + 2 * j) & 3) << 2); glds16(src + (size_t)(2 * j) * NZ + 8 * c, sb + j * 1024); }
    }
}
__device__ __forceinline__ void phase_ret_out_ring(CTXP, bf16* z, const bf16* RP) {
    constexpr int SLOT = 32768;
    LAS float* red = (LAS float*)(F.lds + LDSCTL_OFF + 1024);
    const int wave = F.wave, qb = wave & 3, eh = wave >> 2;
    const int NU = (BATCH * 4 * 32 - F.vcu + F.G - 1) / F.G;
    if (NU <= 0) return;
    ro_issue_slot<0>(F, z, 0); ro_issue_slot<1>(F, z, 0); ro_issue_slot<2>(F, z, 0);
    if (NU > 1) ro_issue_slot<0>(F, z, 1);
#pragma unroll 1
    for (int ui = 0; ui < NU; ++ui) {
        int lane = F.lane; asm volatile("" : "+v"(lane));
        const int r = lane & 31, h = lane >> 5, i16 = lane & 15, tq = i16 >> 2, tp = i16 & 3, blk = (lane >> 4) & 1;
        const int unit = F.vcu + ui * F.G;
        const int n = unit & 31, hd = (unit >> 5) & 3, b = unit >> 7;
        const size_t m0 = (size_t)b * SEQ + (size_t)n * 128;
        const float log2g = log2f(1.f - exp2f(-5.f - (float)hd));
        const int iq = 32 * qb + r;
        const int more = (ui + 1 < NU) ? 1 : 0;
        const bf16* qrow = z + (m0 + iq) * NZ + C_RQ + 128 * hd + 8 * h;
        bf16x8 qf[8];
#pragma unroll
        for (int ks = 0; ks < 8; ++ks) qf[ks] = *(const bf16x8*)(qrow + 16 * ks);
        f32x16 acc[4];
        const bf16* rp = RP + (size_t)unit * 32768 + (128 * eh + r) * 128 + 8 * h;
        const float xi = exp2f(log2g * (float)(iq + 1));
#pragma unroll
        for (int et = 0; et < 4; ++et) {
            bf16x8 a[8];
#pragma unroll
            for (int ks = 0; ks < 8; ++ks) a[ks] = *(const bf16x8*)(rp + et * 32 * 128 + 16 * ks);
#pragma unroll
            for (int i = 0; i < 16; ++i) acc[et][i] = 0.f;
#pragma unroll
            for (int ks = 0; ks < 8; ++ks) acc[et] = MFMA32(a[ks], qf[ks], acc[et]);
#pragma unroll
            for (int i = 0; i < 16; ++i) acc[et][i] *= xi;
            asm volatile("" ::: "memory");
        }
        ro_wait_bar(2 + more);
        bf16x8 xf[4][2];
        {
            const LAS unsigned char* Kl = F.lds + RING_OFF + ((3 * ui) & 3) * SLOT;
#pragma unroll
            for (int kt = 0; kt < 4; ++kt) {
                if (kt <= qb) {
                    f32x16 X;
#pragma unroll
                    for (int i = 0; i < 16; ++i) X[i] = 0.f;
                    const int key = 32 * kt + r;
#pragma unroll
                    for (int ks = 0; ks < 8; ++ks) { const bf16x8 a = *(const LAS bf16x8*)(Kl + key * 256 + (((2 * ks + h) ^ (key & 15)) << 4)); X = MFMA32(a, qf[ks], X); }
#pragma unroll
                    for (int i = 0; i < 16; ++i) { const int kj = 32 * kt + crow(i, h); X[i] = (kj <= iq) ? X[i] * exp2f(log2g * (float)(iq - kj)) : 0.f; }
                    xf[kt][0] = PACK_STEP(X, 0); xf[kt][1] = PACK_STEP(X, 1);
                }
                __builtin_amdgcn_sched_barrier(0);
            }
        }
#pragma unroll
        for (int vh = 0; vh < 2; ++vh) {
            if (vh == 0) { ro_wait_bar(1 + more); if (more) ro_issue_slot<1>(F, z, ui + 1); }
            else         { ro_wait_bar(2 * more); if (more) ro_issue_slot<2>(F, z, ui + 1); }
            const LAS unsigned char* Vl = F.lds + RING_OFF + ((3 * ui + 1 + vh) & 3) * SLOT;
#pragma unroll
            for (int k2 = 0; k2 < 2; ++k2) {
                const int kt = 2 * vh + k2;
                if (kt <= qb) {
#pragma unroll
                    for (int s2 = 0; s2 < 2; ++s2) {
#pragma unroll
                        for (int et = 0; et < 4; ++et) {
                            const int row = 32 * k2 + 16 * s2 + 4 * h + tq, chunk = 16 * eh + 4 * et + 2 * blk + (tp >> 1);
                            const LAS unsigned char* vp = Vl + row * 512 + ((chunk ^ (tq << 2)) << 4) + 8 * (tp & 1);
                            const s16x4 lo = tr_read(vp), hi = tr_read(vp + 8 * 512);
                            const bf16x8 pa = __builtin_shufflevector(lo, hi, 0, 1, 2, 3, 4, 5, 6, 7);
                            acc[et] = MFMA32(pa, xf[kt][s2], acc[et]);
                        }
                    }
                }
            }
        }
        float ss = 0.f;
#pragma unroll
        for (int et = 0; et < 4; ++et)
#pragma unroll
            for (int i = 0; i < 16; ++i) ss += acc[et][i] * acc[et][i];
        ss += __shfl_xor(ss, 32);
        if (h == 0) red[eh * 128 + iq] = ss;
        asm volatile("s_waitcnt lgkmcnt(0)\n\ts_barrier" ::: "memory");
        if (ui + 2 < NU) ro_issue_slot<0>(F, z, ui + 2);
        const float rstd = 1.f / sqrtf((red[iq] + red[128 + iq]) * (1.f / 256.f) + EPS);
        bf16* grow = z + (m0 + iq) * NZ + C_RG + 256 * hd + 128 * eh + 4 * h;
#pragma unroll
        for (int et = 0; et < 4; ++et)
#pragma unroll
            for (int g4 = 0; g4 < 4; ++g4) {
                bf16* p = grow + 32 * et + 8 * g4;
                const v2u gv = *(const v2u*)p;
                const float g0_ = bflo(gv.x), g1 = bfhi(gv.x), g2 = bflo(gv.y), g3 = bfhi(gv.y);
                const float o0 = acc[et][4 * g4] * rstd * (g0_ / (1.f + __expf(-g0_))), o1 = acc[et][4 * g4 + 1] * rstd * (g1 / (1.f + __expf(-g1)));
                const float o2 = acc[et][4 * g4 + 2] * rstd * (g2 / (1.f + __expf(-g2))), o3 = acc[et][4 * g4 + 3] * rstd * (g3 / (1.f + __expf(-g3)));
                v2u w; w.x = cvtpk(o0, o1); w.y = cvtpk(o2, o3);
                *(v2u*)p = w;
            }
        asm volatile("s_waitcnt lgkmcnt(0)\n\ts_barrier" ::: "memory");
    }
    asm volatile("s_waitcnt vmcnt(0)\n\ts_barrier" ::: "memory");
}

__device__ __forceinline__ void ro2_wait_bar(int cnt) {
    if (cnt >= 24) RO_WAIT_BAR(24); else if (cnt >= 16) RO_WAIT_BAR(16); else if (cnt >= 8) RO_WAIT_BAR(8); else if (cnt >= 4) RO_WAIT_BAR(4); else RO_WAIT_BAR(0);
}
template <int KIND> __device__ __forceinline__ void ro2_issue(CTXP, const bf16* z, const bf16* RP, int ui) {
    int lane = F.lane; asm volatile("" : "+v"(lane));
    const int wave = F.wave;
    const int unit = F.vcu + ui * F.G;
    const int n = unit & 31, hd = (unit >> 5) & 3, b = unit >> 7;
    const size_t m0 = (size_t)b * SEQ + (size_t)n * 128;
    LAS unsigned char* sb = F.lds + RING_OFF + (KIND & 3) * 32768 + wave * 4096;
    if (KIND == 4 || KIND == 5) {
        const int row = 8 * wave + (lane >> 5);
        const bf16* src = z + (m0 + 64 * (KIND - 4) + row) * NZ + C_RV + 256 * hd;
#pragma unroll
        for (int j = 0; j < 4; ++j) { const int c = (lane & 31) ^ (((row + 2 * j) & 3) << 2); glds16(src + (size_t)(2 * j) * NZ + 8 * c, sb + j * 1024); }
    } else {
        const int row = 16 * wave + (lane >> 4);
#pragma unroll
        for (int j = 0; j < 4; ++j) { const int rw = row + 4 * j, c = (lane & 15) ^ (rw & 15);
            const bf16* src;
            if (KIND == 0) src = z + (m0 + rw) * NZ + C_RQ + 128 * hd + 8 * c;
            else if (KIND == 3) src = z + (m0 + rw) * NZ + C_RK + 128 * hd + 8 * c;
            else if (KIND == 1 || KIND == 2) { const int e = (rw < 64 ? rw : 64 + rw) + 64 * (KIND - 1); src = RP + (size_t)unit * 32768 + e * 128 + 8 * c; }
            else { const int e = 128 * (c >> 3) + 64 * (KIND - 6) + 8 * (c & 7); src = z + (m0 + rw) * NZ + C_RG + 256 * hd + e; }
            glds16(src, sb + j * 1024); }
    }
}
__device__ __forceinline__ void phase_ret_out_dma(CTXP, bf16* z, const bf16* RP) {
    constexpr int SLOT = 32768;
    LAS float* red = (LAS float*)(F.lds + LDSCTL_OFF + 1024);
    const int wave = F.wave, qb = wave & 3, eh = wave >> 2;
    const int NU = (BATCH * 4 * 32 - F.vcu + F.G - 1) / F.G;
    if (NU <= 0) return;
    ro2_issue<0>(F, z, RP, 0); ro2_issue<1>(F, z, RP, 0); ro2_issue<2>(F, z, RP, 0);
#pragma unroll 1
    for (int ui = 0; ui < NU; ++ui) {
        int lane = F.lane; asm volatile("" : "+v"(lane));
        const int r = lane & 31, h = lane >> 5, i16 = lane & 15, tq = i16 >> 2, tp = i16 & 3, blk = (lane >> 4) & 1;
        const int unit = F.vcu + ui * F.G;
        const int n = unit & 31, hd = (unit >> 5) & 3, b = unit >> 7;
        const size_t m0 = (size_t)b * SEQ + (size_t)n * 128;
        const float log2g = log2f(1.f - exp2f(-5.f - (float)hd));
        const int iq = 32 * qb + r;
        const int more = (ui + 1 < NU) ? 1 : 0, first = (ui == 0) ? 1 : 0;
        const LAS unsigned char* R0 = F.lds + RING_OFF;
        ro2_wait_bar(first ? 8 : 24);
        ro2_issue<3>(F, z, RP, ui);
        bf16x8 qf[8];
        { const int row = 32 * qb + r;
#pragma unroll
          for (int ks = 0; ks < 8; ++ks) qf[ks] = *(const LAS bf16x8*)(R0 + 0 * SLOT + row * 256 + (((2 * ks + h) ^ (row & 15)) << 4)); }
        f32x16 acc[4];
        const float xi = exp2f(log2g * (float)(iq + 1));
#pragma unroll
        for (int hf = 0; hf < 2; ++hf) {
            if (hf == 0) { ro2_wait_bar(first ? 8 : 24); ro2_issue<4>(F, z, RP, ui); }
            else         { ro2_wait_bar(first ? 8 : 16); ro2_issue<5>(F, z, RP, ui); }
            const LAS unsigned char* Rl = R0 + (1 + hf) * SLOT;
#pragma unroll
            for (int e2 = 0; e2 < 2; ++e2) {
                const int et = 2 * hf + e2, row = 64 * eh + 32 * e2 + r;
#pragma unroll
                for (int i = 0; i < 16; ++i) acc[et][i] = 0.f;
#pragma unroll
                for (int ks = 0; ks < 8; ++ks) { const bf16x8 a = *(const LAS bf16x8*)(Rl + row * 256 + (((2 * ks + h) ^ (row & 15)) << 4)); acc[et] = MFMA32(a, qf[ks], acc[et]); }
#pragma unroll
                for (int i = 0; i < 16; ++i) acc[et][i] *= xi;
            }
        }
        ro2_wait_bar(8);
        ro2_issue<6>(F, z, RP, ui);
        bf16x8 xf[4][2];
        {
            const LAS unsigned char* Kl = R0 + 3 * SLOT;
#pragma unroll
            for (int kt = 0; kt < 4; ++kt) {
                if (kt <= qb) {
                    f32x16 X;
#pragma unroll
                    for (int i = 0; i < 16; ++i) X[i] = 0.f;
                    const int key = 32 * kt + r;
#pragma unroll
                    for (int ks = 0; ks < 8; ++ks) { const bf16x8 a = *(const LAS bf16x8*)(Kl + key * 256 + (((2 * ks + h) ^ (key & 15)) << 4)); X = MFMA32(a, qf[ks], X); }
#pragma unroll
                    for (int i = 0; i < 16; ++i) { const int kj = 32 * kt + crow(i, h); X[i] = (kj <= iq) ? X[i] * exp2f(log2g * (float)(iq - kj)) : 0.f; }
                    xf[kt][0] = PACK_STEP(X, 0); xf[kt][1] = PACK_STEP(X, 1);
                }
                __builtin_amdgcn_sched_barrier(0);
            }
        }
#pragma unroll
        for (int vh = 0; vh < 2; ++vh) {
            ro2_wait_bar(8);
            if (vh == 0) ro2_issue<7>(F, z, RP, ui); else if (more) ro2_issue<0>(F, z, RP, ui + 1);
            const LAS unsigned char* Vl = R0 + vh * SLOT;
#pragma unroll
            for (int k2 = 0; k2 < 2; ++k2) {
                const int kt = 2 * vh + k2;
                if (kt <= qb) {
#pragma unroll
                    for (int s2 = 0; s2 < 2; ++s2) {
#pragma unroll
                        for (int et = 0; et < 4; ++et) {
                            const int row = 32 * k2 + 16 * s2 + 4 * h + tq, chunk = 16 * eh + 4 * et + 2 * blk + (tp >> 1);
                            const LAS unsigned char* vp = Vl + row * 512 + ((chunk ^ (tq << 2)) << 4) + 8 * (tp & 1);
                            const s16x4 lo = tr_read(vp), hi = tr_read(vp + 8 * 512);
                            const bf16x8 pa = __builtin_shufflevector(lo, hi, 0, 1, 2, 3, 4, 5, 6, 7);
                            acc[et] = MFMA32(pa, xf[kt][s2], acc[et]);
                        }
                    }
                }
            }
        }
        float ss = 0.f;
#pragma unroll
        for (int et = 0; et < 4; ++et)
#pragma unroll
            for (int i = 0; i < 16; ++i) ss += acc[et][i] * acc[et][i];
        ss += __shfl_xor(ss, 32);
        if (h == 0) red[eh * 128 + iq] = ss;
        bf16* grow = z + (m0 + iq) * NZ + C_RG + 256 * hd + 128 * eh + 4 * h;
        float rstd = 0.f;
#pragma unroll
        for (int hf = 0; hf < 2; ++hf) {
            if (hf == 0) { asm volatile("s_waitcnt lgkmcnt(0)" ::: "memory"); ro2_wait_bar(4 + 4 * more); if (more) ro2_issue<1>(F, z, RP, ui + 1);
                           rstd = 1.f / sqrtf((red[iq] + red[128 + iq]) * (1.f / 256.f) + EPS); }
            else         { ro2_wait_bar(8 + 8 * more); if (more) ro2_issue<2>(F, z, RP, ui + 1); }
            const LAS unsigned char* Gl = R0 + (2 + hf) * SLOT;
            const int row = 32 * qb + r;
#pragma unroll
            for (int e2 = 0; e2 < 2; ++e2)
#pragma unroll
                for (int g4 = 0; g4 < 4; ++g4) {
                    const int et = 2 * hf + e2, c = 8 * eh + 4 * e2 + g4;
                    const v2u gv = *(const LAS v2u*)(Gl + row * 256 + ((c ^ (row & 15)) << 4) + 8 * h);
                    const float g0_ = bflo(gv.x), g1 = bfhi(gv.x), g2 = bflo(gv.y), g3 = bfhi(gv.y);
                    const float o0 = acc[et][4 * g4] * rstd * (g0_ / (1.f + __expf(-g0_))), o1 = acc[et][4 * g4 + 1] * rstd * (g1 / (1.f + __expf(-g1)));
                    const float o2 = acc[et][4 * g4 + 2] * rstd * (g2 / (1.f + __expf(-g2))), o3 = acc[et][4 * g4 + 3] * rstd * (g3 / (1.f + __expf(-g3)));
                    v2u w; w.x = cvtpk(o0, o1); w.y = cvtpk(o2, o3);
                    *(v2u*)(grow + 32 * et + 8 * g4) = w;
                }
        }
    }
    asm volatile("s_waitcnt vmcnt(0) lgkmcnt(0)\n\ts_barrier" ::: "memory");
}
#ifndef PROBE_AMP
#define PROBE_AMP 0
#define PROBE_MASK 0
#endif
#ifndef MK_PER_PHASE
#define MK_PER_PHASE 0
#endif
constexpr int PPL = 7;
constexpr int NPH = 1 + DEPTH * PPL + 1;
struct Args { const float* in[11]; float* out; unsigned char* ws; int ph_lo, ph_hi; };
typedef __attribute__((address_space(4))) const Args CArgs;
__global__ void __launch_bounds__(NWAVES * 64, 2) mega_fwd(Args args) {
    extern __shared__ __attribute__((aligned(16))) unsigned char lds[];
    volatile LAS unsigned* MISC = (volatile LAS unsigned*)((LAS unsigned char*)lds + MISC_OFF);
    for (int u = threadIdx.x; u < (LDS_BYTES - LDSCTL_OFF) / 4; u += NWAVES * 64) ((LAS unsigned*)((LAS unsigned char*)lds + LDSCTL_OFF))[u] = 0u;
    __syncthreads();
    const int lo = args.ph_lo, hi = args.ph_hi;
    unsigned* ctl = (unsigned*)(args.ws + WS_CTL);
    XcdBarrier bar; bar.bar = ctl + CW_BAR; bar.x = 0; bar.st = nullptr;
    if (hi - lo > 1) { bar = xcd_barrier_post(ctl + CW_BAR, MISC + 8); xcd_barrier_census(bar); }
#pragma unroll 1
    for (int ph = lo; ph < hi; ++ph) {
        CArgs* ap = (CArgs*)__builtin_amdgcn_kernarg_segment_ptr(); asm volatile("" : "+s"(ap));
        int tid = threadIdx.x; asm volatile("" : "+v"(tid));
        Ctx F;
        F.lds = (LAS unsigned char*)lds;
        F.tid = tid; F.lane = tid & 63; F.wave = __builtin_amdgcn_readfirstlane(tid >> 6);
        F.G = gridDim.x; { const int bx = blockIdx.x; F.vcu = (F.G % 8 == 0) ? (bx % 8) * (F.G / 8) + bx / 8 : bx; }
#pragma unroll
        for (int i = 0; i < 11; ++i) F.in[i] = ap->in[i];
        F.out = ap->out; F.ws = ap->ws;
        bf16* const H = (bf16*)(F.ws + WS_H);
        bf16* const Z = (bf16*)(F.ws + WS_Z);
        const int bx = (int)blockIdx.x;
#if PROBE_AMP
        const unsigned long long pt0 = __builtin_amdgcn_s_memrealtime();
#endif
        if (ph == 0) phase_prologue(F);
        else if (ph == NPH - 1) phase_rms_final(F, H, F.out, F.in[10]);
        else {
            const int l = (ph - 1) / PPL, k = (ph - 1) % PPL;
            bf16* const KVb = (bf16*)F.out;
            float* const SS = (float*)(F.ws + WS_SS);
            switch (k) {
            case 0: { pg8::Gemm<M, NZ, D, D> g{H, wsl(F, l, W_WIN)}; pg8::StaticOrder<M, NZ> S; S.init(F.G, bx);
                      pg8::EpiWin E{Z, NZ, (const f32x2*)(F.ws + WS_TABA), (const f32x2*)(F.ws + WS_TABR), SS}; pg8::gemm_phase<pg8::EpiWin, pg8::StaticOrder<M, NZ>, true, true>(F.lds + RING_OFF, g, S, E);
                      { const int nwg = (M / 256) * (NZ / 256), short_from = nwg % F.G;
                        if (short_from > 0 && bx >= short_from) convert_items(F, l * CI_LAYER + CI_IN, (l + 1 < DEPTH) ? (l + 1) * CI_LAYER + CI_IN : (l + 1) * CI_LAYER, (bx - short_from) * NWAVES + F.wave, (F.G - short_from) * NWAVES);
                        else if (short_from == 0) convert_items(F, l * CI_LAYER + CI_IN, (l + 1 < DEPTH) ? (l + 1) * CI_LAYER + CI_IN : (l + 1) * CI_LAYER); } } break;
            case 1: phase_ret_state(F, Z, KVb); phase_attn_mfma(F, Z, F.in[3] + l * 8); break;
            case 2: phase_ret_out_dma(F, Z, KVb); break;
            case 3: { pg8::StaticOrder<M, D> S; S.init(F.G, bx);
                      pg8::gemm_phase_gate<M, D, 512, D, NZ, pg8::StaticOrder<M, D>>(F.lds + RING_OFF, Z + C_AQ, wsl(F, l, W_WA), Z + C_RG, wsl(F, l, W_WB), Z + C_GA, NZ, C_GB - C_GA, S); } break;
            case 4: { pg8::Gemm<M, D, D, NZ> g{Z + C_GA, wsl(F, l, W_WOUT)}; pg8::StaticOrder<M, D> S; S.init(F.G, bx);
                      pg8::EpiResBf16 E{H, SS, D}; pg8::gemm_phase<pg8::EpiResBf16, pg8::StaticOrder<M, D>, true, true>(F.lds + RING_OFF, g, S, E); } break;
            case 5: { pg8::Gemm<M, FF, D, D> g{H, wsl(F, l, W_WUP)}; pg8::StaticOrder<M, FF> S; S.init(F.G, bx);
                      pg8::EpiBf16<2> E{Z, FF, SS}; pg8::gemm_phase<pg8::EpiBf16<2>, pg8::StaticOrder<M, FF>, true, true>(F.lds + RING_OFF, g, S, E); } break;
            default: { pg8::Gemm<M, D, FF, FF> g{Z, wsl(F, l, W_WDOWN)}; pg8::StaticOrder<M, D> S; S.init(F.G, bx);
                      pg8::EpiResBf16 E{H, SS, D}; pg8::gemm_phase<pg8::EpiResBf16, pg8::StaticOrder<M, D>, true, true>(F.lds + RING_OFF, g, S, E); } break;
            }
        }
#if PROBE_AMP
        {
            const int cls = (ph == 0) ? 0 : (ph == NPH - 1) ? 9 : 1 + (ph - 1) % PPL;
            __syncthreads();
            const unsigned long long pt1 = __builtin_amdgcn_s_memrealtime();
            if ((PROBE_MASK >> cls) & 1) { const unsigned long long dt = (pt1 - pt0) * PROBE_AMP; while (__builtin_amdgcn_s_memrealtime() - pt1 < dt) __builtin_amdgcn_s_sleep(8); }
        }
#endif
        if (ph + 1 < hi) xcd_barrier(bar);
    }
}

extern "C" void kernel_launch(void* const* d_in, const int* in_sizes, int n_in, void* d_out, int out_size, void* d_ws, size_t ws_size, hipStream_t stream) {
    static int grid = 0;
    if (grid == 0) {
        if (n_in != 11 || in_sizes[0] != M * D || out_size != M * D || ws_size < WS_END) {
            fprintf(stderr, "kernel_launch: unexpected shapes: n_in %d in0 %d out %d ws %zu (need %zu)\n", n_in, n_in > 0 ? in_sizes[0] : -1, out_size, ws_size, (size_t)WS_END); grid = -1; return; }
        int dev = 0, cus = 0, per_cu = 0;
        if (hipGetDevice(&dev) != hipSuccess || hipDeviceGetAttribute(&cus, hipDeviceAttributeMultiprocessorCount, dev) != hipSuccess) { grid = -1; return; }
        if (hipFuncSetAttribute((const void*)mega_fwd, hipFuncAttributeMaxDynamicSharedMemorySize, LDS_BYTES) != hipSuccess) { fprintf(stderr, "kernel_launch: hipFuncSetAttribute failed\n"); grid = -1; return; }
        if (hipOccupancyMaxActiveBlocksPerMultiprocessor(&per_cu, (const void*)mega_fwd, NWAVES * 64, LDS_BYTES) != hipSuccess || per_cu < 1)
            fprintf(stderr, "kernel_launch: occupancy query reports %d workgroups per CU\n", per_cu);
        (void)hipGetLastError();
        grid = cus;
    }
    if (grid < 0) return;
    if (hipMemsetAsync((char*)d_ws + WS_CTL, 0, CTL_ZERO_BYTES, stream) != hipSuccess) return;
    Args a{};
    for (int i = 0; i < 11; ++i) a.in[i] = (const float*)d_in[i];
    a.out = (float*)d_out; a.ws = (unsigned char*)d_ws;
#if MK_PER_PHASE
    for (int p = 0; p < NPH; ++p) { a.ph_lo = p; a.ph_hi = p + 1; hipLaunchKernelGGL(mega_fwd, dim3(grid), dim3(NWAVES * 64), LDS_BYTES, stream, a); }
#else
    a.ph_lo = 0; a.ph_hi = NPH;
    hipLaunchKernelGGL(mega_fwd, dim3(grid), dim3(NWAVES * 64), LDS_BYTES, stream, a);
#endif
}
```

```cpp
#include <hip/hip_runtime.h>
#include <cstdio>
#include <cstdint>
namespace pg8 {
#define PG8_LAS __attribute__((address_space(3)))
typedef unsigned short bf16_t;
typedef short bf16x8 __attribute__((ext_vector_type(8)));
typedef float f32x4 __attribute__((ext_vector_type(4)));
typedef float f32x2 __attribute__((ext_vector_type(2)));
typedef unsigned u32x4 __attribute__((ext_vector_type(4)));
constexpr int BM = 256, BK = 64, HALF = 128, HTB = HALF * BK * 2  , STAGE_BYTES = 8 * HTB, NXCD = 8, WGM = 2;

__host__ __device__ __forceinline__ int lds_byte(int r, int c) { const int st = (r >> 4) * 2 + (c >> 5), rr = r & 15, cc = c & 31, ob = rr * 64 + cc * 2; return st * 1024 + (ob ^ (((ob >> 9) & 1) << 5)); }
__host__ __device__ __forceinline__ void stage_rc(int b, int& R, int& C) { const int st = b / 1024, sb = b % 1024, swz = sb ^ (((sb >> 9) & 1) << 5); R = (st >> 1) * 16 + swz / 64; C = (st & 1) * 32 + (swz % 64) / 2; }
__host__ __device__ __forceinline__ int perm32(int rho) { const int n = rho >> 4, i = rho & 15; return 8 * (i >> 2) + 4 * n + (i & 3); }

struct Unit { int pm, pn; };
template <int M_, int N_, int K_, int LDA_> struct Gemm { const bf16_t* A; const bf16_t* Bt; static constexpr int M = M_, N = N_, K = K_, lda = LDA_; };

template <int M_, int N_> struct StaticOrder {
    static constexpr int nM = M_ / BM, nN = N_ / BM, nwg = nM * nN; int G, c;
    __host__ __device__ void init(int G_, int c_) { G = G_; c = c_; }
    __host__ __device__ bool next(int i, Unit& u) const {
        const long L = (long)i * G + c; if (L >= nwg) return false;
        int wgid = (int)L; { const int q = nwg / NXCD, r = nwg % NXCD, xcd = wgid % NXCD, off = wgid / NXCD; wgid = (xcd < r ? xcd * (q + 1) : r * (q + 1) + (xcd - r) * q) + off; }
        const int nig = WGM * nN, gid = wgid / nig, fm = gid * WGM, gsz = (nM - fm) < WGM ? (nM - fm) : WGM;
        u.pm = fm + ((wgid % nig) % gsz); u.pn = (wgid % nig) / gsz; return true;
    }
    __device__ __forceinline__ void a_ready(const Unit&) const {}
    __device__ __forceinline__ void done(const Unit&) const {}
};

__device__ __forceinline__ unsigned cvt_pk_bf16(float lo, float hi) { unsigned r; asm volatile("v_cvt_pk_bf16_f32 %0, %1, %2" : "=v"(r) : "v"(lo), "v"(hi)); return r; }

__device__ __forceinline__ float row_rstd4(const float* SS, int row, int fq);
constexpr int STG_OFF0 = 3 * HTB;
constexpr int STG_OFF1 = STAGE_BYTES + 2048;
template <int ACT  > struct EpiBf16 {
    static constexpr bool PERM = true, AFTER_DRAIN = false, STAGED = true;
    bf16_t* O; int ldc; const float* SS;
    int panel_rows;
    __device__ __forceinline__ void staged(const f32x4 (&acc)[2][2][4][2], const Unit& u, int wr, int wc, int fr, int fq, PG8_LAS unsigned char* lds, int lane) const {
        const int row0 = u.pm * BM + wr * 64 + fr;
        float rs[2][4];
        if (SS) {
            f32x4 sv[2][4];
#pragma unroll
            for (int ai = 0; ai < 2; ++ai)
#pragma unroll
                for (int m = 0; m < 4; ++m) sv[ai][m] = *(const f32x4*)(SS + (size_t)(row0 + ai * HALF + m * 16) * 16 + 4 * fq);
#pragma unroll
            for (int ai = 0; ai < 2; ++ai)
#pragma unroll
                for (int m = 0; m < 4; ++m) { float t = (sv[ai][m][0] + sv[ai][m][1]) + (sv[ai][m][2] + sv[ai][m][3]); t += __shfl_xor(t, 16); t += __shfl_xor(t, 32); rs[ai][m] = 1.0f / sqrtf(t * (1.0f / 1024.0f) + 1e-6f); }
        } else {
#pragma unroll
            for (int ai = 0; ai < 2; ++ai)
#pragma unroll
                for (int m = 0; m < 4; ++m) rs[ai][m] = 1.f;
        }
        asm volatile("" ::: "memory");
        PG8_LAS unsigned char* stg = lds + (wr ? STG_OFF1 : STG_OFF0);
        const int wofs = fr * 512, c0 = wc * 4 + fq, sw = fr & 7;
        const int rr = 4 * wc + (lane >> 5), rp = lane & 31;
#pragma unroll
        for (int g = 0; g < 8; ++g) { const int ai = g >> 2, m = g & 3; PG8_LAS unsigned char* sb = stg + (g & 1) * 8192;
#pragma unroll
            for (int bj = 0; bj < 2; ++bj) { f32x4 v0 = acc[ai][bj][m][0] * rs[ai][m], v1 = acc[ai][bj][m][1] * rs[ai][m];
                if (ACT == 2) {
#pragma unroll
                    for (int i = 0; i < 4; ++i) { const float a = fmaxf(v0[i], 0.f), b = fmaxf(v1[i], 0.f); v0[i] = a * a; v1[i] = b * b; } }
                u32x4 w; w.x = cvt_pk_bf16(v0[0], v0[1]); w.y = cvt_pk_bf16(v0[2], v0[3]); w.z = cvt_pk_bf16(v1[0], v1[1]); w.w = cvt_pk_bf16(v1[2], v1[3]);
                *(PG8_LAS u32x4*)(sb + wofs + (((bj * 16 + c0) ^ sw) << 4)) = w; }
            asm volatile("s_waitcnt lgkmcnt(0)\n\ts_barrier" ::: "memory");
            const size_t grow = (size_t)(u.pm * BM + ai * HALF + wr * 64 + m * 16);
#pragma unroll
            for (int i = 0; i < 2; ++i) { const int r = rr + 2 * i; const u32x4 v = *(const PG8_LAS u32x4*)(sb + r * 512 + rp * 16);
                *(u32x4*)(O + (grow + r) * ldc + u.pn * BM + ((rp ^ (r & 7)) << 3)) = v; }
        }
        asm volatile("s_waitcnt lgkmcnt(0)\n\ts_barrier" ::: "memory");
    }
    __device__ __forceinline__ void operator()(const f32x4 (&acc)[2][2][4][2], const Unit& u, int wr, int wc, int fr, int fq) const {
        const int row0 = u.pm * BM + wr * 64 + fr; const int col0 = u.pn * BM + wc * 32 + 8 * fq;
        float rs[2][4];
        if (SS) {
            f32x4 sv[2][4];
#pragma unroll
            for (int ai = 0; ai < 2; ++ai)
#pragma unroll
                for (int m = 0; m < 4; ++m) sv[ai][m] = *(const f32x4*)(SS + (size_t)(row0 + ai * HALF + m * 16) * 16 + 4 * fq);
#pragma unroll
            for (int ai = 0; ai < 2; ++ai)
#pragma unroll
                for (int m = 0; m < 4; ++m) { float t = (sv[ai][m][0] + sv[ai][m][1]) + (sv[ai][m][2] + sv[ai][m][3]); t += __shfl_xor(t, 16); t += __shfl_xor(t, 32); rs[ai][m] = 1.0f / sqrtf(t * (1.0f / 1024.0f) + 1e-6f); }
        } else {
#pragma unroll
            for (int ai = 0; ai < 2; ++ai)
#pragma unroll
                for (int m = 0; m < 4; ++m) rs[ai][m] = 1.f;
        }
        asm volatile("" ::: "memory");
#pragma unroll
        for (int ai = 0; ai < 2; ++ai)
#pragma unroll
            for (int m = 0; m < 4; ++m) { bf16_t* rowp = O + (size_t)(row0 + ai * HALF + m * 16) * ldc + col0;
#pragma unroll
                for (int bj = 0; bj < 2; ++bj) { f32x4 v0 = acc[ai][bj][m][0] * rs[ai][m], v1 = acc[ai][bj][m][1] * rs[ai][m];
                    if (ACT == 2) {
#pragma unroll
                        for (int i = 0; i < 4; ++i) { const float a = fmaxf(v0[i], 0.f), b = fmaxf(v1[i], 0.f); v0[i] = a * a; v1[i] = b * b; } }
                    u32x4 w; w.x = cvt_pk_bf16(v0[0], v0[1]); w.y = cvt_pk_bf16(v0[2], v0[3]); w.z = cvt_pk_bf16(v1[0], v1[1]); w.w = cvt_pk_bf16(v1[2], v1[3]);
                    *(u32x4*)(rowp + bj * HALF) = w; } }
    }
};
template <int PASS> struct EpiGate {
    static __device__ __forceinline__ float sig(float x) { return __builtin_amdgcn_rcpf(1.f + __expf(-x)); }
    static __device__ __forceinline__ float lo(unsigned w) { return __builtin_bit_cast(float, w << 16); }
    static __device__ __forceinline__ float hi(unsigned w) { return __builtin_bit_cast(float, w & 0xffff0000u); }
};
__host__ __device__ __forceinline__ int win_colmap(int rho) {
    const int pn = rho >> 8, bj = (rho >> 7) & 1, p = rho & 127;
    if (pn <= 1) return 256 * pn + 64 * (p >> 5) + (p & 31) + 32 * bj;
    if (pn == 2) return (p < 64) ? 512 + 64 * (p >> 5) + (p & 31) + 32 * bj : 640 + (p - 64) + 64 * bj;
    if (pn <= 4) return 768 + 256 * (pn - 3) + 128 * (p >> 6) + 2 * (p & 63) + bj;
    if (pn <= 6) return 1280 + 256 * (pn - 5) + 128 * (p >> 6) + 2 * (p & 63) + bj;
    return rho;
}
struct EpiWin {
    static constexpr bool PERM = true, AFTER_DRAIN = false, STAGED = false;
    bf16_t* Z; int ldc; const f32x2* tabA; const f32x2* tabR; const float* SS;
    __device__ __forceinline__ void operator()(const f32x4 (&acc)[2][2][4][2], const Unit& u, int wr, int wc, int fr, int fq) const {
        const int row0 = u.pm * BM + wr * 64 + fr, pn = u.pn;
        int mode, c0, c1, fb = 0; float sc = 1.f;
        if (pn <= 1)      { mode = 1; c0 = 256 * pn + 64 * wc + 8 * fq; c1 = c0 + 32; fb = 8 * fq; }
        else if (pn == 2) { if (wc < 2) { mode = 1; c0 = 512 + 64 * wc + 8 * fq; c1 = c0 + 32; fb = 8 * fq; } else { mode = 0; c0 = 640 + 32 * (wc - 2) + 8 * fq; c1 = c0 + 64; } }
        else if (pn <= 6) { mode = 2; const int base = (pn <= 4) ? 768 + 256 * (pn - 3) : 1280 + 256 * (pn - 5); c0 = base + 128 * (wc >> 1) + 32 * (wc & 1) + 8 * fq; c1 = c0 + 64; fb = 32 * (wc & 1) + 8 * fq;
                            sc = (pn >= 5) ? 0.08838834764831845f : 1.f; }
        else              { mode = 0; c0 = 256 * pn + 32 * wc + 8 * fq; c1 = c0 + HALF; }
        f32x4 sv[2][4];
#pragma unroll
        for (int ai = 0; ai < 2; ++ai)
#pragma unroll
            for (int m = 0; m < 4; ++m) sv[ai][m] = *(const f32x4*)(SS + (size_t)(row0 + ai * HALF + m * 16) * 16 + 4 * fq);
        float rs[2][4];
#pragma unroll
        for (int ai = 0; ai < 2; ++ai)
#pragma unroll
            for (int m = 0; m < 4; ++m) { float t = (sv[ai][m][0] + sv[ai][m][1]) + (sv[ai][m][2] + sv[ai][m][3]); t += __shfl_xor(t, 16); t += __shfl_xor(t, 32); rs[ai][m] = 1.0f / sqrtf(t * (1.0f / 1024.0f) + 1e-6f); }
        if (mode == 0) {
#pragma unroll
            for (int ai = 0; ai < 2; ++ai)
#pragma unroll
                for (int m = 0; m < 4; ++m) { bf16_t* rowp = Z + (size_t)(row0 + ai * HALF + m * 16) * ldc; const float r_ = rs[ai][m];
                    const f32x4 a0 = acc[ai][0][m][0] * r_, a1 = acc[ai][0][m][1] * r_, b0 = acc[ai][1][m][0] * r_, b1 = acc[ai][1][m][1] * r_;
                    *(u32x4*)(rowp + c0) = (u32x4){cvt_pk_bf16(a0[0], a0[1]), cvt_pk_bf16(a0[2], a0[3]), cvt_pk_bf16(a1[0], a1[1]), cvt_pk_bf16(a1[2], a1[3])};
                    *(u32x4*)(rowp + c1) = (u32x4){cvt_pk_bf16(b0[0], b0[1]), cvt_pk_bf16(b0[2], b0[3]), cvt_pk_bf16(b1[0], b1[1]), cvt_pk_bf16(b1[2], b1[3])}; }
        } else {
#pragma unroll
            for (int ai = 0; ai < 2; ++ai)
#pragma unroll
                for (int m = 0; m < 4; ++m) { const int row = row0 + ai * HALF + m * 16, pos = row & 4095; bf16_t* rowp = Z + (size_t)row * ldc; const float scr = sc * rs[ai][m];
                    const f32x4* tp = (mode == 1) ? (const f32x4*)(tabA + pos * 32 + fb) : (const f32x4*)(tabR + pos * 64 + fb);
                    const f32x4 t0 = tp[0], t1 = tp[1], t2 = tp[2], t3 = tp[3];
                    const f32x4 x0 = acc[ai][0][m][0], x1 = acc[ai][0][m][1], y0 = acc[ai][1][m][0], y1 = acc[ai][1][m][1];
                    const f32x4 a0 = {(x0[0] * t0[0] - y0[0] * t0[1]) * scr, (x0[1] * t0[2] - y0[1] * t0[3]) * scr, (x0[2] * t1[0] - y0[2] * t1[1]) * scr, (x0[3] * t1[2] - y0[3] * t1[3]) * scr};
                    const f32x4 a1 = {(x1[0] * t2[0] - y1[0] * t2[1]) * scr, (x1[1] * t2[2] - y1[1] * t2[3]) * scr, (x1[2] * t3[0] - y1[2] * t3[1]) * scr, (x1[3] * t3[2] - y1[3] * t3[3]) * scr};
                    const f32x4 b0 = {(y0[0] * t0[0] + x0[0] * t0[1]) * scr, (y0[1] * t0[2] + x0[1] * t0[3]) * scr, (y0[2] * t1[0] + x0[2] * t1[1]) * scr, (y0[3] * t1[2] + x0[3] * t1[3]) * scr};
                    const f32x4 b1 = {(y1[0] * t2[0] + x1[0] * t2[1]) * scr, (y1[1] * t2[2] + x1[1] * t2[3]) * scr, (y1[2] * t3[0] + x1[2] * t3[1]) * scr, (y1[3] * t3[2] + x1[3] * t3[3]) * scr};
                    *(u32x4*)(rowp + c0) = (u32x4){cvt_pk_bf16(a0[0], a0[1]), cvt_pk_bf16(a0[2], a0[3]), cvt_pk_bf16(a1[0], a1[1]), cvt_pk_bf16(a1[2], a1[3])};
                    *(u32x4*)(rowp + c1) = (u32x4){cvt_pk_bf16(b0[0], b0[1]), cvt_pk_bf16(b0[2], b0[3]), cvt_pk_bf16(b1[0], b1[1]), cvt_pk_bf16(b1[2], b1[3])}; }
        }
    }
};

__device__ __forceinline__ float row_rstd(const float* SS, int row) {
    const f32x4* s = (const f32x4*)(SS + (size_t)row * 16); const f32x4 a = s[0], b = s[1], c = s[2], d = s[3];
    const float t = ((a[0] + a[1]) + (a[2] + a[3])) + ((b[0] + b[1]) + (b[2] + b[3])) + ((c[0] + c[1]) + (c[2] + c[3])) + ((d[0] + d[1]) + (d[2] + d[3]));
    return 1.0f / sqrtf(t * (1.0f / 1024.0f) + 1e-6f);
}
__device__ __forceinline__ float row_rstd4(const float* SS, int row, int fq) {
    const f32x4 a = *(const f32x4*)(SS + (size_t)row * 16 + 4 * fq);
    float t = (a[0] + a[1]) + (a[2] + a[3]);
    t += __shfl_xor(t, 16); t += __shfl_xor(t, 32);
    return 1.0f / sqrtf(t * (1.0f / 1024.0f) + 1e-6f);
}
struct EpiResBf16 {
    static constexpr bool PERM = true, AFTER_DRAIN = false, STAGED = false;
    bf16_t* X; float* SS; int ldc;
    static __device__ __forceinline__ float lo(unsigned w) { return __builtin_bit_cast(float, w << 16); }
    static __device__ __forceinline__ float hi(unsigned w) { return __builtin_bit_cast(float, w & 0xffff0000u); }
    __device__ __forceinline__ void operator()(const f32x4 (&acc)[2][2][4][2], const Unit& u, int wr, int wc, int fr, int fq) const {
        const int row0 = u.pm * BM + wr * 64 + fr; const int col0 = u.pn * BM + wc * 32 + 8 * fq;
        u32x4 bv[2][4][2];
#pragma unroll
        for (int ai = 0; ai < 2; ++ai)
#pragma unroll
            for (int m = 0; m < 4; ++m)
#pragma unroll
                for (int bj = 0; bj < 2; ++bj) bv[ai][m][bj] = *(const u32x4*)(X + (size_t)(row0 + ai * HALF + m * 16) * ldc + col0 + bj * HALF);
        asm volatile("" ::: "memory");
#pragma unroll
        for (int ai = 0; ai < 2; ++ai)
#pragma unroll
            for (int m = 0; m < 4; ++m) { const int row = row0 + ai * HALF + m * 16; bf16_t* rowp = X + (size_t)row * ldc + col0; float ss = 0.f;
#pragma unroll
                for (int bj = 0; bj < 2; ++bj) { bf16_t* p = rowp + bj * HALF; const u32x4 b = bv[ai][m][bj]; const f32x4 v0 = acc[ai][bj][m][0], v1 = acc[ai][bj][m][1];
                    const float o0 = lo(b.x) + v0[0], o1 = hi(b.x) + v0[1], o2 = lo(b.y) + v0[2], o3 = hi(b.y) + v0[3], o4 = lo(b.z) + v1[0], o5 = hi(b.z) + v1[1], o6 = lo(b.w) + v1[2], o7 = hi(b.w) + v1[3];
                    ss += ((o0 * o0 + o1 * o1) + (o2 * o2 + o3 * o3)) + ((o4 * o4 + o5 * o5) + (o6 * o6 + o7 * o7));
                    u32x4 w; w.x = cvt_pk_bf16(o0, o1); w.y = cvt_pk_bf16(o2, o3); w.z = cvt_pk_bf16(o4, o5); w.w = cvt_pk_bf16(o6, o7);
                    *(u32x4*)p = w; }
                ss += __shfl_xor(ss, 16); ss += __shfl_xor(ss, 32);
                if (fq == 0) SS[(size_t)row * 16 + u.pn * 4 + wc] = ss; }
    }
};

template <class Epi, class Sched, bool ALIGN_EPI, bool SP2, class GemmT>
__device__ __forceinline__ void gemm_phase(PG8_LAS unsigned char* lds, const GemmT g, const Sched& S, const Epi& E) {
    int tid_ = threadIdx.x; asm volatile("" : "+v"(tid_));
    const int tid = tid_, wid = __builtin_amdgcn_readfirstlane(tid >> 6), lane = tid & 63, wr = wid >> 2, wc = wid & 3, fr = lane & 15, fq = lane >> 4;
    constexpr int K = GemmT::K, nt = K / BK, lda = GemmT::lda;
    unsigned voffA[2], voffB[2];
#pragma unroll
    for (int i = 0; i < 2; ++i) { int R, C; stage_rc(tid * 16 + i * 8192, R, C); const int Rb = Epi::PERM ? ((R & ~31) + perm32(R & 31)) : R;
        voffA[i] = (unsigned)(R * lda + C) * 2u; voffB[i] = (unsigned)(Rb * K + C) * 2u; }
    constexpr size_t kstep = (size_t)(BK * 2);
    constexpr size_t hstepA = (size_t)HALF * lda * 2, hstepB = (size_t)HALF * K * 2;
    constexpr size_t tstepA = 2 * hstepA, tstepB = 2 * hstepB;
    const unsigned ldsw = (unsigned)wid * 1024u;
    const int aoff = lds_byte(wr * 64 + fr, fq * 8), boff = lds_byte(wc * 32 + fr, fq * 8);
#define PG8_SA(b, h) (((b) * 2 + (h)) * HTB)
#define PG8_SB(b, h) ((4 + (b) * 2 + (h)) * HTB)
#define PG8_STAGE(bufoff, gbase, voff) do { _Pragma("unroll") for (int _i = 0; _i < 2; ++_i) \
        __builtin_amdgcn_global_load_lds((const unsigned*)((const char*)(gbase) + (voff)[_i]), (PG8_LAS unsigned*)(lds + (bufoff) + ldsw + _i * 8192), 16, 0, 0); } while (0)
#define PG8_LDA(dst, b, h) do { _Pragma("unroll") for (int m = 0; m < 4; ++m) _Pragma("unroll") for (int k = 0; k < 2; ++k) dst[m][k] = *(const PG8_LAS bf16x8*)(lds + PG8_SA(b, h) + aoff + m * 2048 + k * 1024); } while (0)
#define PG8_LDB(dst, b, h) do { _Pragma("unroll") for (int n = 0; n < 2; ++n) _Pragma("unroll") for (int k = 0; k < 2; ++k) dst[n][k] = *(const PG8_LAS bf16x8*)(lds + PG8_SB(b, h) + boff + n * 2048 + k * 1024); } while (0)
#define PG8_MMA(ai, bj, At, Bt) do { __builtin_amdgcn_s_setprio(1); _Pragma("unroll") for (int m = 0; m < 4; ++m) _Pragma("unroll") for (int n = 0; n < 2; ++n) _Pragma("unroll") for (int k = 0; k < 2; ++k) \
        acc[ai][bj][m][n] = __builtin_amdgcn_mfma_f32_16x16x32_bf16(Bt[n][k], At[m][k], acc[ai][bj][m][n], 0, 0, 0); __builtin_amdgcn_s_setprio(0); } while (0)
#define PG8_WAIT_V(n) asm volatile("s_waitcnt vmcnt(" #n ")" ::: "memory")
#define PG8_WAIT_L(n) asm volatile("s_waitcnt lgkmcnt(" #n ")" ::: "memory")
#define PG8_BAR __builtin_amdgcn_s_barrier()
#define PG8_SCHED __builtin_amdgcn_sched_barrier(0)
    Unit cur, nxt; int ui = 0;
    if (!S.next(0, cur)) return;
    f32x4 acc[2][2][4][2];
#pragma unroll
    for (int a = 0; a < 2; ++a)
#pragma unroll
        for (int b = 0; b < 2; ++b)
#pragma unroll
            for (int m = 0; m < 4; ++m)
#pragma unroll
                for (int n = 0; n < 2; ++n) acc[a][b][m][n] = (f32x4){0.f, 0.f, 0.f, 0.f};
    bf16x8 At[4][2], B0[2][2], B1[2][2];
    const char* cA = (const char*)g.A + (size_t)cur.pm * tstepA; const char* cB = (const char*)g.Bt + (size_t)cur.pn * tstepB;
    S.a_ready(cur);
    if constexpr (SP2) {
        PG8_STAGE(PG8_SB(0, 0), cB, voffB); PG8_STAGE(PG8_SB(0, 1), cB + hstepB, voffB); PG8_STAGE(PG8_SA(0, 0), cA, voffA); PG8_STAGE(PG8_SA(0, 1), cA + hstepA, voffA);
        if (wr == 1) PG8_BAR;
        PG8_WAIT_V(2); PG8_BAR;
        PG8_STAGE(PG8_SB(1, 0), cB + kstep, voffB); PG8_STAGE(PG8_SA(1, 0), cA + kstep, voffA); PG8_STAGE(PG8_SB(1, 1), cB + hstepB + kstep, voffB);
        PG8_WAIT_V(6); PG8_BAR;
    } else {
        PG8_STAGE(PG8_SB(0, 0), cB, voffB); PG8_STAGE(PG8_SA(0, 0), cA, voffA); PG8_STAGE(PG8_SB(0, 1), cB + hstepB, voffB); PG8_STAGE(PG8_SA(0, 1), cA + hstepA, voffA);
        if (wr == 1) PG8_BAR;
        PG8_WAIT_V(4); PG8_BAR;
        PG8_STAGE(PG8_SB(1, 0), cB + kstep, voffB); PG8_STAGE(PG8_SA(1, 0), cA + kstep, voffA); PG8_STAGE(PG8_SB(1, 1), cB + hstepB + kstep, voffB);
        PG8_WAIT_V(6); PG8_BAR;
    }
    for (;;) {
        const bool has_next = S.next(ui + 1, nxt);
        const char* nA = has_next ? (const char*)g.A + (size_t)nxt.pm * tstepA : cA; const char* nB = has_next ? (const char*)g.Bt + (size_t)nxt.pn * tstepB : cB;
#pragma unroll 1
        for (int t = 0; t < nt; t += 2) {
            const bool last = (t == nt - 2);
            const char* a1 = cA + (size_t)(t + 1) * kstep;
            const char* a2 = last ? nA : cA + (size_t)(t + 2) * kstep; const char* b2 = last ? nB : cB + (size_t)(t + 2) * kstep;
            const char* a3 = a2 + kstep; const char* b3 = b2 + kstep;
            if (last && has_next) S.a_ready(nxt);
            if constexpr (SP2) {
            PG8_LDB(B0, 0, 0); PG8_LDB(B1, 0, 1); PG8_SCHED; PG8_LDA(At, 0, 0); PG8_STAGE(PG8_SA(1, 1), a1 + hstepA, voffA);
            PG8_WAIT_V(8); PG8_WAIT_L(0); PG8_BAR; PG8_MMA(0, 0, At, B0); PG8_MMA(0, 1, At, B1); PG8_BAR; PG8_SCHED;
            PG8_LDA(At, 0, 1); PG8_STAGE(PG8_SB(0, 0), b2, voffB); PG8_STAGE(PG8_SB(0, 1), b2 + hstepB, voffB); PG8_STAGE(PG8_SA(0, 0), a2, voffA);
            PG8_WAIT_V(8); PG8_WAIT_L(0); PG8_BAR; PG8_MMA(1, 0, At, B0); PG8_MMA(1, 1, At, B1); PG8_BAR; PG8_SCHED;
            PG8_LDB(B0, 1, 0); PG8_LDB(B1, 1, 1); PG8_SCHED; PG8_LDA(At, 1, 0); PG8_STAGE(PG8_SA(0, 1), a2 + hstepA, voffA);
            PG8_WAIT_V(8); PG8_WAIT_L(0); PG8_BAR; PG8_MMA(0, 0, At, B0); PG8_MMA(0, 1, At, B1); PG8_BAR; PG8_SCHED;
            PG8_LDA(At, 1, 1); PG8_STAGE(PG8_SB(1, 0), b3, voffB); PG8_STAGE(PG8_SB(1, 1), b3 + hstepB, voffB); PG8_STAGE(PG8_SA(1, 0), a3, voffA);
            PG8_WAIT_V(8); PG8_WAIT_L(0); PG8_BAR; PG8_MMA(1, 0, At, B0); PG8_MMA(1, 1, At, B1); PG8_BAR; PG8_SCHED;
            } else {
            PG8_LDB(B0, 0, 0); PG8_SCHED; PG8_LDA(At, 0, 0); PG8_STAGE(PG8_SA(1, 1), a1 + hstepA, voffA);
            PG8_WAIT_L(8); PG8_BAR; PG8_WAIT_L(0); PG8_MMA(0, 0, At, B0); PG8_BAR; PG8_SCHED;
            PG8_LDB(B1, 0, 1); PG8_STAGE(PG8_SB(0, 0), b2, voffB);
            PG8_BAR; PG8_WAIT_L(0); PG8_MMA(0, 1, At, B1); PG8_BAR;
            PG8_LDA(At, 0, 1); PG8_STAGE(PG8_SA(0, 0), a2, voffA);
            PG8_BAR; PG8_WAIT_L(0); PG8_MMA(1, 0, At, B0); PG8_BAR; PG8_SCHED;
            PG8_STAGE(PG8_SB(0, 1), b2 + hstepB, voffB);
            PG8_WAIT_V(6); PG8_BAR; PG8_MMA(1, 1, At, B1); PG8_BAR;
            PG8_LDB(B0, 1, 0); PG8_SCHED; PG8_LDA(At, 1, 0); PG8_STAGE(PG8_SA(0, 1), a2 + hstepA, voffA);
            PG8_WAIT_L(8); PG8_BAR; PG8_WAIT_L(0); PG8_MMA(0, 0, At, B0); PG8_BAR; PG8_SCHED;
            PG8_LDB(B1, 1, 1); PG8_STAGE(PG8_SB(1, 0), b3, voffB);
            PG8_BAR; PG8_WAIT_L(0); PG8_MMA(0, 1, At, B1); PG8_BAR;
            PG8_LDA(At, 1, 1); PG8_STAGE(PG8_SA(1, 0), a3, voffA);
            PG8_BAR; PG8_WAIT_L(0); PG8_MMA(1, 0, At, B0); PG8_BAR; PG8_SCHED;
            PG8_STAGE(PG8_SB(1, 1), b3 + hstepB, voffB);
            PG8_WAIT_V(6); PG8_BAR; PG8_MMA(1, 1, At, B1); PG8_BAR;
            }
        }
        if constexpr (ALIGN_EPI) { if (wr == 0) PG8_BAR; }
        if constexpr (!Epi::AFTER_DRAIN) { if constexpr (Epi::STAGED) E.staged(acc, cur, wr, wc, fr, fq, lds, lane); else E(acc, cur, wr, wc, fr, fq); S.done(cur); }
        if (!has_next) break;
#pragma unroll
        for (int a = 0; a < 2; ++a)
#pragma unroll
            for (int b = 0; b < 2; ++b)
#pragma unroll
                for (int m = 0; m < 4; ++m)
#pragma unroll
                    for (int n = 0; n < 2; ++n) acc[a][b][m][n] = (f32x4){0.f, 0.f, 0.f, 0.f};
        cur = nxt; cA = nA; cB = nB; ++ui;
        if constexpr (ALIGN_EPI) { if (wr == 1) PG8_BAR; }
    }
    PG8_WAIT_V(0);
    if constexpr (!ALIGN_EPI) { if (wr == 0) PG8_BAR; }
    PG8_BAR;
    if constexpr (Epi::AFTER_DRAIN) { E.fused(acc, cur, wr, wc, fr, fq, lds, wid, lane); S.done(cur); }
#undef PG8_SA
#undef PG8_SB
#undef PG8_STAGE
#undef PG8_LDA
#undef PG8_LDB
#undef PG8_MMA
#undef PG8_WAIT_V
#undef PG8_WAIT_L
#undef PG8_BAR
#undef PG8_SCHED
}
template <int M_, int N_, int K1, int K2, int LDA, class Sched>
__device__ __forceinline__ void gemm_phase_gate(PG8_LAS unsigned char* lds, const bf16_t* A1, const bf16_t* B1t, const bf16_t* A2, const bf16_t* B2t, bf16_t* Zg, int ldc, int gboff, const Sched& S) {
    int tid_ = threadIdx.x; asm volatile("" : "+v"(tid_));
    const int tid = tid_, wid = __builtin_amdgcn_readfirstlane(tid >> 6), lane = tid & 63, wr = wid >> 2, wc = wid & 3, fr = lane & 15, fq = lane >> 4;
    constexpr int NT1 = K1 / BK, nt = (K1 + K2) / BK, lda = LDA;
    static_assert(NT1 % 2 == 0 && nt % 2 == 0, "segments are whole loop trips");
    unsigned voffA[2], voffB1[2], voffB2[2];
#pragma unroll
    for (int i = 0; i < 2; ++i) { int R, C; stage_rc(tid * 16 + i * 8192, R, C); const int Rb = (R & ~31) + perm32(R & 31);
        voffA[i] = (unsigned)(R * lda + C) * 2u; voffB1[i] = (unsigned)(Rb * K1 + C) * 2u; voffB2[i] = (unsigned)(Rb * K2 + C) * 2u; }
    constexpr size_t kstep = (size_t)(BK * 2);
    constexpr size_t hstepA = (size_t)HALF * lda * 2, hstepB1 = (size_t)HALF * K1 * 2, hstepB2 = (size_t)HALF * K2 * 2;
    constexpr size_t tstepA = 2 * hstepA, tstepB1 = 2 * hstepB1, tstepB2 = 2 * hstepB2;
    const unsigned ldsw = (unsigned)wid * 1024u;
    const int aoff = lds_byte(wr * 64 + fr, fq * 8), boff = lds_byte(wc * 32 + fr, fq * 8);
#define PG8_SA(b, h) (((b) * 2 + (h)) * HTB)
#define PG8_SB(b, h) ((4 + (b) * 2 + (h)) * HTB)
#define PG8_STAGE(bufoff, gbase, voff) do { _Pragma("unroll") for (int _i = 0; _i < 2; ++_i) \
        __builtin_amdgcn_global_load_lds((const unsigned*)((const char*)(gbase) + (voff)[_i]), (PG8_LAS unsigned*)(lds + (bufoff) + ldsw + _i * 8192), 16, 0, 0); } while (0)
#define PG8_LDA(dst, b, h) do { _Pragma("unroll") for (int m = 0; m < 4; ++m) _Pragma("unroll") for (int k = 0; k < 2; ++k) dst[m][k] = *(const PG8_LAS bf16x8*)(lds + PG8_SA(b, h) + aoff + m * 2048 + k * 1024); } while (0)
#define PG8_LDB(dst, b, h) do { _Pragma("unroll") for (int n = 0; n < 2; ++n) _Pragma("unroll") for (int k = 0; k < 2; ++k) dst[n][k] = *(const PG8_LAS bf16x8*)(lds + PG8_SB(b, h) + boff + n * 2048 + k * 1024); } while (0)
#define PG8_MMA(ai, bj, At, Bt) do { __builtin_amdgcn_s_setprio(1); _Pragma("unroll") for (int m = 0; m < 4; ++m) _Pragma("unroll") for (int n = 0; n < 2; ++n) _Pragma("unroll") for (int k = 0; k < 2; ++k) \
        acc[ai][bj][m][n] = __builtin_amdgcn_mfma_f32_16x16x32_bf16(Bt[n][k], At[m][k], acc[ai][bj][m][n], 0, 0, 0); __builtin_amdgcn_s_setprio(0); } while (0)
#define PG8_WAIT_V(n) asm volatile("s_waitcnt vmcnt(" #n ")" ::: "memory")
#define PG8_WAIT_L(n) asm volatile("s_waitcnt lgkmcnt(" #n ")" ::: "memory")
#define PG8_BAR __builtin_amdgcn_s_barrier()
#define PG8_SCHED __builtin_amdgcn_sched_barrier(0)
    Unit cur, nxt; int ui = 0;
    if (!S.next(0, cur)) return;
    f32x4 acc[2][2][4][2];
#pragma unroll
    for (int a = 0; a < 2; ++a)
#pragma unroll
        for (int b = 0; b < 2; ++b)
#pragma unroll
            for (int m = 0; m < 4; ++m)
#pragma unroll
                for (int n = 0; n < 2; ++n) acc[a][b][m][n] = (f32x4){0.f, 0.f, 0.f, 0.f};
    bf16x8 At[4][2], B0[2][2], B1[2][2];
    const char* cA1 = (const char*)A1 + (size_t)cur.pm * tstepA; const char* cB1 = (const char*)B1t + (size_t)cur.pn * tstepB1;
    const char* cA2 = (const char*)A2 + (size_t)cur.pm * tstepA; const char* cB2 = (const char*)B2t + (size_t)cur.pn * tstepB2;
    PG8_STAGE(PG8_SB(0, 0), cB1, voffB1); PG8_STAGE(PG8_SB(0, 1), cB1 + hstepB1, voffB1); PG8_STAGE(PG8_SA(0, 0), cA1, voffA); PG8_STAGE(PG8_SA(0, 1), cA1 + hstepA, voffA);
    if (wr == 1) PG8_BAR;
    PG8_WAIT_V(2); PG8_BAR;
    PG8_STAGE(PG8_SB(1, 0), cB1 + kstep, voffB1); PG8_STAGE(PG8_SA(1, 0), cA1 + kstep, voffA); PG8_STAGE(PG8_SB(1, 1), cB1 + hstepB1 + kstep, voffB1);
    PG8_WAIT_V(6); PG8_BAR;
    for (;;) {
        const bool has_next = S.next(ui + 1, nxt);
        const char* nA1 = has_next ? (const char*)A1 + (size_t)nxt.pm * tstepA : cA1; const char* nB1 = has_next ? (const char*)B1t + (size_t)nxt.pn * tstepB1 : cB1;
        const int row0 = cur.pm * BM + wr * 64 + fr, col0 = cur.pn * BM + wc * 32 + 8 * fq;
#pragma unroll 1
        for (int t = 0; t < nt; t += 2) {
            const bool last = (t == nt - 2);
            const bool seg2 = (t >= NT1);
            const bool nseg2 = !last && (t + 2 >= NT1);
            const char* a1 = seg2 ? cA2 + (size_t)(t + 1 - NT1) * kstep : cA1 + (size_t)(t + 1) * kstep;
            const char* a2 = last ? nA1 : (nseg2 ? cA2 + (size_t)(t + 2 - NT1) * kstep : cA1 + (size_t)(t + 2) * kstep);
            const char* b2 = last ? nB1 : (nseg2 ? cB2 + (size_t)(t + 2 - NT1) * kstep : cB1 + (size_t)(t + 2) * kstep);
            const char* a3 = a2 + kstep; const char* b3 = b2 + kstep;
            unsigned vB[2]; vB[0] = nseg2 ? voffB2[0] : voffB1[0]; vB[1] = nseg2 ? voffB2[1] : voffB1[1];
            const size_t hB = nseg2 ? hstepB2 : hstepB1;
            if (t == NT1) {
#pragma unroll
                for (int ai = 0; ai < 2; ++ai)
#pragma unroll
                    for (int m = 0; m < 4; ++m) { const bf16_t* rowp = Zg + (size_t)(row0 + ai * HALF + m * 16) * ldc + col0;
#pragma unroll
                        for (int bj = 0; bj < 2; ++bj) { const bf16_t* pp = rowp + bj * HALF; const u32x4 ga = *(const u32x4*)pp, gb = *(const u32x4*)(pp + gboff);
#define PG8_RHO(GA, GB, LOHI) ((1.f + __expf(-fmaxf(EpiGate<0>::LOHI(GB), -30.f))) * __builtin_amdgcn_rcpf(1.f + __expf(-EpiGate<0>::LOHI(GA))))
                            f32x4 r0 = {PG8_RHO(ga.x, gb.x, lo), PG8_RHO(ga.x, gb.x, hi), PG8_RHO(ga.y, gb.y, lo), PG8_RHO(ga.y, gb.y, hi)};
                            f32x4 r1 = {PG8_RHO(ga.z, gb.z, lo), PG8_RHO(ga.z, gb.z, hi), PG8_RHO(ga.w, gb.w, lo), PG8_RHO(ga.w, gb.w, hi)};
#undef PG8_RHO
                            acc[ai][bj][m][0] = acc[ai][bj][m][0] * r0; acc[ai][bj][m][1] = acc[ai][bj][m][1] * r1; } }
            }
            PG8_LDB(B0, 0, 0); PG8_LDB(B1, 0, 1); PG8_SCHED; PG8_LDA(At, 0, 0); PG8_STAGE(PG8_SA(1, 1), a1 + hstepA, voffA);
            PG8_WAIT_V(8); PG8_WAIT_L(0); PG8_BAR; PG8_MMA(0, 0, At, B0); PG8_MMA(0, 1, At, B1); PG8_BAR; PG8_SCHED;
            PG8_LDA(At, 0, 1); PG8_STAGE(PG8_SB(0, 0), b2, vB); PG8_STAGE(PG8_SB(0, 1), b2 + hB, vB); PG8_STAGE(PG8_SA(0, 0), a2, voffA);
            PG8_WAIT_V(8); PG8_WAIT_L(0); PG8_BAR; PG8_MMA(1, 0, At, B0); PG8_MMA(1, 1, At, B1); PG8_BAR; PG8_SCHED;
            PG8_LDB(B0, 1, 0); PG8_LDB(B1, 1, 1); PG8_SCHED; PG8_LDA(At, 1, 0); PG8_STAGE(PG8_SA(0, 1), a2 + hstepA, voffA);
            PG8_WAIT_V(8); PG8_WAIT_L(0); PG8_BAR; PG8_MMA(0, 0, At, B0); PG8_MMA(0, 1, At, B1); PG8_BAR; PG8_SCHED;
            PG8_LDA(At, 1, 1); PG8_STAGE(PG8_SB(1, 0), b3, vB); PG8_STAGE(PG8_SB(1, 1), b3 + hB, vB); PG8_STAGE(PG8_SA(1, 0), a3, voffA);
            PG8_WAIT_V(8); PG8_WAIT_L(0); PG8_BAR; PG8_MMA(1, 0, At, B0); PG8_MMA(1, 1, At, B1); PG8_BAR; PG8_SCHED;
        }
        if (wr == 0) PG8_BAR;
#define GBC(x) fmaxf((x), -30.f)
        {
            u32x4 gv[2][4][2];
#pragma unroll
            for (int ai = 0; ai < 2; ++ai)
#pragma unroll
                for (int m = 0; m < 4; ++m)
#pragma unroll
                    for (int bj = 0; bj < 2; ++bj) gv[ai][m][bj] = *(const u32x4*)(Zg + (size_t)(row0 + ai * HALF + m * 16) * ldc + col0 + bj * HALF + gboff);
            asm volatile("" ::: "memory");
#pragma unroll
            for (int ai = 0; ai < 2; ++ai)
#pragma unroll
                for (int m = 0; m < 4; ++m) { bf16_t* rowp = Zg + (size_t)(row0 + ai * HALF + m * 16) * ldc + col0;
#pragma unroll
                    for (int bj = 0; bj < 2; ++bj) { bf16_t* pp = rowp + bj * HALF; const u32x4 gb = gv[ai][m][bj]; const f32x4 v0 = acc[ai][bj][m][0], v1 = acc[ai][bj][m][1];
                        u32x4 w;
                        w.x = cvt_pk_bf16(EpiGate<0>::sig(GBC(EpiGate<0>::lo(gb.x))) * v0[0], EpiGate<0>::sig(GBC(EpiGate<0>::hi(gb.x))) * v0[1]); w.y = cvt_pk_bf16(EpiGate<0>::sig(GBC(EpiGate<0>::lo(gb.y))) * v0[2], EpiGate<0>::sig(GBC(EpiGate<0>::hi(gb.y))) * v0[3]);
                        w.z = cvt_pk_bf16(EpiGate<0>::sig(GBC(EpiGate<0>::lo(gb.z))) * v1[0], EpiGate<0>::sig(GBC(EpiGate<0>::hi(gb.z))) * v1[1]); w.w = cvt_pk_bf16(EpiGate<0>::sig(GBC(EpiGate<0>::lo(gb.w))) * v1[2], EpiGate<0>::sig(GBC(EpiGate<0>::hi(gb.w))) * v1[3]);
                        *(u32x4*)pp = w; } }
        }
#undef GBC
        if (!has_next) break;
#pragma unroll
        for (int a = 0; a < 2; ++a)
#pragma unroll
            for (int b = 0; b < 2; ++b)
#pragma unroll
                for (int m = 0; m < 4; ++m)
#pragma unroll
                    for (int n = 0; n < 2; ++n) acc[a][b][m][n] = (f32x4){0.f, 0.f, 0.f, 0.f};
        cur = nxt; cA1 = nA1; cB1 = nB1;
        cA2 = (const char*)A2 + (size_t)cur.pm * tstepA; cB2 = (const char*)B2t + (size_t)cur.pn * tstepB2; ++ui;
        if (wr == 1) PG8_BAR;
    }
    PG8_WAIT_V(0);
    PG8_BAR;
#undef PG8_SA
#undef PG8_SB
#undef PG8_STAGE
#undef PG8_LDA
#undef PG8_LDB
#undef PG8_MMA
#undef PG8_WAIT_V
#undef PG8_WAIT_L
#undef PG8_BAR
#undef PG8_SCHED
}
}
constexpr int NWAVES = 8;
constexpr int BATCH = 8, SEQ = 4096, D = 1024, M = BATCH * SEQ, NZ = 5888, FF = 4096, DEPTH = 2;
constexpr int C_AQ = 0, C_AK = 512, C_AV = 640, C_RQ = 768, C_RK = 1280, C_RV = 1792, C_RG = 2816, C_GA = 3840, C_GB = 4864;
constexpr int C_YA = 768, C_YB = 1792;
constexpr float EPS = 1e-6f;

constexpr size_t MiB = 1u << 20;
constexpr size_t WS_CTL = 0, CTL_ZERO_BYTES = 1 * MiB;
constexpr size_t WS_TABA = 1 * MiB, WS_TABR = 2 * MiB;
constexpr size_t WS_SS = 4 * MiB;
constexpr size_t WS_W = 6 * MiB;
constexpr size_t W_WIN = 0, W_WA = 6029312, W_WB = 6553600, W_WOUT = 7602176, W_WUP = 8650752, W_WDOWN = 12845056, W_LAYER = 17039360;
constexpr size_t WS_H = 71 * MiB;
constexpr size_t WS_Z = 135 * MiB;
constexpr size_t WS_END = 503 * MiB;
static_assert(WS_W + 2 * W_LAYER * 2 <= WS_H && WS_H + (size_t)M * D * 2 <= WS_Z && WS_Z + (size_t)M * NZ * 2 <= WS_END, "d_ws map");
constexpr int CW_BAR = 4096;

constexpr int RING_OFF = 0, RING_BYTES = 131072;
constexpr int LDSCTL_OFF = RING_BYTES, MISC_OFF = LDSCTL_OFF + 320;
constexpr int LDS_BYTES = 163840;

#define GAS __attribute__((address_space(1)))
#define LAS __attribute__((address_space(3)))
typedef unsigned short bf16;
typedef unsigned v4u __attribute__((ext_vector_type(4)));
typedef unsigned v2u __attribute__((ext_vector_type(2)));
typedef float f32x4 __attribute__((ext_vector_type(4)));
typedef float f32x2 __attribute__((ext_vector_type(2)));
#define LDS_WAIT() asm volatile("s_waitcnt lgkmcnt(0)" ::: "memory")
#define VM_WAIT() asm volatile("s_waitcnt vmcnt(0)" ::: "memory")
__device__ __forceinline__ unsigned f2bf(float f) { unsigned u = __builtin_bit_cast(unsigned, f); return (u + 0x7fffu + ((u >> 16) & 1u)) >> 16; }
__device__ __forceinline__ unsigned pk2(float lo, float hi) { return f2bf(lo) | (f2bf(hi) << 16); }
__device__ __forceinline__ float bf2f(unsigned short b) { return __builtin_bit_cast(float, (unsigned)b << 16); }
__device__ __forceinline__ float bflo(unsigned w) { return __builtin_bit_cast(float, w << 16); }
__device__ __forceinline__ float bfhi(unsigned w) { return __builtin_bit_cast(float, w & 0xffff0000u); }

#define XB_TMO      128
#define XB_XCNT(j)  (256  + 64 * (j))
#define XB_XSUB(j)  (1280 + 64 * (j))
#define XB_XGEN(j)  (2304 + 64 * (j))
#define XB_TOP      3328
#define XB_TOPGEN   3392
#define XCD_BAR_WORDS 3456
#define XB_SPIN_CAP (1u << 24)

__device__ __forceinline__ unsigned xb_ld(unsigned* p)              { return __hip_atomic_load(p, __ATOMIC_RELAXED, __HIP_MEMORY_SCOPE_AGENT); }
__device__ __forceinline__ unsigned xb_add(unsigned* p, unsigned v) { return __hip_atomic_fetch_add(p, v, __ATOMIC_RELAXED, __HIP_MEMORY_SCOPE_AGENT); }
__device__ __forceinline__ unsigned xb_xcc_id() { return (unsigned)__builtin_amdgcn_s_getreg((3 << 11) | 20) & 0xFu; }
#define XB_SPIN(cond, bar) do { unsigned _sp = 0; while (cond) { __builtin_amdgcn_s_sleep(1); \
    if ((++_sp & 255u) == 0u) { if (xb_ld(&(bar)[XB_TMO])) break; if (_sp > XB_SPIN_CAP) { atomicAdd(&(bar)[XB_TMO], 1u); break; } } } } while (0)

struct XcdBarrier { unsigned* bar; unsigned x; volatile LAS unsigned* st; };

__device__ __forceinline__ XcdBarrier xcd_barrier_post(unsigned* bar, volatile LAS unsigned* st) {
    XcdBarrier b; b.bar = bar; b.x = xb_xcc_id(); b.st = st;
    if (threadIdx.x == 0) (void)xb_add(&bar[XB_XCNT(b.x)], 1u);
    return b;
}
__device__ __forceinline__ void xcd_barrier_complete(unsigned* bar, unsigned x, unsigned& nloc, unsigned& nx) {
    const unsigned G = gridDim.x * gridDim.y * gridDim.z;
    unsigned sum, cnt, mine, sp = 0u;
    for (;;) {
        sum = 0u; cnt = 0u; mine = 0u;
#pragma unroll 1
        for (unsigned j = 0; j < 16; ++j) { const unsigned c = xb_ld(&bar[XB_XCNT(j)]); sum += c; cnt += (c > 0u) ? 1u : 0u; mine = (j == x) ? c : mine; }
        if (sum == G) break;
        __builtin_amdgcn_s_sleep(1);
        if ((++sp & 255u) == 0u) { if (xb_ld(&bar[XB_TMO])) break; if (sp > XB_SPIN_CAP) { atomicAdd(&bar[XB_TMO], 1u); break; } }
    }
    nloc = mine > 0u ? mine : 1u; nx = cnt > 0u ? cnt : 1u;
}
__device__ __forceinline__ void xcd_barrier_census(const XcdBarrier& b) {
    if (threadIdx.x == 0) { unsigned nloc, nx; xcd_barrier_complete(b.bar, b.x, nloc, nx); b.st[0] = nloc; b.st[1] = nx; }
    __syncthreads();
}
__device__ __forceinline__ void xcd_barrier(const XcdBarrier& b) {
    asm volatile("s_waitcnt vmcnt(0)" ::: "memory");
    __syncthreads();
    if (threadIdx.x == 0) {
        unsigned* bar = b.bar;
        __builtin_amdgcn_s_waitcnt(0);
        const unsigned nloc = b.st[0], nx = b.st[1];
        const unsigned old = xb_add(&bar[XB_XSUB(b.x)], 1u);
        const unsigned gen = old / nloc;
        if (old + 1u == (gen + 1u) * nloc) {
            __builtin_amdgcn_fence(__ATOMIC_RELEASE, "agent");
            asm volatile("s_waitcnt vmcnt(0)" ::: "memory");
            const unsigned og = xb_add(&bar[XB_TOP], 1u);
            const unsigned tg = og / nx;
            if (og + 1u == (tg + 1u) * nx) xb_add(&bar[XB_TOPGEN], 1u);
            else XB_SPIN(xb_ld(&bar[XB_TOPGEN]) == tg, bar);
            __builtin_amdgcn_fence(__ATOMIC_ACQUIRE, "agent");
            xb_add(&bar[XB_XGEN(b.x)], 1u);
            asm volatile("s_waitcnt vmcnt(0)" ::: "memory");
        } else {
            XB_SPIN(xb_ld(&bar[XB_XGEN(b.x)]) == gen, bar);
            __builtin_amdgcn_fence(__ATOMIC_ACQUIRE, "agent");
            asm volatile("s_waitcnt vmcnt(0)" ::: "memory");
        }
    }
    __syncthreads();
}

__device__ __forceinline__ float wave_sum(float v) {
#pragma unroll
    for (int o = 1; o < 64; o <<= 1) v += __shfl_xor(v, o);
    return v;
}
template <bool WINMAP> __device__ __forceinline__ void p0_transpose_item(const float* W, int K, int N, bf16* WT, LAS float* scr, int item, int lane, const float* gk = nullptr) {
    const int nblk = N / 32, kb = item / nblk, nb = item % nblk, k0 = 64 * kb, n0 = 32 * nb;
    const int srcc = WINMAP ? pg8::win_colmap(n0 + (lane & 31)) : n0 + (lane & 31);
    float wv[32];
#pragma unroll
    for (int i = 0; i < 32; ++i) { const int kk = 2 * i + (lane >> 5); wv[i] = W[(size_t)(k0 + kk) * N + srcc]; }
    if (gk) {
#pragma unroll
        for (int i = 0; i < 32; ++i) wv[i] *= gk[k0 + 2 * i + (lane >> 5)];
    }
#pragma unroll
    for (int i = 0; i < 32; ++i) { const int kk = 2 * i + (lane >> 5); scr[kk * 33 + (lane & 31)] = wv[i]; }
    LDS_WAIT(); asm volatile("" ::: "memory");
    const int c = lane & 7;
#pragma unroll
    for (int j = 0; j < 4; ++j) { const int n = (lane >> 3) + 8 * j; const LAS float* s = scr + (8 * c) * 33 + n;
        v4u o; o.x = pk2(s[0 * 33], s[1 * 33]); o.y = pk2(s[2 * 33], s[3 * 33]); o.z = pk2(s[4 * 33], s[5 * 33]); o.w = pk2(s[6 * 33], s[7 * 33]);
        *(GAS v4u*)(WT + (size_t)(n0 + n) * K + k0 + 8 * c) = o; }
    LDS_WAIT(); asm volatile("" ::: "memory");
}
struct Ctx {
    LAS unsigned char* lds;
    int tid, lane, wave, vcu, G;
    const float* in[11]; float* out; unsigned char* ws;
};
#define CTXP const Ctx& F

__device__ __forceinline__ bf16* wsl(CTXP, int l, size_t off) { return (bf16*)(F.ws + WS_W) + (size_t)l * W_LAYER + off; }

constexpr int CI_IN = (D / 64) * (NZ / 32), CI_A = (512 / 64) * (D / 32), CI_B = (D / 64) * (D / 32), CI_O = CI_B, CI_U = (D / 64) * (FF / 32), CI_D = (FF / 64) * (D / 32);
constexpr int CI_LAYER = CI_IN + CI_A + CI_B + CI_O + CI_U + CI_D;
__device__ __forceinline__ void convert_items(CTXP, int lo, int hi, int gw = -1, int NGW = 0) {
    LAS float* scr = (LAS float*)(F.lds + RING_OFF + F.wave * 16384);
    if (gw < 0) { gw = F.vcu * NWAVES + F.wave; NGW = F.G * NWAVES; }
    for (int it = lo + gw; it < hi; it += NGW) {
        const int l = it / CI_LAYER; int r = it % CI_LAYER;
        if (r < CI_IN) { p0_transpose_item<true>(F.in[2] + (size_t)l * D * NZ, D, NZ, wsl(F, l, W_WIN), scr, r, F.lane, F.in[1] + l * D); continue; } r -= CI_IN;
        if (r < CI_A) { p0_transpose_item<false>(F.in[4] + (size_t)l * 512 * D, 512, D, wsl(F, l, W_WA), scr, r, F.lane); continue; } r -= CI_A;
        if (r < CI_B) { p0_transpose_item<false>(F.in[5] + (size_t)l * D * D, D, D, wsl(F, l, W_WB), scr, r, F.lane); continue; } r -= CI_B;
        if (r < CI_O) { p0_transpose_item<false>(F.in[6] + (size_t)l * D * D, D, D, wsl(F, l, W_WOUT), scr, r, F.lane); continue; } r -= CI_O;
        if (r < CI_U) { p0_transpose_item<false>(F.in[8] + (size_t)l * D * FF, D, FF, wsl(F, l, W_WUP), scr, r, F.lane, F.in[7] + l * D); continue; } r -= CI_U;
        p0_transpose_item<false>(F.in[9] + (size_t)l * FF * D, FF, D, wsl(F, l, W_WDOWN), scr, r, F.lane);
    }
}
__device__ __forceinline__ void phase_prologue(CTXP) {
    const int gw = F.vcu * NWAVES + F.wave, NGW = F.G * NWAVES;
    convert_items(F, 0, CI_IN);
    {
        bf16* H = (bf16*)(F.ws + WS_H); float* SS = (float*)(F.ws + WS_SS);
        for (int m = gw; m < M; m += NGW) {
            const f32x4* xr = (const f32x4*)(F.in[0] + (size_t)m * D) + F.lane;
            unsigned long long* o8 = (unsigned long long*)(H + (size_t)m * D) + F.lane; float s = 0.f;
#pragma unroll
            for (int j = 0; j < 4; ++j) { const f32x4 v = xr[64 * j]; s += (v.x * v.x + v.y * v.y) + (v.z * v.z + v.w * v.w);
                o8[64 * j] = (unsigned long long)pk2(v.x, v.y) | ((unsigned long long)pk2(v.z, v.w) << 32); }
            s = wave_sum(s);
            if (F.lane < 16) SS[(size_t)m * 16 + F.lane] = (F.lane == 0) ? s : 0.f;
        }
    }
    f32x2* tabA = (f32x2*)(F.ws + WS_TABA); f32x2* tabR = (f32x2*)(F.ws + WS_TABR);
    const int gt = (F.vcu * NWAVES + F.wave) * 64 + F.lane, NGT = F.G * NWAVES * 64;
    for (int idx = gt; idx < SEQ * 96; idx += NGT) {
        const int pos = idx / 96, j = idx % 96;
        const float ex = (j < 32) ? (float)j * (1.f / 32.f) : (float)(j - 32) * (1.f / 63.f);
        const float inv = exp2f(-ex * 13.287712379549449f);
        const float ang = (float)pos * inv;
        float s, c; sincosf(ang, &s, &c);
        const f32x2 v = {c, s};
        if (j < 32) tabA[pos * 32 + j] = v; else tabR[pos * 64 + (j - 32)] = v;
    }
}

__device__ __forceinline__ void phase_rms_final(CTXP, const bf16* X, float* out, const float* g) {
    const int gw = F.vcu * NWAVES + F.wave, NGW = F.G * NWAVES;
    const f32x4* g4 = (const f32x4*)g + F.lane; const float* SS = (const float*)(F.ws + WS_SS);
    const f32x4 ga = g4[0], gb = g4[64], gc = g4[128], gd = g4[192];
    for (int m = gw; m < M; m += NGW) {
        const v2u* xr = (const v2u*)(X + (size_t)m * D) + F.lane; f32x4* orow = (f32x4*)(out + (size_t)m * D) + F.lane;
        const float rstd = pg8::row_rstd(SS, m);
        const v2u a = xr[0], b = xr[64], c = xr[128], d = xr[192];
        orow[0]   = (f32x4){bflo(a.x), bfhi(a.x), bflo(a.y), bfhi(a.y)} * rstd * ga;
        orow[64]  = (f32x4){bflo(b.x), bfhi(b.x), bflo(b.y), bfhi(b.y)} * rstd * gb;
        orow[128] = (f32x4){bflo(c.x), bfhi(c.x), bflo(c.y), bfhi(c.y)} * rstd * gc;
        orow[192] = (f32x4){bflo(d.x), bfhi(d.x), bflo(d.y), bfhi(d.y)} * rstd * gd;
    }
}

typedef short bf16x8 __attribute__((ext_vector_type(8)));
typedef short s16x4 __attribute__((ext_vector_type(4)));
typedef float f32x16 __attribute__((ext_vector_type(16)));
typedef __bf16 bf16x2_t __attribute__((ext_vector_type(2)));
#define MFMA32(a, b, c) __builtin_amdgcn_mfma_f32_32x32x16_bf16((a), (b), (c), 0, 0, 0)
__device__ __forceinline__ int crow(int r, int h) { return (r & 3) + 8 * (r >> 2) + 4 * h; }
__device__ __forceinline__ unsigned cvtpk(float lo, float hi) { f32x2 v = {lo, hi}; bf16x2_t b = __builtin_convertvector(v, bf16x2_t); return __builtin_bit_cast(unsigned, b); }
__device__ __forceinline__ s16x4 tr_read(const LAS unsigned char* p) { return __builtin_bit_cast(s16x4, __builtin_amdgcn_ds_read_tr16_b64_v4i16((LAS s16x4*)p)); }
#define PACK_STEP(x, s) __builtin_bit_cast(bf16x8, (v4u){cvtpk((x)[8 * (s)], (x)[8 * (s) + 1]), cvtpk((x)[8 * (s) + 2], (x)[8 * (s) + 3]), cvtpk((x)[8 * (s) + 4], (x)[8 * (s) + 5]), cvtpk((x)[8 * (s) + 6], (x)[8 * (s) + 7])})

__device__ __forceinline__ void phase_attn_mfma(CTXP, bf16* z, const float* sinks) {
    const LAS unsigned char* Kl = F.lds + RING_OFF; const LAS unsigned char* Vl = F.lds + RING_OFF + 32768;
    const int tid = F.tid, lane = F.lane, r = lane & 31, h = lane >> 5, wave = F.wave;
    const int i16 = lane & 15, tq = i16 >> 2, tp = i16 & 3, blk = (lane >> 4) & 1;
    for (int unit = F.vcu; unit < BATCH * 32 * 2; unit += F.G) {
        const int g = unit & 1, n = (unit >> 1) & 31, b = unit >> 6;
        const size_t m0 = (size_t)b * SEQ + (size_t)n * 128;
        const int kj_lo = (n == 0) ? 128 : 0, kt_lo = (n == 0) ? 4 : 0;
#pragma unroll
        for (int p = 0; p < 4; ++p) { const int row = p * 64 + (tid >> 3), c = tid & 7;
            if (row >= kj_lo) { const bf16* src = z + (m0 - 128 + row) * NZ + 64 * g + 8 * c;
                const v4u kv = *(const v4u*)(src + C_AK), vv = *(const v4u*)(src + C_AV);
                *(LAS v4u*)(Kl + row * 128 + ((c ^ (row & 7)) * 16)) = kv; *(LAS v4u*)(Vl + row * 128 + c * 16) = vv; } }
        __syncthreads();
        const int hq = 4 * g + (wave >> 1);
        const float sinkl = sinks[hq] * 1.4426950408889634f;
#pragma unroll 1
        for (int qq = 0; qq < 2; ++qq) {
            const int qs = (wave & 1) * 2 + qq;
            bf16* qrow = z + (m0 + 32 * qs + r) * NZ + C_AQ + 64 * hq;
            bf16x8 qf[4];
#pragma unroll
            for (int ks = 0; ks < 4; ++ks) qf[ks] = *(const bf16x8*)(qrow + 16 * ks + 8 * h);
            f32x16 s[5];
            const int iq = 32 * qs + r;
#pragma unroll
            for (int t = 0; t < 5; ++t) {
                const int kt = qs + t;
                if (kt < kt_lo) {
#pragma unroll
                    for (int i = 0; i < 16; ++i) s[t][i] = -INFINITY;
                } else {
                    f32x16 acc;
#pragma unroll
                    for (int i = 0; i < 16; ++i) acc[i] = 0.f;
                    const int key = 32 * kt + r;
#pragma unroll
                    for (int ks = 0; ks < 4; ++ks) { const bf16x8 a = *(const LAS bf16x8*)(Kl + key * 128 + (((2 * ks + h) ^ (key & 7)) * 16)); acc = MFMA32(a, qf[ks], acc); }
#pragma unroll
                    for (int i = 0; i < 16; ++i) { const int kj = 32 * kt + crow(i, h); const bool valid = (kj >= iq + 1) && (kj <= iq + 128); s[t][i] = valid ? acc[i] * 0.18033688011112042f : -INFINITY; }
                }
            }
            float mx = sinkl;
#pragma unroll
            for (int t = 0; t < 5; ++t)
#pragma unroll
                for (int i = 0; i < 16; ++i) mx = fmaxf(mx, s[t][i]);
            mx = fmaxf(mx, __shfl_xor(mx, 32));
            float l = 0.f;
#pragma unroll
            for (int t = 0; t < 5; ++t)
#pragma unroll
                for (int i = 0; i < 16; ++i) { const float p = __builtin_amdgcn_exp2f(s[t][i] - mx); s[t][i] = p; l += p; }
            l += __shfl_xor(l, 32);
            l += __builtin_amdgcn_exp2f(sinkl - mx);
            f32x16 o[2];
#pragma unroll
            for (int i = 0; i < 16; ++i) { o[0][i] = 0.f; o[1][i] = 0.f; }
#pragma unroll
            for (int t = 0; t < 5; ++t) {
                const int kt = qs + t;
                if (kt >= kt_lo) {
#pragma unroll
                    for (int s2 = 0; s2 < 2; ++s2) {
                        const bf16x8 xs = PACK_STEP(s[t], s2);
#pragma unroll
                        for (int dt = 0; dt < 2; ++dt) {
                            const LAS unsigned char* vp = Vl + (32 * kt + 16 * s2 + 4 * h + tq) * 128 + (32 * dt + 16 * blk) * 2 + 8 * tp;
                            const s16x4 lo = tr_read(vp), hi = tr_read(vp + 8 * 128);
                            const bf16x8 pa = __builtin_shufflevector(lo, hi, 0, 1, 2, 3, 4, 5, 6, 7);
                            o[dt] = MFMA32(pa, xs, o[dt]);
                        }
                    }
                }
            }
            const float rl = 1.f / l;
#pragma unroll
            for (int dt = 0; dt < 2; ++dt)
#pragma unroll
                for (int g4 = 0; g4 < 4; ++g4) {
                    v2u w; w.x = cvtpk(o[dt][4 * g4] * rl, o[dt][4 * g4 + 1] * rl); w.y = cvtpk(o[dt][4 * g4 + 2] * rl, o[dt][4 * g4 + 3] * rl);
                    *(v2u*)(qrow + 32 * dt + 8 * g4 + 4 * h) = w;
                }
        }
        __syncthreads();
    }
}

__device__ __forceinline__ void glds16(const void* gsrc, LAS unsigned char* ldst) {
    unsigned keep; const unsigned dst = (unsigned)__builtin_amdgcn_readfirstlane((int)(unsigned)(size_t)ldst);
    asm volatile("s_mov_b32 %0, m0\n\ts_mov_b32 m0, %2\n\ts_nop 0\n\tglobal_load_lds_dwordx4 %1, off\n\ts_mov_b32 m0, %0" : "=&s"(keep) : "v"(gsrc), "s"(dst) : "memory");
}
__device__ __forceinline__ void phase_ret_state(CTXP, const bf16* z, bf16* KV) {
    constexpr int SLOT = 32768, KOFF = 0, VOFF = 16384;
    const int wave = F.wave;
    for (int unit = F.vcu; unit < BATCH * 4 * 8; unit += F.G) {
        int lane = F.lane; asm volatile("" : "+v"(lane));
        const int r = lane & 31, h = lane >> 5, i16 = lane & 15, tq = i16 >> 2, tp = i16 & 3, blk = (lane >> 4) & 1;
        const int eq = unit & 3, dh = (unit >> 2) & 1, hd = (unit >> 3) & 3, b = unit >> 5;
        const float log2g = log2f(1.f - exp2f(-5.f - (float)hd)), gch = exp2f(128.f * log2g);
        const bf16* ksrc = z + ((size_t)b * SEQ + (wave * 16 + (lane >> 3))) * NZ + C_RK + 128 * hd + 64 * dh + 8 * (lane & 7);
        const bf16* vsrc = z + ((size_t)b * SEQ + (wave * 16 + (lane >> 3))) * NZ + C_RV + 256 * hd + 64 * eq + 8 * (lane & 7);
#define RS_ISSUE(n_, slot_) do { const size_t ro_ = (size_t)(n_) * 128 * NZ; LAS unsigned char* sb_ = F.lds + RING_OFF + (slot_) * SLOT + wave * 2048; \
        glds16(ksrc + ro_, sb_ + KOFF); glds16(ksrc + ro_ + (size_t)8 * NZ, sb_ + KOFF + 1024); \
        glds16(vsrc + ro_, sb_ + VOFF); glds16(vsrc + ro_ + (size_t)8 * NZ, sb_ + VOFF + 1024); } while (0)
        RS_ISSUE(0, 0); RS_ISSUE(1, 1); RS_ISSUE(2, 2);
        f32x16 acc;
#pragma unroll
        for (int i = 0; i < 16; ++i) acc[i] = 0.f;
        float zb[8];
#pragma unroll
        for (int j = 0; j < 8; ++j) zb[j] = exp2f(log2g * (float)(127 - 8 * h - j));
        const int dt = wave & 1, et = (wave >> 1) & 1;
        bf16* outp = KV + ((size_t)(b * 4 + hd) * 32) * 32768 + (64 * eq + 32 * et + r) * 128 + 64 * dh + 32 * dt + 4 * h;
#pragma unroll 1
        for (int n = 0; n < 32; ++n) {
            if (n < 30) asm volatile("s_waitcnt vmcnt(8)" ::: "memory"); else if (n == 30) asm volatile("s_waitcnt vmcnt(4)" ::: "memory"); else asm volatile("s_waitcnt vmcnt(0)" ::: "memory");
            __builtin_amdgcn_s_barrier();
            if (wave < 4) {
#pragma unroll
                for (int g4 = 0; g4 < 4; ++g4) { v2u w; w.x = cvtpk(acc[4 * g4], acc[4 * g4 + 1]); w.y = cvtpk(acc[4 * g4 + 2], acc[4 * g4 + 3]); *(v2u*)(outp + 8 * g4) = w; }
            }
            outp += 32768;
            if (n + 3 < 32) RS_ISSUE(n + 3, (n + 3) & 3);
            if (wave < 4) {
                const LAS unsigned char* Kl = F.lds + RING_OFF + (n & 3) * SLOT + KOFF; const LAS unsigned char* Vl = F.lds + RING_OFF + (n & 3) * SLOT + VOFF;
#pragma unroll
                for (int i = 0; i < 16; ++i) acc[i] *= gch;
#pragma unroll
                for (int s = 0; s < 8; ++s) {
                    const LAS unsigned char* vp = Vl + (16 * s + 8 * h + tq) * 128 + (32 * et + 16 * blk) * 2 + 8 * tp;
                    const s16x4 vlo = tr_read(vp), vhi = tr_read(vp + 4 * 128);
                    const LAS unsigned char* kp = Kl + (16 * s + 8 * h + tq) * 128 + (32 * dt + 16 * blk) * 2 + 8 * tp;
                    const s16x4 klo = tr_read(kp), khi = tr_read(kp + 4 * 128);
                    const float fs = exp2f(log2g * (float)(-16 * s));
                    v4u bq;
                    bq.x = cvtpk(bf2f((unsigned short)vlo[0]) * (zb[0] * fs), bf2f((unsigned short)vlo[1]) * (zb[1] * fs)); bq.y = cvtpk(bf2f((unsigned short)vlo[2]) * (zb[2] * fs), bf2f((unsigned short)vlo[3]) * (zb[3] * fs));
                    bq.z = cvtpk(bf2f((unsigned short)vhi[0]) * (zb[4] * fs), bf2f((unsigned short)vhi[1]) * (zb[5] * fs)); bq.w = cvtpk(bf2f((unsigned short)vhi[2]) * (zb[6] * fs), bf2f((unsigned short)vhi[3]) * (zb[7] * fs));
                    const bf16x8 bfrag = __builtin_bit_cast(bf16x8, bq);
                    const bf16x8 afrag = __builtin_shufflevector(klo, khi, 0, 1, 2, 3, 4, 5, 6, 7);
                    acc = MFMA32(afrag, bfrag, acc);
                }
            }
        }
#undef RS_ISSUE
        asm volatile("s_waitcnt vmcnt(0)" ::: "memory");
        __builtin_amdgcn_s_barrier();
    }
}
#define RO_WAIT_BAR(N) asm volatile("s_waitcnt vmcnt(" #N ")\n\ts_barrier" ::: "memory")
__device__ __forceinline__ void ro2_wait_bar(int cnt) {
    if (cnt >= 24) RO_WAIT_BAR(24); else if (cnt >= 16) RO_WAIT_BAR(16); else if (cnt >= 8) RO_WAIT_BAR(8); else if (cnt >= 4) RO_WAIT_BAR(4); else RO_WAIT_BAR(0);
}
template <int KIND> __device__ __forceinline__ void ro2_issue(CTXP, const bf16* z, const bf16* RP, int ui) {
    int lane = F.lane; asm volatile("" : "+v"(lane));
    const int wave = F.wave;
    const int unit = F.vcu + ui * F.G;
    const int n = unit & 31, hd = (unit >> 5) & 3, b = unit >> 7;
    const size_t m0 = (size_t)b * SEQ + (size_t)n * 128;
    LAS unsigned char* sb = F.lds + RING_OFF + (KIND & 3) * 32768 + wave * 4096;
    if (KIND == 4 || KIND == 5) {
        const int row = 8 * wave + (lane >> 5);
        const bf16* src = z + (m0 + 64 * (KIND - 4) + row) * NZ + C_RV + 256 * hd;
#pragma unroll
        for (int j = 0; j < 4; ++j) { const int c = (lane & 31) ^ (((row + 2 * j) & 3) << 2); glds16(src + (size_t)(2 * j) * NZ + 8 * c, sb + j * 1024); }
    } else {
        const int row = 16 * wave + (lane >> 4);
#pragma unroll
        for (int j = 0; j < 4; ++j) { const int rw = row + 4 * j, c = (lane & 15) ^ (rw & 15);
            const bf16* src;
            if (KIND == 0) src = z + (m0 + rw) * NZ + C_RQ + 128 * hd + 8 * c;
            else if (KIND == 3) src = z + (m0 + rw) * NZ + C_RK + 128 * hd + 8 * c;
            else if (KIND == 1 || KIND == 2) { const int e = (rw < 64 ? rw : 64 + rw) + 64 * (KIND - 1); src = RP + (size_t)unit * 32768 + e * 128 + 8 * c; }
            else { const int e = 128 * (c >> 3) + 64 * (KIND - 6) + 8 * (c & 7); src = z + (m0 + rw) * NZ + C_RG + 256 * hd + e; }
            glds16(src, sb + j * 1024); }
    }
}
__device__ __forceinline__ void phase_ret_out_dma(CTXP, bf16* z, const bf16* RP) {
    constexpr int SLOT = 32768;
    LAS float* red = (LAS float*)(F.lds + LDSCTL_OFF + 1024);
    const int wave = F.wave, qb = wave & 3, eh = wave >> 2;
    const int NU = (BATCH * 4 * 32 - F.vcu + F.G - 1) / F.G;
    if (NU <= 0) return;
    ro2_issue<0>(F, z, RP, 0); ro2_issue<1>(F, z, RP, 0); ro2_issue<2>(F, z, RP, 0);
#pragma unroll 1
    for (int ui = 0; ui < NU; ++ui) {
        int lane = F.lane; asm volatile("" : "+v"(lane));
        const int r = lane & 31, h = lane >> 5, i16 = lane & 15, tq = i16 >> 2, tp = i16 & 3, blk = (lane >> 4) & 1;
        const int unit = F.vcu + ui * F.G;
        const int n = unit & 31, hd = (unit >> 5) & 3, b = unit >> 7;
        const size_t m0 = (size_t)b * SEQ + (size_t)n * 128;
        const float log2g = log2f(1.f - exp2f(-5.f - (float)hd));
        const int iq = 32 * qb + r;
        const int more = (ui + 1 < NU) ? 1 : 0, first = (ui == 0) ? 1 : 0;
        const LAS unsigned char* R0 = F.lds + RING_OFF;
        ro2_wait_bar(first ? 8 : 24);
        ro2_issue<3>(F, z, RP, ui);
        bf16x8 qf[8];
        { const int row = 32 * qb + r;
#pragma unroll
          for (int ks = 0; ks < 8; ++ks) qf[ks] = *(const LAS bf16x8*)(R0 + 0 * SLOT + row * 256 + (((2 * ks + h) ^ (row & 15)) << 4)); }
        f32x16 acc[4];
        const float xi = exp2f(log2g * (float)(iq + 1));
#pragma unroll
        for (int hf = 0; hf < 2; ++hf) {
            if (hf == 0) { ro2_wait_bar(first ? 8 : 24); ro2_issue<4>(F, z, RP, ui); }
            else         { ro2_wait_bar(first ? 8 : 16); ro2_issue<5>(F, z, RP, ui); }
            const LAS unsigned char* Rl = R0 + (1 + hf) * SLOT;
#pragma unroll
            for (int e2 = 0; e2 < 2; ++e2) {
                const int et = 2 * hf + e2, row = 64 * eh + 32 * e2 + r;
#pragma unroll
                for (int i = 0; i < 16; ++i) acc[et][i] = 0.f;
#pragma unroll
                for (int ks = 0; ks < 8; ++ks) { const bf16x8 a = *(const LAS bf16x8*)(Rl + row * 256 + (((2 * ks + h) ^ (row & 15)) << 4)); acc[et] = MFMA32(a, qf[ks], acc[et]); }
#pragma unroll
                for (int i = 0; i < 16; ++i) acc[et][i] *= xi;
            }
        }
        ro2_wait_bar(8);
        ro2_issue<6>(F, z, RP, ui);
        bf16x8 xf[4][2];
        {
            const LAS unsigned char* Kl = R0 + 3 * SLOT;
#pragma unroll
            for (int kt = 0; kt < 4; ++kt) {
                if (kt <= qb) {
                    f32x16 X;
#pragma unroll
                    for (int i = 0; i < 16; ++i) X[i] = 0.f;
                    const int key = 32 * kt + r;
#pragma unroll
                    for (int ks = 0; ks < 8; ++ks) { const bf16x8 a = *(const LAS bf16x8*)(Kl + key * 256 + (((2 * ks + h) ^ (key & 15)) << 4)); X = MFMA32(a, qf[ks], X); }
#pragma unroll
                    for (int i = 0; i < 16; ++i) { const int kj = 32 * kt + crow(i, h); X[i] = (kj <= iq) ? X[i] * exp2f(log2g * (float)(iq - kj)) : 0.f; }
                    xf[kt][0] = PACK_STEP(X, 0); xf[kt][1] = PACK_STEP(X, 1);
                }
                __builtin_amdgcn_sched_barrier(0);
            }
        }
#pragma unroll
        for (int vh = 0; vh < 2; ++vh) {
            ro2_wait_bar(8);
            if (vh == 0) ro2_issue<7>(F, z, RP, ui); else if (more) ro2_issue<0>(F, z, RP, ui + 1);
            const LAS unsigned char* Vl = R0 + vh * SLOT;
#pragma unroll
            for (int k2 = 0; k2 < 2; ++k2) {
                const int kt = 2 * vh + k2;
                if (kt <= qb) {
#pragma unroll
                    for (int s2 = 0; s2 < 2; ++s2) {
#pragma unroll
                        for (int et = 0; et < 4; ++et) {
                            const int row = 32 * k2 + 16 * s2 + 4 * h + tq, chunk = 16 * eh + 4 * et + 2 * blk + (tp >> 1);
                            const LAS unsigned char* vp = Vl + row * 512 + ((chunk ^ (tq << 2)) << 4) + 8 * (tp & 1);
                            const s16x4 lo = tr_read(vp), hi = tr_read(vp + 8 * 512);
                            const bf16x8 pa = __builtin_shufflevector(lo, hi, 0, 1, 2, 3, 4, 5, 6, 7);
                            acc[et] = MFMA32(pa, xf[kt][s2], acc[et]);
                        }
                    }
                }
            }
        }
        float ss = 0.f;
#pragma unroll
        for (int et = 0; et < 4; ++et)
#pragma unroll
            for (int i = 0; i < 16; ++i) ss += acc[et][i] * acc[et][i];
        ss += __shfl_xor(ss, 32);
        if (h == 0) red[eh * 128 + iq] = ss;
        bf16* grow = z + (m0 + iq) * NZ + C_RG + 256 * hd + 128 * eh + 4 * h;
        float rstd = 0.f;
#pragma unroll
        for (int hf = 0; hf < 2; ++hf) {
            if (hf == 0) { asm volatile("s_waitcnt lgkmcnt(0)" ::: "memory"); ro2_wait_bar(4 + 4 * more); if (more) ro2_issue<1>(F, z, RP, ui + 1);
                           rstd = 1.f / sqrtf((red[iq] + red[128 + iq]) * (1.f / 256.f) + EPS); }
            else         { ro2_wait_bar(8 + 8 * more); if (more) ro2_issue<2>(F, z, RP, ui + 1); }
            const LAS unsigned char* Gl = R0 + (2 + hf) * SLOT;
            const int row = 32 * qb + r;
#pragma unroll
            for (int e2 = 0; e2 < 2; ++e2)
#pragma unroll
                for (int g4 = 0; g4 < 4; ++g4) {
                    const int et = 2 * hf + e2, c = 8 * eh + 4 * e2 + g4;
                    const v2u gv = *(const LAS v2u*)(Gl + row * 256 + ((c ^ (row & 15)) << 4) + 8 * h);
                    const float g0_ = bflo(gv.x), g1 = bfhi(gv.x), g2 = bflo(gv.y), g3 = bfhi(gv.y);
                    const float o0 = acc[et][4 * g4] * rstd * (g0_ / (1.f + __expf(-g0_))), o1 = acc[et][4 * g4 + 1] * rstd * (g1 / (1.f + __expf(-g1)));
                    const float o2 = acc[et][4 * g4 + 2] * rstd * (g2 / (1.f + __expf(-g2))), o3 = acc[et][4 * g4 + 3] * rstd * (g3 / (1.f + __expf(-g3)));
                    v2u w; w.x = cvtpk(o0, o1); w.y = cvtpk(o2, o3);
                    *(v2u*)(grow + 32 * et + 8 * g4) = w;
                }
        }
    }
    asm volatile("s_waitcnt vmcnt(0) lgkmcnt(0)\n\ts_barrier" ::: "memory");
}
#ifndef PROBE_AMP
#define PROBE_AMP 0
#define PROBE_MASK 0
#endif
#ifndef MK_PER_PHASE
#define MK_PER_PHASE 0
#endif
constexpr int PPL = 7;
constexpr int NPH = 1 + DEPTH * PPL + 1;
struct Args { const float* in[11]; float* out; unsigned char* ws; int ph_lo, ph_hi; };
typedef __attribute__((address_space(4))) const Args CArgs;
__global__ void __launch_bounds__(NWAVES * 64, 2) mega_fwd(Args args) {
    extern __shared__ __attribute__((aligned(16))) unsigned char lds[];
    volatile LAS unsigned* MISC = (volatile LAS unsigned*)((LAS unsigned char*)lds + MISC_OFF);
    for (int u = threadIdx.x; u < (LDS_BYTES - LDSCTL_OFF) / 4; u += NWAVES * 64) ((LAS unsigned*)((LAS unsigned char*)lds + LDSCTL_OFF))[u] = 0u;
    __syncthreads();
    const int lo = args.ph_lo, hi = args.ph_hi;
    unsigned* ctl = (unsigned*)(args.ws + WS_CTL);
    XcdBarrier bar; bar.bar = ctl + CW_BAR; bar.x = 0; bar.st = nullptr;
    if (hi - lo > 1) { bar = xcd_barrier_post(ctl + CW_BAR, MISC + 8); xcd_barrier_census(bar); }
#pragma unroll 1
    for (int ph = lo; ph < hi; ++ph) {
        CArgs* ap = (CArgs*)__builtin_amdgcn_kernarg_segment_ptr(); asm volatile("" : "+s"(ap));
        int tid = threadIdx.x; asm volatile("" : "+v"(tid));
        Ctx F;
        F.lds = (LAS unsigned char*)lds;
        F.tid = tid; F.lane = tid & 63; F.wave = __builtin_amdgcn_readfirstlane(tid >> 6);
        F.G = gridDim.x; { const int bx = blockIdx.x; F.vcu = (F.G % 8 == 0) ? (bx % 8) * (F.G / 8) + bx / 8 : bx; }
#pragma unroll
        for (int i = 0; i < 11; ++i) F.in[i] = ap->in[i];
        F.out = ap->out; F.ws = ap->ws;
        bf16* const H = (bf16*)(F.ws + WS_H);
        bf16* const Z = (bf16*)(F.ws + WS_Z);
        const int bx = (int)blockIdx.x;
#if PROBE_AMP
        const unsigned long long pt0 = __builtin_amdgcn_s_memrealtime();
#endif
        if (ph == 0) phase_prologue(F);
        else if (ph == NPH - 1) phase_rms_final(F, H, F.out, F.in[10]);
        else {
            const int l = (ph - 1) / PPL, k = (ph - 1) % PPL;
            bf16* const KVb = (bf16*)F.out;
            float* const SS = (float*)(F.ws + WS_SS);
            switch (k) {
            case 0: { pg8::Gemm<M, NZ, D, D> g{H, wsl(F, l, W_WIN)}; pg8::StaticOrder<M, NZ> S; S.init(F.G, bx);
                      pg8::EpiWin E{Z, NZ, (const f32x2*)(F.ws + WS_TABA), (const f32x2*)(F.ws + WS_TABR), SS}; pg8::gemm_phase<pg8::EpiWin, pg8::StaticOrder<M, NZ>, true, true>(F.lds + RING_OFF, g, S, E);
                      { const int nwg = (M / 256) * (NZ / 256), short_from = nwg % F.G;
                        if (short_from > 0 && bx >= short_from) convert_items(F, l * CI_LAYER + CI_IN, (l + 1 < DEPTH) ? (l + 1) * CI_LAYER + CI_IN : (l + 1) * CI_LAYER, (bx - short_from) * NWAVES + F.wave, (F.G - short_from) * NWAVES);
                        else if (short_from == 0) convert_items(F, l * CI_LAYER + CI_IN, (l + 1 < DEPTH) ? (l + 1) * CI_LAYER + CI_IN : (l + 1) * CI_LAYER); } } break;
            case 1: phase_ret_state(F, Z, KVb); phase_attn_mfma(F, Z, F.in[3] + l * 8); break;
            case 2: phase_ret_out_dma(F, Z, KVb); break;
            case 3: { pg8::StaticOrder<M, D> S; S.init(F.G, bx);
                      pg8::gemm_phase_gate<M, D, 512, D, NZ, pg8::StaticOrder<M, D>>(F.lds + RING_OFF, Z + C_AQ, wsl(F, l, W_WA), Z + C_RG, wsl(F, l, W_WB), Z + C_GA, NZ, C_GB - C_GA, S); } break;
            case 4: { pg8::Gemm<M, D, D, NZ> g{Z + C_GA, wsl(F, l, W_WOUT)}; pg8::StaticOrder<M, D> S; S.init(F.G, bx);
                      pg8::EpiResBf16 E{H, SS, D}; pg8::gemm_phase<pg8::EpiResBf16, pg8::StaticOrder<M, D>, true, true>(F.lds + RING_OFF, g, S, E); } break;
            case 5: { pg8::Gemm<M, FF, D, D> g{H, wsl(F, l, W_WUP)}; pg8::StaticOrder<M, FF> S; S.init(F.G, bx);
                      pg8::EpiBf16<2> E{Z, FF, SS}; pg8::gemm_phase<pg8::EpiBf16<2>, pg8::StaticOrder<M, FF>, true, true>(F.lds + RING_OFF, g, S, E); } break;
            default: { pg8::Gemm<M, D, FF, FF> g{Z, wsl(F, l, W_WDOWN)}; pg8::StaticOrder<M, D> S; S.init(F.G, bx);
                      pg8::EpiResBf16 E{H, SS, D}; pg8::gemm_phase<pg8::EpiResBf16, pg8::StaticOrder<M, D>, true, true>(F.lds + RING_OFF, g, S, E); } break;
            }
        }
#if PROBE_AMP
        {
            const int cls = (ph == 0) ? 0 : (ph == NPH - 1) ? 9 : 1 + (ph - 1) % PPL;
            __syncthreads();
            const unsigned long long pt1 = __builtin_amdgcn_s_memrealtime();
            if ((PROBE_MASK >> cls) & 1) { const unsigned long long dt = (pt1 - pt0) * PROBE_AMP; while (__builtin_amdgcn_s_memrealtime() - pt1 < dt) __builtin_amdgcn_s_sleep(8); }
        }
#endif
        if (ph + 1 < hi) xcd_barrier(bar);
    }
}

extern "C" void kernel_launch(void* const* d_in, const int* in_sizes, int n_in, void* d_out, int out_size, void* d_ws, size_t ws_size, hipStream_t stream) {
    static int grid = 0;
    if (grid == 0) {
        if (n_in != 11 || in_sizes[0] != M * D || out_size != M * D || ws_size < WS_END) {
            fprintf(stderr, "kernel_launch: unexpected shapes: n_in %d in0 %d out %d ws %zu (need %zu)\n", n_in, n_in > 0 ? in_sizes[0] : -1, out_size, ws_size, (size_t)WS_END); grid = -1; return; }
        int dev = 0, cus = 0, per_cu = 0;
        if (hipGetDevice(&dev) != hipSuccess || hipDeviceGetAttribute(&cus, hipDeviceAttributeMultiprocessorCount, dev) != hipSuccess) { grid = -1; return; }
        if (hipFuncSetAttribute((const void*)mega_fwd, hipFuncAttributeMaxDynamicSharedMemorySize, LDS_BYTES) != hipSuccess) { fprintf(stderr, "kernel_launch: hipFuncSetAttribute failed\n"); grid = -1; return; }
        if (hipOccupancyMaxActiveBlocksPerMultiprocessor(&per_cu, (const void*)mega_fwd, NWAVES * 64, LDS_BYTES) != hipSuccess || per_cu < 1)
            fprintf(stderr, "kernel_launch: occupancy query reports %d workgroups per CU\n", per_cu);
        (void)hipGetLastError();
        grid = cus;
    }
    if (grid < 0) return;
    if (hipMemsetAsync((char*)d_ws + WS_CTL, 0, CTL_ZERO_BYTES, stream) != hipSuccess) return;
    Args a{};
    for (int i = 0; i < 11; ++i) a.in[i] = (const float*)d_in[i];
    a.out = (float*)d_out; a.ws = (unsigned char*)d_ws;
#if MK_PER_PHASE
    for (int p = 0; p < NPH; ++p) { a.ph_lo = p; a.ph_hi = p + 1; hipLaunchKernelGGL(mega_fwd, dim3(grid), dim3(NWAVES * 64), LDS_BYTES, stream, a); }
#else
    a.ph_lo = 0; a.ph_hi = NPH;
    hipLaunchKernelGGL(mega_fwd, dim3(grid), dim3(NWAVES * 64), LDS_BYTES, stream, a);
#endif
}
```
